# Optimizing an MI355X kernel written in HIP

```python
import math, functools
import jax, jax.numpy as jnp
from jax import lax
import numpy as np

D_MODEL = 1024
BATCH = 2
SEQ = 8192
DEPTH = 2
DEC_BATCH = 128
DEC_SEQ = 8
PAST_LEN = 2048
PAGE_SIZE = 128

N_HEADS = 16
HEAD_DIM = D_MODEL // N_HEADS
N_KV_HEADS = 4
GROUP = N_HEADS // N_KV_HEADS
L_CMP = 32
D_CMP = 16
L_SEL = 64
TOP_N = 16
WINDOW = 512
Q_BLOCK = 128
SSM_CH = 16
N_GROUPS = D_MODEL // SSM_CH
STATE_P = 64
D_FF = 2816
CONV_W = 3
PLE_DIM = 256

N_MIXERS = 2
N_ATTN = (DEPTH + 1) // 2
N_SSM = DEPTH // 2
Q_COLS = N_HEADS * HEAD_DIM
KV_COLS = N_KV_HEADS * HEAD_DIM
ATTN_IN_COLS = Q_COLS + 6 * KV_COLS + 3 * N_HEADS
NORM_EPS = 1e-6
NEG_INF = -1e30
FORCE_BONUS = 1e4

kernel_name = "nsa_s5_hybrid_decode_step"


def rms_norm(x, gain):
    xf = x.astype(jnp.float32)
    y = xf * lax.rsqrt(jnp.mean(xf * xf, axis=-1, keepdims=True) + NORM_EPS)
    return (y * gain.astype(jnp.float32)).astype(x.dtype)


def alibi_slopes():
    return jnp.exp2(-8.0 * jnp.arange(1, N_HEADS + 1, dtype=jnp.float32) / N_HEADS)


def masked_softmax(s, mask):
    p = jax.nn.softmax(jnp.where(mask, s, NEG_INF), axis=-1)
    return p * mask


def compress_rows(rows, pe, w1, w2):
    nc = (rows.shape[0] - L_CMP) // D_CMP + 1
    idx = jnp.arange(nc)[:, None] * D_CMP + jnp.arange(L_CMP)[None, :]
    blk = rows[idx] + pe[None, :, None, :]
    h = jax.nn.gelu(jnp.einsum('nlgd,lde->nge', blk, w1))
    return jnp.einsum('nge,ef->ngf', h, w2)


def n_sel_blocks(length):
    return max(-(-length // L_SEL), TOP_N)


def selection_blocks(rows, ns_pad):
    rows = jnp.pad(rows, ((0, ns_pad * L_SEL - rows.shape[0]), (0, 0), (0, 0)))
    return rows.reshape(ns_pad, L_SEL, N_KV_HEADS, HEAD_DIM).transpose(2, 0, 1, 3)


def nsa_attend(q, q_pos, gates, kc, vc, ksb, vsb, kw, vw, w_pos):
    f32 = jnp.float32
    tq = q.shape[0]
    scale = HEAD_DIM ** -0.5
    qg = q.reshape(tq, N_KV_HEADS, GROUP, HEAD_DIM)
    slopes = alibi_slopes().reshape(1, N_KV_HEADS, GROUP, 1)
    qp = q_pos.astype(f32)

    nc = kc.shape[0]
    c_start = jnp.arange(nc) * D_CMP
    c_center = c_start.astype(f32) + (L_CMP - 1) / 2
    s = jnp.einsum('tgrd,ngd->tgrn', qg, kc).astype(f32) * scale
    s = s - slopes * (qp[:, None, None, None] - c_center)
    c_mask = (c_start + L_CMP - 1 <= q_pos[:, None])[:, None, None, :]
    p_cmp = masked_softmax(s, c_mask)
    o_cmp = jnp.einsum('tgrn,ngd->tgrd', p_cmp, vc.astype(f32))

    ns = ksb.shape[1]
    ratio = L_SEL // D_CMP
    imp = jnp.pad(p_cmp.sum(axis=2), ((0, 0), (0, 0), (0, ns * ratio - nc)))
    imp = imp.reshape(tq, N_KV_HEADS, ns, ratio).sum(-1)
    blk = jnp.arange(ns)
    cur = (q_pos // L_SEL)[:, None]
    forced = (blk == 0) | (blk == cur) | (blk == cur - 1)
    started = blk * L_SEL <= q_pos[:, None]
    score = jnp.where(started[:, None, :], imp + FORCE_BONUS * forced[:, None, :], NEG_INF)
    _, idx = lax.top_k(score, TOP_N)
    g_ix = jnp.arange(N_KV_HEADS)[None, :, None]
    ks = ksb[g_ix, idx]
    vs = vsb[g_ix, idx]
    tok = idx[..., None] * L_SEL + jnp.arange(L_SEL)
    dist = (q_pos[:, None, None, None] - tok).reshape(tq, N_KV_HEADS, 1, TOP_N * L_SEL)
    s = jnp.einsum('tgrd,tgkld->tgrkl', qg, ks).astype(f32).reshape(tq, N_KV_HEADS, GROUP, TOP_N * L_SEL)
    s = s * scale - slopes * dist.astype(f32)
    p_sel = masked_softmax(s, dist >= 0)
    o_sel = jnp.einsum('tgrkl,tgkld->tgrd',
                       p_sel.reshape(tq, N_KV_HEADS, GROUP, TOP_N, L_SEL), vs.astype(f32))

    wd = q_pos[:, None] - w_pos[None, :]
    w_mask = ((wd >= 0) & (wd < WINDOW) & (w_pos >= 0)[None, :])[:, None, None, :]
    s = jnp.einsum('tgrd,lgd->tgrl', qg, kw).astype(f32) * scale - slopes * wd.astype(f32)[:, None, None, :]
    p_win = masked_softmax(s, w_mask)
    o_win = jnp.einsum('tgrl,lgd->tgrd', p_win, vw.astype(f32))

    g = gates.astype(f32).reshape(tq, N_KV_HEADS, GROUP, 3)
    o = g[..., 0:1] * o_cmp + g[..., 1:2] * o_sel + g[..., 2:3] * o_win
    return o.reshape(tq, N_HEADS, HEAD_DIM).astype(q.dtype)


def nsa_project(u, w_in):
    b, t, _ = u.shape
    z = u @ w_in
    q = z[..., :Q_COLS].reshape(b, t, N_HEADS, HEAD_DIM)
    kv = z[..., Q_COLS:Q_COLS + 4 * KV_COLS].reshape(b, t, 4, N_KV_HEADS, HEAD_DIM)
    win = z[..., Q_COLS + 4 * KV_COLS:Q_COLS + 6 * KV_COLS].reshape(b, t, 2, N_KV_HEADS, HEAD_DIM)
    gates = jax.nn.sigmoid(z[..., Q_COLS + 6 * KV_COLS:]).reshape(b, t, N_HEADS, 3)
    return q, kv, win, gates


def nsa_prompt_seq(q, gates, kv, win, cmp_pe, cmp_w1, cmp_w2):
    t = q.shape[0]
    kc = compress_rows(kv[:, 0], cmp_pe[0], cmp_w1[0], cmp_w2[0])
    vc = compress_rows(kv[:, 1], cmp_pe[1], cmp_w1[1], cmp_w2[1])
    ns = n_sel_blocks(t)
    ksb = selection_blocks(kv[:, 2], ns)
    vsb = selection_blocks(kv[:, 3], ns)
    win_pad = jnp.pad(win, ((WINDOW, 0), (0, 0), (0, 0), (0, 0)))
    band = WINDOW + Q_BLOCK

    def block(b):
        q0 = b * Q_BLOCK
        qb = lax.dynamic_slice_in_dim(q, q0, Q_BLOCK, 0)
        gb = lax.dynamic_slice_in_dim(gates, q0, Q_BLOCK, 0)
        wb = lax.dynamic_slice_in_dim(win_pad, q0, band, 0)
        q_pos = q0 + jnp.arange(Q_BLOCK)
        w_pos = q0 - WINDOW + jnp.arange(band)
        return nsa_attend(qb, q_pos, gb, kc, vc, ksb, vsb, wb[:, 0], wb[:, 1], w_pos)

    o = lax.map(block, jnp.arange(t // Q_BLOCK))
    return o.reshape(t, N_HEADS, HEAD_DIM)


def nsa_layer_prompt(u, w_in, w_out, cmp_pe, cmp_w1, cmp_w2):
    b, t, _ = u.shape
    q, kv, win, gates = nsa_project(u, w_in)
    o = jax.vmap(nsa_prompt_seq, in_axes=(0, 0, 0, 0, None, None, None))(q, gates, kv, win, cmp_pe, cmp_w1, cmp_w2)
    keep = min(WINDOW, t)
    return o.reshape(b, t, Q_COLS) @ w_out, kv, win[:, t - keep:]


def nsa_layer_sample(u, cache_kv, layer, cache_win_l, page_table, w_in, w_out, cmp_pe, cmp_w1, cmp_w2):
    b, t, _ = u.shape
    q, kv, win, gates = nsa_project(u, w_in)
    past_len = page_table.shape[1] * cache_kv.shape[2]
    wbuf = cache_win_l.shape[1]
    ns = n_sel_blocks(past_len + t)
    q_pos = past_len + jnp.arange(t)
    w_pos = past_len - wbuf + jnp.arange(wbuf + t)

    def one(args):
        qs, gs, kv_new, win_new, win_past, prow = args
        past = cache_kv[layer, prow].reshape(past_len, 4, N_KV_HEADS, HEAD_DIM)
        rows = jnp.concatenate([past, kv_new], axis=0)
        kc = compress_rows(rows[:, 0], cmp_pe[0], cmp_w1[0], cmp_w2[0])
        vc = compress_rows(rows[:, 1], cmp_pe[1], cmp_w1[1], cmp_w2[1])
        ksb = selection_blocks(rows[:, 2], ns)
        vsb = selection_blocks(rows[:, 3], ns)
        band = jnp.concatenate([win_past, win_new], axis=0)
        o = nsa_attend(qs, q_pos, gs, kc, vc, ksb, vsb, band[:, 0], band[:, 1], w_pos)
        return o, band[t:]

    o, new_win = lax.map(one, (q, gates, kv, win, cache_win_l, page_table))
    return o.reshape(b, t, Q_COLS) @ w_out, kv, new_win


def ssm_combine(left, right):
    a_l, b_l = left
    a_r, b_r = right
    return a_l * a_r, a_r * b_l + b_r


def s5_layer(u, h0, a_re, a_im, log_dt, b_re, b_im, c_re, c_im, d_skip, w_glu):
    f32 = jnp.float32
    bsz, t, _ = u.shape
    lam = lax.complex(a_re.astype(f32), a_im.astype(f32))
    dt = jnp.exp(log_dt.astype(f32))[:, None]
    a_bar = jnp.exp(lam * dt)
    b_bar = ((a_bar - 1.0) / lam)[:, :, None] * lax.complex(b_re.astype(f32), b_im.astype(f32))
    c_mat = lax.complex(c_re.astype(f32), c_im.astype(f32))
    uf = u.astype(f32)
    ug = uf.reshape(bsz, t, N_GROUPS, SSM_CH).astype(jnp.complex64)
    bu = jnp.einsum('gpc,btgc->btgp', b_bar, ug)
    bu = bu.at[:, 0].add(a_bar * h0)
    a_seq = jnp.broadcast_to(a_bar, bu.shape)
    _, h = lax.associative_scan(ssm_combine, (a_seq, bu), axis=1)
    y = jnp.einsum('gcp,btgp->btgc', c_mat, h).real.reshape(bsz, t, D_MODEL) + d_skip.astype(f32) * uf
    z = jax.nn.gelu(y)
    ab = z @ w_glu.astype(f32)
    out = ab[..., :D_MODEL] * jax.nn.sigmoid(ab[..., D_MODEL:])
    return out.astype(u.dtype), h[:, -1]


def conv_ffn(u, buf, w_up, conv_w, conv_b, w_down):
    t = u.shape[1]
    hg = u @ w_up
    h, g = hg[..., :D_FF], hg[..., D_FF:]
    hc = jnp.concatenate([buf.astype(h.dtype), h], axis=1)
    conv = conv_b + sum(conv_w[j] * hc[:, j:j + t] for j in range(CONV_W))
    return (jax.nn.gelu(conv) * g) @ w_down, hc[:, t:]


def per_layer_embed(x, p, gain, w_proj, w_gate):
    gate = jax.nn.sigmoid(rms_norm(x, gain) @ w_gate)
    return x + (p @ w_proj) * gate


def setup_inputs(seed: int = 0) -> dict:
    key = jax.random.key(seed)
    keys = iter(jax.random.split(key, 40))
    f32 = jnp.float32

    def nrm(shape, scale=1.0):
        return jax.random.normal(next(keys), shape, f32) * scale

    n_pages = PAST_LEN // PAGE_SIZE
    n_pool = (DEC_BATCH * n_pages * 5) // 4
    win_buf = min(WINDOW, PAST_LEN)
    inp = {}
    inp["x_prompt"] = nrm((BATCH, SEQ, D_MODEL))
    inp["x_sample"] = nrm((DEC_BATCH, DEC_SEQ, D_MODEL))
    inp["cache_kv"] = nrm((N_ATTN, n_pool, PAGE_SIZE, 4, N_KV_HEADS, HEAD_DIM))
    inp["cache_win"] = nrm((N_ATTN, DEC_BATCH, win_buf, 2, N_KV_HEADS, HEAD_DIM))
    inp["state_ssm_re"] = nrm((N_SSM, DEC_BATCH, N_GROUPS, STATE_P), 0.1)
    inp["state_ssm_im"] = nrm((N_SSM, DEC_BATCH, N_GROUPS, STATE_P), 0.1)
    inp["state_conv"] = nrm((DEPTH, DEC_BATCH, CONV_W - 1, D_FF))
    perm = jax.random.permutation(next(keys), n_pool)
    inp["page_table"] = perm[:DEC_BATCH * n_pages].reshape(DEC_BATCH, n_pages).astype(jnp.int32)
    inp["p_prompt"] = nrm((DEPTH, BATCH, SEQ, PLE_DIM))
    inp["p_sample"] = nrm((DEPTH, DEC_BATCH, DEC_SEQ, PLE_DIM))
    inp["norm_mix"] = 1.0 + nrm((DEPTH, D_MODEL), 0.01)
    inp["norm_ffn"] = 1.0 + nrm((DEPTH, D_MODEL), 0.01)
    inp["norm_ple"] = 1.0 + nrm((DEPTH, D_MODEL), 0.01)
    inp["norm_final"] = 1.0 + nrm((D_MODEL,), 0.01)
    inp["w_attn_in"] = nrm((N_ATTN, D_MODEL, ATTN_IN_COLS), D_MODEL ** -0.5)
    inp["w_attn_out"] = nrm((N_ATTN, Q_COLS, D_MODEL), Q_COLS ** -0.5)
    inp["cmp_pe"] = nrm((N_ATTN, 2, L_CMP, HEAD_DIM), 0.02)
    inp["cmp_w1"] = nrm((N_ATTN, 2, L_CMP, HEAD_DIM, HEAD_DIM), (L_CMP * HEAD_DIM) ** -0.5)
    inp["cmp_w2"] = nrm((N_ATTN, 2, HEAD_DIM, HEAD_DIM), HEAD_DIM ** -0.5)
    inp["ssm_a_re"] = -0.5 + nrm((N_SSM, N_GROUPS, STATE_P), 0.01)
    inp["ssm_a_im"] = jnp.pi * jnp.arange(STATE_P, dtype=f32) + nrm((N_SSM, N_GROUPS, STATE_P), 0.01)
    inp["ssm_log_dt"] = jax.random.uniform(next(keys), (N_SSM, N_GROUPS), f32, math.log(1e-3), math.log(1e-1))
    inp["ssm_b_re"] = nrm((N_SSM, N_GROUPS, STATE_P, SSM_CH), (2 * SSM_CH) ** -0.5)
    inp["ssm_b_im"] = nrm((N_SSM, N_GROUPS, STATE_P, SSM_CH), (2 * SSM_CH) ** -0.5)
    inp["ssm_c_re"] = nrm((N_SSM, N_GROUPS, SSM_CH, STATE_P), STATE_P ** -0.5)
    inp["ssm_c_im"] = nrm((N_SSM, N_GROUPS, SSM_CH, STATE_P), STATE_P ** -0.5)
    inp["ssm_d"] = nrm((N_SSM, D_MODEL), 0.5)
    inp["w_glu"] = nrm((N_SSM, D_MODEL, 2 * D_MODEL), D_MODEL ** -0.5)
    inp["w_ffn_up"] = nrm((DEPTH, D_MODEL, 2 * D_FF), D_MODEL ** -0.5)
    inp["ffn_conv_w"] = nrm((DEPTH, CONV_W, D_FF), CONV_W ** -0.5)
    inp["ffn_conv_b"] = nrm((DEPTH, D_FF), 0.01)
    inp["w_ffn_down"] = nrm((DEPTH, D_FF, D_MODEL), D_FF ** -0.5)
    inp["w_ple_proj"] = nrm((DEPTH, PLE_DIM, D_MODEL), PLE_DIM ** -0.5)
    inp["w_ple_gate"] = nrm((DEPTH, D_MODEL, D_MODEL), D_MODEL ** -0.5)
    return inp


def reference(x_prompt, x_sample, cache_kv, cache_win, state_ssm_re, state_ssm_im, state_conv, page_table,
              p_prompt, p_sample, norm_mix, norm_ffn, norm_ple, norm_final, w_attn_in, w_attn_out,
              cmp_pe, cmp_w1, cmp_w2, ssm_a_re, ssm_a_im, ssm_log_dt, ssm_b_re, ssm_b_im, ssm_c_re, ssm_c_im,
              ssm_d, w_glu, w_ffn_up, ffn_conv_w, ffn_conv_b, w_ffn_down, w_ple_proj, w_ple_gate):
    f32 = jnp.float32
    bsz = x_prompt.shape[0]
    xp, xs = x_prompt, x_sample
    kv_p, kv_s, win_p, win_s = [], [], [], []
    sre_p, sim_p, sre_s, sim_s = [], [], [], []
    cb_p, cb_s = [], []
    for i in range(DEPTH):
        j = i // N_MIXERS
        up = rms_norm(xp, norm_mix[i])
        us = rms_norm(xs, norm_mix[i])
        if i % N_MIXERS == 0:
            mp, kvp, wp = nsa_layer_prompt(up, w_attn_in[j], w_attn_out[j], cmp_pe[j], cmp_w1[j], cmp_w2[j])
            ms, kvs, ws = nsa_layer_sample(us, cache_kv, j, cache_win[j], page_table,
                                           w_attn_in[j], w_attn_out[j], cmp_pe[j], cmp_w1[j], cmp_w2[j])
            kv_p.append(kvp)
            kv_s.append(kvs)
            win_p.append(wp)
            win_s.append(ws)
        else:
            h0p = jnp.zeros((bsz, N_GROUPS, STATE_P), jnp.complex64)
            h0s = lax.complex(state_ssm_re[j].astype(f32), state_ssm_im[j].astype(f32))
            mp, hp = s5_layer(up, h0p, ssm_a_re[j], ssm_a_im[j], ssm_log_dt[j], ssm_b_re[j], ssm_b_im[j],
                              ssm_c_re[j], ssm_c_im[j], ssm_d[j], w_glu[j])
            ms, hs = s5_layer(us, h0s, ssm_a_re[j], ssm_a_im[j], ssm_log_dt[j], ssm_b_re[j], ssm_b_im[j],
                              ssm_c_re[j], ssm_c_im[j], ssm_d[j], w_glu[j])
            sre_p.append(hp.real)
            sim_p.append(hp.imag)
            sre_s.append(hs.real)
            sim_s.append(hs.imag)
        xp = xp + mp
        xs = xs + ms
        fp, bp = conv_ffn(rms_norm(xp, norm_ffn[i]), jnp.zeros((bsz, CONV_W - 1, D_FF), xp.dtype),
                          w_ffn_up[i], ffn_conv_w[i], ffn_conv_b[i], w_ffn_down[i])
        fs, bs = conv_ffn(rms_norm(xs, norm_ffn[i]), state_conv[i],
                          w_ffn_up[i], ffn_conv_w[i], ffn_conv_b[i], w_ffn_down[i])
        cb_p.append(bp)
        cb_s.append(bs)
        xp = per_layer_embed(xp + fp, p_prompt[i], norm_ple[i], w_ple_proj[i], w_ple_gate[i])
        xs = per_layer_embed(xs + fs, p_sample[i], norm_ple[i], w_ple_proj[i], w_ple_gate[i])
    y_prompt = rms_norm(xp, norm_final)
    y_sample = rms_norm(xs, norm_final)
    new_kv_prompt = jnp.stack(kv_p)
    new_kv_sample = jnp.stack(kv_s)
    new_win_prompt = jnp.stack(win_p)
    new_win_sample = jnp.stack(win_s)
    new_ssm_re_prompt = jnp.stack(sre_p)
    new_ssm_im_prompt = jnp.stack(sim_p)
    new_ssm_re_sample = jnp.stack(sre_s)
    new_ssm_im_sample = jnp.stack(sim_s)
    new_conv_prompt = jnp.stack(cb_p)
    new_conv_sample = jnp.stack(cb_s)
    return (y_prompt, y_sample, new_kv_prompt, new_kv_sample, new_win_prompt, new_win_sample,
            new_ssm_re_prompt, new_ssm_im_prompt, new_ssm_re_sample, new_ssm_im_sample,
            new_conv_prompt, new_conv_sample)
```

```cpp
#include <hip/hip_runtime.h>
#include <cstdio>
#include <cstdint>

#define GAS __attribute__((address_space(1)))
#define LAS __attribute__((address_space(3)))
typedef unsigned short bf16;
typedef unsigned v4u __attribute__((ext_vector_type(4)));
typedef unsigned v2u __attribute__((ext_vector_type(2)));
typedef float f32x4 __attribute__((ext_vector_type(4)));
typedef float f32x2 __attribute__((ext_vector_type(2)));
typedef short bf16x8 __attribute__((ext_vector_type(8)));
typedef float f32x16 __attribute__((ext_vector_type(16)));

constexpr int DM = 1024, SEQ = 8192, NB = 2, MP = NB * SEQ  , DB = 128, DS = 8, MS = DB * DS  , M = MP + MS  ;
constexpr int PAST = 2048, PAGE = 128, NPAGES = PAST / PAGE  ;
constexpr int NH = 16, HD = 64, NG = 4;
constexpr int NIN = 2608, NINP = 2816;
constexpr int FF = 2816, PLE = 256;
constexpr int NCP = 511, NCS = 127;
constexpr int NSP = 128, NSS = 33;
constexpr float EPS = 1e-6f;
constexpr int CMP_ROWS_P = 2 * NB * 512 * NG;
constexpr int CMP_ROWS_S = 2 * DB * 128 * NG;
constexpr int CMP_ROWS = CMP_ROWS_P + CMP_ROWS_S;

constexpr size_t MiB = 1u << 20;
constexpr size_t WS_CTL = 0, CTL_ZERO_BYTES = 2 * MiB;
constexpr size_t WS_WIN_T = 2 * MiB, WS_WOUT_T = 8 * MiB, WS_WUP_T0 = 10 * MiB, WS_WUP_T1 = 21 * MiB, WS_WDN_T0 = 32 * MiB, WS_WDN_T1 = 38 * MiB;
constexpr size_t WS_WP_T0 = 44 * MiB, WS_WP_T1 = 45 * MiB, WS_WG_T0 = 47 * MiB, WS_WG_T1 = 49 * MiB, WS_WGLU_T = 51 * MiB, WS_W1R_T = 55 * MiB, WS_CVEC = 55 * MiB + 768 * 1024, WS_S5TAB = 56 * MiB;
constexpr size_t WS_XBA = 64 * MiB, WS_XBB = 98 * MiB, WS_XR = 132 * MiB, WS_QB = 200 * MiB, WS_OB = 234 * MiB, WS_KVB = 268 * MiB, WS_WINB = 302 * MiB, WS_GATES = 319 * MiB;
constexpr size_t WS_KCP = 323 * MiB, WS_VCP = 323 * MiB + 512 * 1024, WS_KCS = 324 * MiB, WS_VCS = 332 * MiB, WS_CMPA = 340 * MiB, WS_PBUF = 612 * MiB;
constexpr size_t WS_HG = 680 * MiB, WS_ACT = 867 * MiB, WS_PB0 = 961 * MiB, WS_PB1 = 970 * MiB, WS_PP0 = 979 * MiB, WS_PP1 = 1013 * MiB, WS_Z = 1047 * MiB, WS_SELS = 1081 * MiB, WS_WINS = 1340 * MiB, WS_S5K = 1407 * MiB, WS_S5W = 1408 * MiB, WS_S5V = 1416 * MiB, WS_S5A = 1424 * MiB, WS_HALOA = 1425 * MiB, WS_HALOB = 1429 * MiB, WS_S5E = 1431 * MiB, WS_S5H = 1448 * MiB, WS_STASH = 1457 * MiB, WS_XG = 1474 * MiB, WS_END = 1509 * MiB;
constexpr int CW_TMO = 0, CW_BAR = 4096, CW_SS = 65536;
static_assert((CW_SS + 7 * M) * 4 <= (int)CTL_ZERO_BYTES, "ctl words inside the memset region");

constexpr int NWAVES = 8;
constexpr int RING_BYTES = 131072;
constexpr int WAVE_LDS = 18432;
constexpr int MISC_OFF = NWAVES * WAVE_LDS;
constexpr int LDS_BYTES = MISC_OFF + 256;

#define RLX_AGENT __ATOMIC_RELAXED, __HIP_MEMORY_SCOPE_AGENT
#define LDS_WAIT() asm volatile("s_waitcnt lgkmcnt(0)" ::: "memory")
#define VM_WAIT() asm volatile("s_waitcnt vmcnt(0)" ::: "memory")

__device__ __forceinline__ float bf2f(bf16 v) { return __uint_as_float(((unsigned)v) << 16); }
__device__ __forceinline__ unsigned f2bf(float f) { unsigned u = __builtin_bit_cast(unsigned, f); return (u + 0x7fffu + ((u >> 16) & 1u)) >> 16; }
__device__ __forceinline__ unsigned cvt_pk(float lo, float hi) { unsigned r; asm("v_cvt_pk_bf16_f32 %0, %1, %2" : "=v"(r) : "v"(lo), "v"(hi)); return r; }
__device__ __forceinline__ unsigned pk2(float lo, float hi) { return cvt_pk(lo, hi); }
__device__ __forceinline__ v4u pk8(f32x4 a, f32x4 b) { v4u w; w.x = pk2(a[0], a[1]); w.y = pk2(a[2], a[3]); w.z = pk2(b[0], b[1]); w.w = pk2(b[2], b[3]); return w; }
__device__ __forceinline__ float wave_sum(float v) {
#pragma unroll
    for (int o = 1; o < 64; o <<= 1) v += __shfl_xor(v, o);
    return v;
}
__device__ __forceinline__ float wave_max(float v) {
#pragma unroll
    for (int o = 1; o < 64; o <<= 1) v = fmaxf(v, __shfl_xor(v, o));
    return v;
}
__device__ __forceinline__ float sigmoidf_(float x) { return __builtin_amdgcn_rcpf(1.f + __builtin_amdgcn_exp2f(-1.4426950408889634f * x)); }
__device__ __forceinline__ float gelu_tanh(float x) { constexpr float K1 = -2.f * 0.7978845608028654f * 1.4426950408889634f, K2 = K1 * 0.044715f;
    const float t = x * __builtin_fmaf(x * x, K2, K1); return x * __builtin_amdgcn_rcpf(1.f + __builtin_amdgcn_exp2f(t)); }
__device__ __forceinline__ float gelu_tanh_div(float x) { const float y = 0.7978845608028654f * (x + 0.044715f * x * x * x); return x / (1.f + __expf(-2.f * y)); }
__device__ __forceinline__ f32x4 ld4(const float* p) { return *(const f32x4*)p; }
__device__ __forceinline__ void st4(float* p, f32x4 v) { *(f32x4*)p = v; }
constexpr size_t O_YP = 0, O_YS = O_YP + (size_t)MP * DM, O_KVP = O_YS + (size_t)MS * DM, O_KVS = O_KVP + (size_t)MP * 1024, O_WINP = O_KVS + (size_t)MS * 1024,
                 O_WINS = O_WINP + (size_t)NB * 512 * 512, O_SREP = O_WINS + (size_t)DB * 512 * 512, O_SIMP = O_SREP + NB * 64 * 64, O_SRES = O_SIMP + NB * 64 * 64,
                 O_SIMS = O_SRES + (size_t)DB * 64 * 64, O_CONVP = O_SIMS + (size_t)DB * 64 * 64, O_CONVS = O_CONVP + 2 * NB * 2 * FF, O_END = O_CONVS + (size_t)2 * DB * 2 * FF;
static_assert(O_END == 72259584, "output size");
__device__ __forceinline__ int mk_lane() { int l; asm volatile("v_mbcnt_lo_u32_b32 %0, -1, 0\n\tv_mbcnt_hi_u32_b32 %0, -1, %0" : "=v"(l)); return l & 63; }
__device__ __forceinline__ void unpk8(v4u w, f32x4& a, f32x4& b) { a[0] = __uint_as_float(w.x << 16); a[1] = __uint_as_float(w.x & 0xffff0000u); a[2] = __uint_as_float(w.y << 16); a[3] = __uint_as_float(w.y & 0xffff0000u);
    b[0] = __uint_as_float(w.z << 16); b[1] = __uint_as_float(w.z & 0xffff0000u); b[2] = __uint_as_float(w.w << 16); b[3] = __uint_as_float(w.w & 0xffff0000u); }
__device__ __forceinline__ v4u pk8c(f32x4 a, f32x4 b) { v4u w; w.x = cvt_pk(a[0], a[1]); w.y = cvt_pk(a[2], a[3]); w.z = cvt_pk(b[0], b[1]); w.w = cvt_pk(b[2], b[3]); return w; }
#define MK_ONE_LAUNCH 1
namespace pg8 {
#define PG8_LAS __attribute__((address_space(3)))
typedef unsigned short bf16_t;
typedef short bf16x8 __attribute__((ext_vector_type(8)));
typedef float f32x4 __attribute__((ext_vector_type(4)));
typedef unsigned u32x4 __attribute__((ext_vector_type(4)));
constexpr int BM = 256, BK = 64, HALF = 128, HTB = HALF * BK * 2  , STAGE_BYTES = 8 * HTB, NXCD = 8, WGM = 8;

__host__ __device__ __forceinline__ int lds_byte(int r, int c) { const int st = (r >> 4) * 2 + (c >> 5), rr = r & 15, cc = c & 31, ob = rr * 64 + cc * 2; return st * 1024 + (ob ^ (((ob >> 9) & 1) << 5)); }
__host__ __device__ __forceinline__ void stage_rc(int b, int& R, int& C) { const int st = b / 1024, sb = b % 1024, swz = sb ^ (((sb >> 9) & 1) << 5); R = (st >> 1) * 16 + swz / 64; C = (st & 1) * 32 + (swz % 64) / 2; }
__host__ __device__ __forceinline__ int perm32(int rho) { const int n = rho >> 4, i = rho & 15; return 8 * (i >> 2) + 4 * n + (i & 3); }

struct Unit { int pm, pn; };
struct Gemm { const bf16_t* A; const bf16_t* Bt; int M, N, K; };

struct StaticOrder {
    int nM, nN, nwg, G, c;
    __host__ __device__ void init(int M, int N, int G_, int c_) { nM = M / BM; nN = N / BM; nwg = nM * nN; G = G_; c = c_; }
    __host__ __device__ __forceinline__ bool next(int i, Unit& u) const {
        const long L = (long)i * G + c; if (L >= nwg) return false;
        int wgid = (int)L; { const int q = nwg / NXCD, r = nwg % NXCD, xcd = wgid % NXCD, off = wgid / NXCD; wgid = (xcd < r ? xcd * (q + 1) : r * (q + 1) + (xcd - r) * q) + off; }
        const int nig = WGM * nN, gid = wgid / nig, fm = gid * WGM, gsz = (nM - fm) < WGM ? (nM - fm) : WGM;
        u.pm = fm + ((wgid % nig) % gsz); u.pn = (wgid % nig) / gsz; return true;
    }
    __device__ __forceinline__ void a_ready(const Unit&) const {}
    __device__ __forceinline__ void done(const Unit&) const {}
};

__device__ __forceinline__ unsigned cvt_pk_bf16(float lo, float hi) { unsigned r; asm volatile("v_cvt_pk_bf16_f32 %0, %1, %2" : "=v"(r) : "v"(lo), "v"(hi)); return r; }
template <class Epi, class Sched, bool ALIGN_EPI = false, bool SP2 = false>
__device__ __forceinline__ void gemm_phase(PG8_LAS unsigned char* lds, const Gemm g, const Sched& S, const Epi& E, const int wid) {
    const int lane = mk_lane(), tid = wid * 64 + lane, wr = wid >> 2, wc = wid & 3, fr = lane & 15, fq = lane >> 4;
    const int K = g.K, nt = K / BK;
    unsigned voffA[2], voffB[2];
#pragma unroll
    for (int i = 0; i < 2; ++i) { int R, C; stage_rc(tid * 16 + i * 8192, R, C); const int Rb = Epi::PERM ? ((R & ~31) + perm32(R & 31)) : R;
        voffA[i] = (unsigned)(R * K + C) * 2u; voffB[i] = (unsigned)(Rb * K + C) * 2u; }
    const size_t kstep = (size_t)(BK * 2);
    const size_t hstep = (size_t)HALF * K * 2;
    const size_t tstep = 2 * hstep;
    const unsigned ldsw = (unsigned)wid * 1024u;
    const int aoff = lds_byte(wr * 64 + fr, fq * 8), boff = lds_byte(wc * 32 + fr, fq * 8);
#define PG8_SA(b, h) (((b) * 2 + (h)) * HTB)
#define PG8_SB(b, h) ((4 + (b) * 2 + (h)) * HTB)
#define PG8_STAGE(bufoff, gbase, voff) do { _Pragma("unroll") for (int _i = 0; _i < 2; ++_i) \
        __builtin_amdgcn_global_load_lds((const unsigned*)((const char*)(gbase) + (voff)[_i]), (PG8_LAS unsigned*)(lds + (bufoff) + ldsw + _i * 8192), 16, 0, 0); } while (0)
#define PG8_LDA(dst, b, h) do { _Pragma("unroll") for (int m = 0; m < 4; ++m) _Pragma("unroll") for (int k = 0; k < 2; ++k) dst[m][k] = *(const PG8_LAS bf16x8*)(lds + PG8_SA(b, h) + aoff + m * 2048 + k * 1024); } while (0)
#define PG8_LDB(dst, b, h) do { _Pragma("unroll") for (int n = 0; n < 2; ++n) _Pragma("unroll") for (int k = 0; k < 2; ++k) dst[n][k] = *(const PG8_LAS bf16x8*)(lds + PG8_SB(b, h) + boff + n * 2048 + k * 1024); } while (0)
#define PG8_MMA(ai, bj, At, Bt) do { __builtin_amdgcn_s_setprio(1); _Pragma("unroll") for (int m = 0; m < 4; ++m) _Pragma("unroll") for (int n = 0; n < 2; ++n) _Pragma("unroll") for (int k = 0; k < 2; ++k) \
        acc[ai][bj][m][n] = __builtin_amdgcn_mfma_f32_16x16x32_bf16(Bt[n][k], At[m][k], acc[ai][bj][m][n], 0, 0, 0); __builtin_amdgcn_s_setprio(0); } while (0)
#define PG8_WAIT_V(n) asm volatile("s_waitcnt vmcnt(" #n ")" ::: "memory")
#define PG8_WAIT_L(n) asm volatile("s_waitcnt lgkmcnt(" #n ")" ::: "memory")
#define PG8_BAR __builtin_amdgcn_s_barrier()
#define PG8_SCHED __builtin_amdgcn_sched_barrier(0)
    Unit cur, nxt; int ui = 0;
    if (!S.next(0, cur)) return;
    f32x4 acc[2][2][4][2];
#pragma unroll
    for (int a = 0; a < 2; ++a)
#pragma unroll
        for (int b = 0; b < 2; ++b)
#pragma unroll
            for (int m = 0; m < 4; ++m)
#pragma unroll
                for (int n = 0; n < 2; ++n) acc[a][b][m][n] = (f32x4){0.f, 0.f, 0.f, 0.f};
    bf16x8 At[4][2], B0[2][2], B1[2][2];
    const char* cA = (const char*)g.A + (size_t)cur.pm * tstep; const char* cB = (const char*)g.Bt + (size_t)cur.pn * tstep;
    S.a_ready(cur);
    if constexpr (SP2) {
        PG8_STAGE(PG8_SB(0, 0), cB, voffB); PG8_STAGE(PG8_SB(0, 1), cB + hstep, voffB); PG8_STAGE(PG8_SA(0, 0), cA, voffA); PG8_STAGE(PG8_SA(0, 1), cA + hstep, voffA);
        if (wr == 1) PG8_BAR;
        PG8_WAIT_V(2); PG8_BAR;
        PG8_STAGE(PG8_SB(1, 0), cB + kstep, voffB); PG8_STAGE(PG8_SA(1, 0), cA + kstep, voffA); PG8_STAGE(PG8_SB(1, 1), cB + hstep + kstep, voffB);
        PG8_WAIT_V(6); PG8_BAR;
    } else {
        PG8_STAGE(PG8_SB(0, 0), cB, voffB); PG8_STAGE(PG8_SA(0, 0), cA, voffA); PG8_STAGE(PG8_SB(0, 1), cB + hstep, voffB); PG8_STAGE(PG8_SA(0, 1), cA + hstep, voffA);
        if (wr == 1) PG8_BAR;
        PG8_WAIT_V(4); PG8_BAR;
        PG8_STAGE(PG8_SB(1, 0), cB + kstep, voffB); PG8_STAGE(PG8_SA(1, 0), cA + kstep, voffA); PG8_STAGE(PG8_SB(1, 1), cB + hstep + kstep, voffB);
        PG8_WAIT_V(6); PG8_BAR;
    }
    for (;;) {
        const bool has_next = S.next(ui + 1, nxt);
        const char* nA = has_next ? (const char*)g.A + (size_t)nxt.pm * tstep : cA; const char* nB = has_next ? (const char*)g.Bt + (size_t)nxt.pn * tstep : cB;
        for (int t = 0; t < nt; t += 2) {
            const bool last = (t == nt - 2);
            const char* a1 = cA + (size_t)(t + 1) * kstep;
            const char* a2 = last ? nA : cA + (size_t)(t + 2) * kstep; const char* b2 = last ? nB : cB + (size_t)(t + 2) * kstep;
            const char* a3 = a2 + kstep; const char* b3 = b2 + kstep;
            if (last && has_next) S.a_ready(nxt);
            if constexpr (SP2) {
            PG8_LDB(B0, 0, 0); PG8_LDB(B1, 0, 1); PG8_SCHED; PG8_LDA(At, 0, 0); PG8_STAGE(PG8_SA(1, 1), a1 + hstep, voffA);
            PG8_WAIT_V(8); PG8_WAIT_L(0); PG8_BAR; PG8_MMA(0, 0, At, B0); PG8_MMA(0, 1, At, B1); PG8_BAR; PG8_SCHED;
            PG8_LDA(At, 0, 1); PG8_STAGE(PG8_SB(0, 0), b2, voffB); PG8_STAGE(PG8_SB(0, 1), b2 + hstep, voffB); PG8_STAGE(PG8_SA(0, 0), a2, voffA);
            PG8_WAIT_V(8); PG8_WAIT_L(0); PG8_BAR; PG8_MMA(1, 0, At, B0); PG8_MMA(1, 1, At, B1); PG8_BAR; PG8_SCHED;
            PG8_LDB(B0, 1, 0); PG8_LDB(B1, 1, 1); PG8_SCHED; PG8_LDA(At, 1, 0); PG8_STAGE(PG8_SA(0, 1), a2 + hstep, voffA);
            PG8_WAIT_V(8); PG8_WAIT_L(0); PG8_BAR; PG8_MMA(0, 0, At, B0); PG8_MMA(0, 1, At, B1); PG8_BAR; PG8_SCHED;
            PG8_LDA(At, 1, 1); PG8_STAGE(PG8_SB(1, 0), b3, voffB); PG8_STAGE(PG8_SB(1, 1), b3 + hstep, voffB); PG8_STAGE(PG8_SA(1, 0), a3, voffA);
            PG8_WAIT_V(8); PG8_WAIT_L(0); PG8_BAR; PG8_MMA(1, 0, At, B0); PG8_MMA(1, 1, At, B1); PG8_BAR; PG8_SCHED;
            } else {
            PG8_LDB(B0, 0, 0); PG8_SCHED; PG8_LDA(At, 0, 0); PG8_STAGE(PG8_SA(1, 1), a1 + hstep, voffA);
            PG8_WAIT_L(8); PG8_BAR; PG8_WAIT_L(0); PG8_MMA(0, 0, At, B0); PG8_BAR; PG8_SCHED;
            PG8_LDB(B1, 0, 1); PG8_STAGE(PG8_SB(0, 0), b2, voffB);
            PG8_BAR; PG8_WAIT_L(0); PG8_MMA(0, 1, At, B1); PG8_BAR;
            PG8_LDA(At, 0, 1); PG8_STAGE(PG8_SA(0, 0), a2, voffA);
            PG8_BAR; PG8_WAIT_L(0); PG8_MMA(1, 0, At, B0); PG8_BAR; PG8_SCHED;
            PG8_STAGE(PG8_SB(0, 1), b2 + hstep, voffB);
            PG8_WAIT_V(6); PG8_BAR; PG8_MMA(1, 1, At, B1); PG8_BAR;
            PG8_LDB(B0, 1, 0); PG8_SCHED; PG8_LDA(At, 1, 0); PG8_STAGE(PG8_SA(0, 1), a2 + hstep, voffA);
            PG8_WAIT_L(8); PG8_BAR; PG8_WAIT_L(0); PG8_MMA(0, 0, At, B0); PG8_BAR; PG8_SCHED;
            PG8_LDB(B1, 1, 1); PG8_STAGE(PG8_SB(1, 0), b3, voffB);
            PG8_BAR; PG8_WAIT_L(0); PG8_MMA(0, 1, At, B1); PG8_BAR;
            PG8_LDA(At, 1, 1); PG8_STAGE(PG8_SA(1, 0), a3, voffA);
            PG8_BAR; PG8_WAIT_L(0); PG8_MMA(1, 0, At, B0); PG8_BAR; PG8_SCHED;
            PG8_STAGE(PG8_SB(1, 1), b3 + hstep, voffB);
            PG8_WAIT_V(6); PG8_BAR; PG8_MMA(1, 1, At, B1); PG8_BAR;
            }
        }
        if constexpr (ALIGN_EPI) { if (wr == 0) PG8_BAR; }
        if constexpr (!Epi::AFTER_DRAIN) { E(acc, cur, wr, wc, fr, fq); S.done(cur); }
        if (!has_next) break;
#pragma unroll
        for (int a = 0; a < 2; ++a)
#pragma unroll
            for (int b = 0; b < 2; ++b)
#pragma unroll
                for (int m = 0; m < 4; ++m)
#pragma unroll
                    for (int n = 0; n < 2; ++n) acc[a][b][m][n] = (f32x4){0.f, 0.f, 0.f, 0.f};
        cur = nxt; cA = nA; cB = nB; ++ui;
        if constexpr (ALIGN_EPI) { if (wr == 1) PG8_BAR; }
    }
    PG8_WAIT_V(0);
    if constexpr (!ALIGN_EPI) { if (wr == 0) PG8_BAR; }
    PG8_BAR;
    if constexpr (Epi::AFTER_DRAIN) { E.fused(acc, cur, wr, wc, fr, fq, lds, wid, lane); S.done(cur); }
#undef PG8_SA
#undef PG8_SB
#undef PG8_STAGE
#undef PG8_LDA
#undef PG8_LDB
#undef PG8_MMA
#undef PG8_WAIT_V
#undef PG8_WAIT_L
#undef PG8_BAR
#undef PG8_SCHED
}
}

#define XB_TMO      128
#define XB_XCNT(j)  (256  + 64 * (j))
#define XB_XSUB(j)  (1280 + 64 * (j))
#define XB_XGEN(j)  (2304 + 64 * (j))
#define XB_TOP      3328
#define XB_TOPGEN   3392
#define XCD_BAR_WORDS 3456
#define XB_SPIN_CAP (1u << 18)

__device__ __forceinline__ unsigned xb_ld(unsigned* p)              { return __hip_atomic_load(p, __ATOMIC_RELAXED, __HIP_MEMORY_SCOPE_AGENT); }
__device__ __forceinline__ unsigned xb_add(unsigned* p, unsigned v) { return __hip_atomic_fetch_add(p, v, __ATOMIC_RELAXED, __HIP_MEMORY_SCOPE_AGENT); }
__device__ __forceinline__ unsigned xb_xcc_id() { return (unsigned)__builtin_amdgcn_s_getreg((3 << 11) | 20) & 0xFu; }
#define XB_SPIN(cond, bar) do { unsigned _sp = 0; while (cond) { __builtin_amdgcn_s_sleep(1); \
    if ((++_sp & 255u) == 0u) { if (xb_ld(&(bar)[XB_TMO])) break; if (_sp > XB_SPIN_CAP) { atomicAdd(&(bar)[XB_TMO], 1u); break; } } } } while (0)

struct XcdBarrier {
    unsigned* bar; unsigned x; unsigned wid;
    volatile LAS unsigned* st;
};

__device__ __forceinline__ XcdBarrier xcd_barrier_post(unsigned* bar, volatile LAS unsigned* st, unsigned wid) {
    XcdBarrier b; b.bar = bar; b.x = xb_xcc_id(); b.st = st; b.wid = wid;
    if (wid == 0u && mk_lane() == 0) (void)xb_add(&bar[XB_XCNT(b.x)], 1u);
    return b;
}
__device__ __forceinline__ void xcd_barrier_complete(unsigned* bar, unsigned x, unsigned& nloc, unsigned& nx) {
    const unsigned G = gridDim.x * gridDim.y * gridDim.z;
    unsigned sum, cnt, mine, sp = 0u;
    for (;;) {
        sum = 0u; cnt = 0u; mine = 0u;
#pragma unroll
        for (unsigned j = 0; j < 16; ++j) { const unsigned c = xb_ld(&bar[XB_XCNT(j)]); sum += c; cnt += (c > 0u) ? 1u : 0u; mine = (j == x) ? c : mine; }
        if (sum == G) break;
        __builtin_amdgcn_s_sleep(1);
        if ((++sp & 255u) == 0u) { if (xb_ld(&bar[XB_TMO])) break; if (sp > XB_SPIN_CAP) { atomicAdd(&bar[XB_TMO], 1u); break; } }
    }
    nloc = mine > 0u ? mine : 1u; nx = cnt > 0u ? cnt : 1u;
}

__device__ __forceinline__ void xcd_barrier(const XcdBarrier& b) {
    asm volatile("s_waitcnt vmcnt(0)" ::: "memory");
    __syncthreads();
    if (b.wid == 0u && mk_lane() == 0) {
        unsigned* bar = b.bar;
        __builtin_amdgcn_s_waitcnt(0);
        unsigned nloc = b.st[0], nx = b.st[1];
        if (nloc == 0u) { xcd_barrier_complete(bar, b.x, nloc, nx); b.st[0] = nloc; b.st[1] = nx; }
        const unsigned old = xb_add(&bar[XB_XSUB(b.x)], 1u);
        const unsigned gen = old / nloc;
        if (old + 1u == (gen + 1u) * nloc) {
            __builtin_amdgcn_fence(__ATOMIC_RELEASE, "agent");
            asm volatile("s_waitcnt vmcnt(0)" ::: "memory");
            const unsigned og = xb_add(&bar[XB_TOP], 1u);
            const unsigned tg = og / nx;
            if (og + 1u == (tg + 1u) * nx) xb_add(&bar[XB_TOPGEN], 1u);
            else XB_SPIN(xb_ld(&bar[XB_TOPGEN]) == tg, bar);
            __builtin_amdgcn_fence(__ATOMIC_ACQUIRE, "agent");
            xb_add(&bar[XB_XGEN(b.x)], 1u);
            asm volatile("s_waitcnt vmcnt(0)" ::: "memory");
        } else {
            XB_SPIN(xb_ld(&bar[XB_XGEN(b.x)]) == gen, bar);
            __builtin_amdgcn_fence(__ATOMIC_ACQUIRE, "agent");
            asm volatile("s_waitcnt vmcnt(0)" ::: "memory");
        }
    }
    __syncthreads();
}

constexpr float LOG2E = 1.4426950408889634f;
constexpr float QSCALE = 0.125f * LOG2E;
typedef const f32x4 (&AccRef)[2][2][4][2];
using pg8::Unit;

struct EpiAttnIn {
    static constexpr bool PERM = true, AFTER_DRAIN = false;
    unsigned char* ws; float* out;
    __device__ __forceinline__ void operator()(AccRef acc, const Unit& u, int wr, int wc, int fr, int fq) const {
        const int pn = u.pn;
        const float* ss = (const float*)(ws + WS_CTL) + CW_SS;
        const int rbase = u.pm * 256 + wr * 64 + fr, cw = wc * 32 + 8 * fq;
#define EAI_LOOP(...) _Pragma("unroll") for (int ai = 0; ai < 2; ++ai) _Pragma("unroll") for (int m = 0; m < 4; ++m) { const int r = rbase + ai * 128 + m * 16; const float rstd = rsqrtf(ss[r] * (1.f / DM) + EPS); \
            _Pragma("unroll") for (int bj = 0; bj < 2; ++bj) { const f32x4 v0 = acc[ai][bj][m][0] * rstd, v1 = acc[ai][bj][m][1] * rstd; __VA_ARGS__ } asm volatile("" ::: "memory"); }
        if (pn < 4) {
            bf16* Qb = (bf16*)(ws + WS_QB) + pn * 256 + cw;
            EAI_LOOP({ *(v4u*)(Qb + (size_t)r * DM + bj * 128) = pk8(v0 * QSCALE, v1 * QSCALE); })
        } else if (pn < 8) {
            const int cc0 = (pn - 4) * 256 + cw;
            bf16* KVb = (bf16*)(ws + WS_KVB) + cc0; bf16* cmpa = (bf16*)(ws + WS_CMPA);
            float* okv = (rbase < MP) ? out + O_KVP + cc0 : out + O_KVS - (size_t)MP * 1024 + cc0;
            EAI_LOOP({ float* o = okv + (size_t)r * 1024 + bj * 128; st4(o, v0); st4(o + 4, v1);
                const v4u w = pk8(v0, v1); *(v4u*)(KVb + (size_t)r * 1024 + bj * 128) = w;
                if (pn < 6 && r < MP) { const int cc = cc0 + bj * 128; const int c = pn - 4, g = (cc & 255) >> 6, d = cc & 63, b = r >> 13, t = r & 8191, mb = t >> 4, l = t & 15;
                    *(v4u*)(cmpa + ((((size_t)(c * NB + b) * 512 + mb) * NG + g) * 16 + l) * 64 + d) = w; }
                if (pn >= 6 && r >= MP) { const int rs = r - MP; *(v4u*)((bf16*)(ws + WS_SELS) + ((size_t)(rs >> 3) * (PAST + DS) + PAST + (rs & 7)) * 512 + (cc0 - 512) + bj * 128) = w; } })
        } else if (pn < 10) {
            const int cc0 = (pn - 8) * 256 + cw;
            bf16* WINb = (bf16*)(ws + WS_WINB) + cc0;
            EAI_LOOP({ const int cc = cc0 + bj * 128; const v4u w = pk8(v0, v1); *(v4u*)(WINb + (size_t)r * 512 + bj * 128) = w;
                if (r >= MP) { const int rs = r - MP; *(v4u*)((bf16*)(ws + WS_WINS) + ((size_t)(rs >> 3) * 520 + 512 + (rs & 7)) * 512 + cc) = w; }
                if (r < MP) { const int t = r & 8191; if (t >= SEQ - 512) { float* o = out + O_WINP + ((size_t)(r >> 13) * 512 + (t - (SEQ - 512))) * 512 + cc; st4(o, v0); st4(o + 4, v1); } }
                else { const int rs = r - MP, s = rs >> 3, t = rs & 7; float* o = out + O_WINS + ((size_t)s * 512 + 504 + t) * 512 + cc; st4(o, v0); st4(o + 4, v1); } })
        } else {
            float* gates = (float*)(ws + WS_GATES);
            EAI_LOOP({ const int cc = bj * 128 + cw; if (cc < 48) { float* o = gates + (size_t)r * 48 + cc;
                f32x4 a, b2; a[0] = sigmoidf_(v0[0]); a[1] = sigmoidf_(v0[1]); a[2] = sigmoidf_(v0[2]); a[3] = sigmoidf_(v0[3]);
                b2[0] = sigmoidf_(v1[0]); b2[1] = sigmoidf_(v1[1]); b2[2] = sigmoidf_(v1[2]); b2[3] = sigmoidf_(v1[3]); st4(o, a); st4(o + 4, b2); } })
        }
#undef EAI_LOOP
    }
};

struct EpiPlain {
    static constexpr bool PERM = true, AFTER_DRAIN = false;
    bf16* O; int ldc;
    __device__ __forceinline__ void operator()(AccRef acc, const Unit& u, int wr, int wc, int fr, int fq) const {
#pragma unroll
        for (int ai = 0; ai < 2; ++ai)
#pragma unroll
            for (int m = 0; m < 4; ++m) {
                const int r = u.pm * 256 + ai * 128 + wr * 64 + m * 16 + fr;
#pragma unroll
                for (int bj = 0; bj < 2; ++bj) { const int c0 = u.pn * 256 + bj * 128 + wc * 32 + 8 * fq; *(v4u*)(O + (size_t)r * ldc + c0) = pk8(acc[ai][bj][m][0], acc[ai][bj][m][1]); }
            }
    }
};

__device__ __forceinline__ void ss_accum(float* ssout, int r, float s, int fq) {
    s += __shfl_xor(s, 16); s += __shfl_xor(s, 32);
    if (fq == 0) atomicAdd(ssout + r, s);
}

struct EpiResid {
    static constexpr bool PERM = true, AFTER_DRAIN = false;
    const bf16* XI; bf16* XO; float* ssout;
    __device__ __forceinline__ void operator()(AccRef acc, const Unit& u, int wr, int wc, int fr, int fq) const {
#pragma unroll
        for (int ai = 0; ai < 2; ++ai)
#pragma unroll
            for (int m = 0; m < 4; ++m) {
                const int r = u.pm * 256 + ai * 128 + wr * 64 + m * 16 + fr;
                float s = 0.f;
#pragma unroll
                for (int bj = 0; bj < 2; ++bj) {
                    const int c0 = u.pn * 256 + bj * 128 + wc * 32 + 8 * fq;
                    f32x4 v0, v1; unpk8(*(const v4u*)(XI + (size_t)r * DM + c0), v0, v1); v0 += acc[ai][bj][m][0]; v1 += acc[ai][bj][m][1];
                    *(v4u*)(XO + (size_t)r * DM + c0) = pk8c(v0, v1);
                    s += (v0[0] * v0[0] + v0[1] * v0[1]) + (v0[2] * v0[2] + v0[3] * v0[3]) + (v1[0] * v1[0] + v1[1] * v1[1]) + (v1[2] * v1[2] + v1[3] * v1[3]);
                }
                ss_accum(ssout, r, s, fq);
            }
    }
};

template <int CTRL> __device__ __forceinline__ float dppf(float v) { return __uint_as_float((unsigned)__builtin_amdgcn_update_dpp(0, (int)__float_as_uint(v), CTRL, 0xf, 0xf, false)); }
template <int CTRL> __device__ __forceinline__ f32x4 dpp4(f32x4 v) { f32x4 r; r[0] = dppf<CTRL>(v[0]); r[1] = dppf<CTRL>(v[1]); r[2] = dppf<CTRL>(v[2]); r[3] = dppf<CTRL>(v[3]); return r; }
__device__ __forceinline__ f32x4 sel4(bool c, f32x4 a, f32x4 b) { f32x4 r; r[0] = c ? a[0] : b[0]; r[1] = c ? a[1] : b[1]; r[2] = c ? a[2] : b[2]; r[3] = c ? a[3] : b[3]; return r; }
__device__ __forceinline__ f32x4 gelu4(f32x4 v) { f32x4 r; r[0] = gelu_tanh(v[0]); r[1] = gelu_tanh(v[1]); r[2] = gelu_tanh(v[2]); r[3] = gelu_tanh(v[3]); return r; }
constexpr int XCH_OFF = RING_BYTES;
struct EpiUpFused {
    static constexpr bool PERM = true, AFTER_DRAIN = false;
    unsigned char* ws; float* out; const float* cw; const float* cb; const float* sconv; int layer; LAS unsigned char* lds;
    __device__ __forceinline__ void operator()(AccRef acc, const Unit& u, int wr, int wc, int fr, int fq) const {
        const float* ss = (const float*)(ws + WS_CTL) + CW_SS + (size_t)(layer ? 4 : 1) * M;
        bf16* ACT = (bf16*)(ws + WS_ACT); float* haloA = (float*)(ws + WS_HALOA); float* haloB = (float*)(ws + WS_HALOB);
        LAS float* xch = (LAS float*)(lds + XCH_OFF);
        const int j0 = u.pn * 128 + wc * 32 + 8 * fq;
        const f32x4 w0a = ld4(cw + j0), w0b = ld4(cw + j0 + 4), w1a = ld4(cw + FF + j0), w1b = ld4(cw + FF + j0 + 4), w2a = ld4(cw + 2 * FF + j0), w2b = ld4(cw + 2 * FF + j0 + 4), bba = ld4(cb + j0), bbb = ld4(cb + j0 + 4);
        const int rs0 = u.pm * 256 + wr * 64 + fr;
        const bool sample = u.pm >= MP / 256;
        if (fr >= 14) {
#pragma unroll
            for (int ai = 0; ai < 2; ++ai) { const int r = rs0 + ai * 128 + 48; const float rstd = rsqrtf(ss[r] * (1.f / DM) + EPS);
                LAS float* d = xch + ((((ai * 2 + wr) * 4 + wc) * 2 + (fr - 14)) * 32) + 8 * fq;
                *(LAS f32x4*)d = acc[ai][0][3][0] * rstd; *(LAS f32x4*)(d + 4) = acc[ai][0][3][1] * rstd; }
        }
        asm volatile("s_waitcnt lgkmcnt(0)" ::: "memory"); __builtin_amdgcn_s_barrier(); asm volatile("" ::: "memory");
#pragma unroll
        for (int ai = 0; ai < 2; ++ai) {
            f32x4 hpa = {0.f, 0.f, 0.f, 0.f}, hpb = {0.f, 0.f, 0.f, 0.f};
            const bool first = (ai == 0 && wr == 0);
            if (!first && fr >= 14) { const int sa = wr ? ai : ai - 1, sw = wr ? 0 : 1;
                const LAS float* s = xch + ((((sa * 2 + sw) * 4 + wc) * 2 + (fr - 14)) * 32) + 8 * fq; hpa = *(const LAS f32x4*)s; hpb = *(const LAS f32x4*)(s + 4); }
            const bool defer = first && !sample && (u.pm & 31) != 0;
#pragma unroll
            for (int m = 0; m < 4; ++m) {
                const int r = rs0 + ai * 128 + m * 16; const float rstd = rsqrtf(ss[r] * (1.f / DM) + EPS);
                const f32x4 ha = acc[ai][0][m][0] * rstd, hb = acc[ai][0][m][1] * rstd, ga = acc[ai][1][m][0] * rstd, gb = acc[ai][1][m][1] * rstd;
                f32x4 p1a, p1b, p2a, p2b;
                if (!sample) {
                    p1a = sel4(fr == 0, dpp4<0x121>(hpa), dpp4<0x121>(ha)); p1b = sel4(fr == 0, dpp4<0x121>(hpb), dpp4<0x121>(hb));
                    p2a = sel4(fr < 2, dpp4<0x122>(hpa), dpp4<0x122>(ha)); p2b = sel4(fr < 2, dpp4<0x122>(hpb), dpp4<0x122>(hb));
                } else {
                    const int t = fr & 7; const float* sc = sconv + (size_t)((r - MP) >> 3) * 2 * FF + j0;
                    f32x4 s0a = {0.f, 0.f, 0.f, 0.f}, s0b = s0a, s1a = s0a, s1b = s0a;
                    if (t < 2) { s1a = ld4(sc + FF); s1b = ld4(sc + FF + 4); if (t == 0) { s0a = ld4(sc); s0b = ld4(sc + 4); } }
                    p1a = sel4(t >= 1, dpp4<0x121>(ha), s1a); p1b = sel4(t >= 1, dpp4<0x121>(hb), s1b);
                    p2a = sel4(t >= 2, dpp4<0x122>(ha), sel4(t == 1, s1a, s0a)); p2b = sel4(t >= 2, dpp4<0x122>(hb), sel4(t == 1, s1b, s0b));
                }
                if (defer && m == 0 && fr < 2) {
                    float* d = haloA + ((size_t)(u.pm * 2 + fr) * 2) * FF + j0; st4(d, ha); st4(d + 4, hb); st4(d + FF, ga); st4(d + FF + 4, gb);
                } else {
                    const f32x4 oa = gelu4(bba + w0a * p2a + w1a * p1a + w2a * ha) * ga, ob = gelu4(bbb + w0b * p2b + w1b * p1b + w2b * hb) * gb;
                    *(v4u*)(ACT + (size_t)r * FF + j0) = pk8(oa, ob);
                }
                if (!sample) { const int t = r & 8191; if (t >= SEQ - 2) { float* o = out + O_CONVP + ((size_t)(layer * NB + (r >> 13)) * 2 + (t - (SEQ - 2))) * FF + j0; st4(o, ha); st4(o + 4, hb); }
                    if (ai == 1 && wr == 1 && m == 3 && fr >= 14) { float* d = haloB + (size_t)(u.pm * 2 + (fr - 14)) * FF + j0; st4(d, ha); st4(d + 4, hb); } }
                else { const int rs = r - MP, t = rs & 7; if (t >= 6) { float* o = out + O_CONVS + ((size_t)(layer * DB + (rs >> 3)) * 2 + (t - 6)) * FF + j0; st4(o, ha); st4(o + 4, hb); } }
                hpa = ha; hpb = hb;
            }
        }
    }
};
__device__ __forceinline__ void up_fix(unsigned char* ws, const float* cw, const float* cb, int pm, int tid) {
    const float* haloA = (const float*)(ws + WS_HALOA) + (size_t)pm * 4 * FF; const float* haloB = (const float*)(ws + WS_HALOB) + (size_t)(pm - 1) * 2 * FF; bf16* ACT = (bf16*)(ws + WS_ACT) + (size_t)pm * 256 * FF;
    for (int j = tid; j < FF; j += NWAVES * 64) {
        const float hm2 = haloB[j], hm1 = haloB[FF + j], h0 = haloA[j], g0 = haloA[FF + j], h1 = haloA[2 * FF + j], g1 = haloA[3 * FF + j];
        const float w0 = cw[j], w1 = cw[FF + j], w2 = cw[2 * FF + j], bb = cb[j];
        ACT[j] = (bf16)f2bf(gelu_tanh(bb + w0 * hm2 + w1 * hm1 + w2 * h0) * g0);
        ACT[FF + j] = (bf16)f2bf(gelu_tanh(bb + w0 * hm1 + w1 * h0 + w2 * h1) * g1);
    }
}

struct EpiGate {
    static constexpr bool PERM = true, AFTER_DRAIN = false;
    const float* ss; const bf16* PP; const bf16* XI; bf16* XO; float* ssout; bf16* XG;
    __device__ __forceinline__ void operator()(AccRef acc, const Unit& u, int wr, int wc, int fr, int fq) const {
#pragma unroll
        for (int ai = 0; ai < 2; ++ai)
#pragma unroll
            for (int m = 0; m < 4; ++m) {
                const int r = u.pm * 256 + ai * 128 + wr * 64 + m * 16 + fr;
                const float rstd = rsqrtf(ss[r] * (1.f / DM) + EPS);
                float s = 0.f;
#pragma unroll
                for (int bj = 0; bj < 2; ++bj) {
                    const int c0 = u.pn * 256 + bj * 128 + wc * 32 + 8 * fq;
                    f32x4 p0, p1, v0, v1; unpk8(*(const v4u*)(PP + (size_t)r * DM + c0), p0, p1); unpk8(*(const v4u*)(XI + (size_t)r * DM + c0), v0, v1);
                    const f32x4 a0 = acc[ai][bj][m][0] * rstd, a1 = acc[ai][bj][m][1] * rstd;
#pragma unroll
                    for (int e = 0; e < 4; ++e) { v0[e] += p0[e] * sigmoidf_(a0[e]); v1[e] += p1[e] * sigmoidf_(a1[e]); }
                    const v4u wv = pk8c(v0, v1);
                    *(v4u*)(XO + (size_t)r * DM + c0) = wv;
                    if (XG) *(v4u*)(XG + ((size_t)(c0 >> 4) * M + r) * 16 + (c0 & 15)) = wv;
                    s += (v0[0] * v0[0] + v0[1] * v0[1]) + (v0[2] * v0[2] + v0[3] * v0[3]) + (v1[0] * v1[0] + v1[1] * v1[1]) + (v1[2] * v1[2] + v1[3] * v1[3]);
                }
                ss_accum(ssout, r, s, fq);
            }
    }
};

struct EpiGlu {
    static constexpr bool PERM = true, AFTER_DRAIN = false;
    const bf16* XI; bf16* XO; float* ssout;
    __device__ __forceinline__ void operator()(AccRef acc, const Unit& u, int wr, int wc, int fr, int fq) const {
#pragma unroll
        for (int ai = 0; ai < 2; ++ai)
#pragma unroll
            for (int m = 0; m < 4; ++m) {
                const int r = u.pm * 256 + ai * 128 + wr * 64 + m * 16 + fr;
                const int c0 = u.pn * 128 + wc * 32 + 8 * fq;
                f32x4 v0, v1; unpk8(*(const v4u*)(XI + (size_t)r * DM + c0), v0, v1);
                const f32x4 a0 = acc[ai][0][m][0], a1 = acc[ai][0][m][1], b0 = acc[ai][1][m][0], b1 = acc[ai][1][m][1];
#pragma unroll
                for (int e = 0; e < 4; ++e) { v0[e] += a0[e] * sigmoidf_(b0[e]); v1[e] += a1[e] * sigmoidf_(b1[e]); }
                *(v4u*)(XO + (size_t)r * DM + c0) = pk8c(v0, v1);
                const float s = (v0[0] * v0[0] + v0[1] * v0[1]) + (v0[2] * v0[2] + v0[3] * v0[3]) + (v1[0] * v1[0] + v1[1] * v1[1]) + (v1[2] * v1[2] + v1[3] * v1[3]);
                ss_accum(ssout, r, s, fq);
            }
    }
};

struct EpiCmp {
    static constexpr bool PERM = true, AFTER_DRAIN = false;
    float* PBUF;
    __device__ __forceinline__ void operator()(AccRef acc, const Unit& u, int wr, int wc, int fr, int fq) const {
        const int row0 = u.pm * 256;
        const int c = row0 / (CMP_ROWS_S / 2);
#pragma unroll
        for (int ai = 0; ai < 2; ++ai)
#pragma unroll
            for (int m = 0; m < 4; ++m) {
                const int r = row0 + ai * 128 + wr * 64 + m * 16 + fr;
                float* o = PBUF + (size_t)r * 128 + wc * 32 + 8 * fq;
                const f32x4 v0 = c ? acc[ai][1][m][0] : acc[ai][0][m][0], v1 = c ? acc[ai][1][m][1] : acc[ai][0][m][1];
                st4(o, v0); st4(o + 4, v1);
            }
    }
};
struct Args {
    const float* in[34]; const int* page_table; float* out; unsigned char* ws; int ph_lo, ph_hi;
};
static_assert(sizeof(Args) == 34 * 8 + 8 + 8 + 8 + 8, "Args has no padding");
enum { I_XP = 0, I_XS, I_CKV, I_CWIN, I_SRE, I_SIM, I_SCONV, I_PT, I_PP, I_PS, I_NMIX, I_NFFN, I_NPLE, I_NFIN, I_WIN, I_WOUT, I_CPE, I_CW1, I_CW2,
       I_ARE, I_AIM, I_LDT, I_BRE, I_BIM, I_CRE, I_CIM, I_SD, I_WGLU, I_WUP, I_CONVW, I_CONVB, I_WDN, I_WPP, I_WPG };

struct Frame {
    LAS unsigned char* lds;
    int tid, lane, wave, gw, NGW;
    unsigned char* ws; float* out; const float* const* in; const int* pt;
    __device__ __forceinline__ float* SS(int k) const { return (float*)(ws + WS_CTL) + CW_SS + (size_t)k * M; }
};

template <int MODE>
__device__ __forceinline__ void transpose_item(const float* W, int K, int N, int nblk, bf16* WT, const float* gain, LAS float* scr, int item, int lane) {
    const int kb = item / nblk, nb = item % nblk, k0 = 32 * kb, n0 = 128 * nb;
    const int nn = n0 + 4 * (lane & 31);
#pragma unroll 8
    for (int i = 0; i < 16; ++i) { const int kk = 2 * i + (lane >> 5); f32x4 v = {0.f, 0.f, 0.f, 0.f};
        if (nn + 3 < N) v = ld4(W + (size_t)(k0 + kk) * N + nn);
        else { if (nn < N) v[0] = W[(size_t)(k0 + kk) * N + nn]; if (nn + 1 < N) v[1] = W[(size_t)(k0 + kk) * N + nn + 1]; if (nn + 2 < N) v[2] = W[(size_t)(k0 + kk) * N + nn + 2]; }
        if (gain) v = v * gain[k0 + kk];
        *(LAS f32x4*)(scr + kk * 132 + 4 * (lane & 31)) = v; }
    LDS_WAIT(); asm volatile("" ::: "memory");
    const int c4 = lane >> 4;
#pragma unroll
    for (int j = 0; j < 8; ++j) { const int n = (lane & 15) + 16 * j; const LAS float* s = scr + (8 * c4) * 132 + n;
        v4u o; o.x = pk2(s[0 * 132], s[1 * 132]); o.y = pk2(s[2 * 132], s[3 * 132]); o.z = pk2(s[4 * 132], s[5 * 132]); o.w = pk2(s[6 * 132], s[7 * 132]);
        int ns = n0 + n, dr = ns;
        if (MODE == 1) { const int half = ns >> 10, jj = ns & 1023; dr = (jj >> 7) * 256 + half * 128 + (jj & 127); }
        if (MODE == 2) { const int half = ns >= FF ? 1 : 0, jj = ns - half * FF; dr = (jj >> 7) * 256 + half * 128 + (jj & 127); }
        *(v4u*)(WT + (size_t)dr * K + k0 + 8 * c4) = o; }
    LDS_WAIT(); asm volatile("" ::: "memory");
}

__device__ __forceinline__ void p0_prologue(Frame& F) {
    LAS float* scr = (LAS float*)(F.lds + F.wave * WAVE_LDS);
    const int gw = F.gw, NGW = F.NGW, lane = F.lane;
    unsigned char* ws = F.ws;
    {
        constexpr int I_IN = 32 * 22, I_OUT = 32 * 8, I_UP = 32 * 44, I_DN = 88 * 8, I_P = 8 * 8, I_G = 32 * 8, I_GLU = 32 * 16;
        constexpr int NITEMS = I_IN + I_OUT + 2 * I_UP + 2 * I_DN + 2 * I_P + 2 * I_G + I_GLU;
        for (int it = gw; it < NITEMS; it += NGW) {
            int r = it;
            if (r < I_IN) { transpose_item<0>(F.in[I_WIN], DM, NIN, 22, (bf16*)(ws + WS_WIN_T), F.in[I_NMIX], scr, r, lane); continue; } r -= I_IN;
            if (r < I_OUT) { transpose_item<0>(F.in[I_WOUT], DM, DM, 8, (bf16*)(ws + WS_WOUT_T), nullptr, scr, r, lane); continue; } r -= I_OUT;
            if (r < I_UP) { transpose_item<2>(F.in[I_WUP], DM, 2 * FF, 44, (bf16*)(ws + WS_WUP_T0), F.in[I_NFFN], scr, r, lane); continue; } r -= I_UP;
            if (r < I_UP) { transpose_item<2>(F.in[I_WUP] + (size_t)DM * 2 * FF, DM, 2 * FF, 44, (bf16*)(ws + WS_WUP_T1), F.in[I_NFFN] + DM, scr, r, lane); continue; } r -= I_UP;
            if (r < I_DN) { transpose_item<0>(F.in[I_WDN], FF, DM, 8, (bf16*)(ws + WS_WDN_T0), nullptr, scr, r, lane); continue; } r -= I_DN;
            if (r < I_DN) { transpose_item<0>(F.in[I_WDN] + (size_t)FF * DM, FF, DM, 8, (bf16*)(ws + WS_WDN_T1), nullptr, scr, r, lane); continue; } r -= I_DN;
            if (r < I_P) { transpose_item<0>(F.in[I_WPP], PLE, DM, 8, (bf16*)(ws + WS_WP_T0), nullptr, scr, r, lane); continue; } r -= I_P;
            if (r < I_P) { transpose_item<0>(F.in[I_WPP] + (size_t)PLE * DM, PLE, DM, 8, (bf16*)(ws + WS_WP_T1), nullptr, scr, r, lane); continue; } r -= I_P;
            if (r < I_G) { transpose_item<0>(F.in[I_WPG], DM, DM, 8, (bf16*)(ws + WS_WG_T0), F.in[I_NPLE], scr, r, lane); continue; } r -= I_G;
            if (r < I_G) { transpose_item<0>(F.in[I_WPG] + (size_t)DM * DM, DM, DM, 8, (bf16*)(ws + WS_WG_T1), F.in[I_NPLE] + DM, scr, r, lane); continue; } r -= I_G;
            transpose_item<1>(F.in[I_WGLU], DM, 2 * DM, 16, (bf16*)(ws + WS_WGLU_T), nullptr, scr, r, lane);
        }
    }
    {
        bf16* W1rT = (bf16*)(ws + WS_W1R_T); const float* w1 = F.in[I_CW1];
        for (int it = gw; it < 256 * 16; it += NGW) {
            const int np = it >> 4, lp = it & 15, c = np >> 7, a = (np >> 6) & 1, e = np & 63;
            W1rT[(size_t)np * 1024 + lp * 64 + lane] = (bf16)f2bf(w1[(((size_t)c * 32 + 16 * a + lp) * 64 + lane) * 64 + e]);
        }
        float* cvec = (float*)(ws + WS_CVEC); const float* pe = F.in[I_CPE];
        for (int it = gw; it < 128; it += NGW) {
            const int c = it >> 6, e = it & 63; float s = 0.f;
            for (int i = lane; i < 2048; i += 64) s += pe[c * 2048 + i] * w1[((size_t)c * 2048 + i) * 64 + e];
            s = wave_sum(s); if (lane == 0) cvec[it] = s;
        }
    }
    {
        bf16* XB = (bf16*)(ws + WS_XBA); float* ss = F.SS(0);
        for (int r = gw; r < M; r += NGW) {
            const float* xr = (r < MP) ? F.in[I_XP] + (size_t)r * DM : F.in[I_XS] + (size_t)(r - MP) * DM;
            float s = 0.f;
#pragma unroll
            for (int j = 0; j < 4; ++j) { const f32x4 v = ld4(xr + 4 * lane + 256 * j); s += (v[0] * v[0] + v[1] * v[1]) + (v[2] * v[2] + v[3] * v[3]);
                v2u w; w.x = pk2(v[0], v[1]); w.y = pk2(v[2], v[3]); *(v2u*)(XB + (size_t)r * DM + 4 * lane + 256 * j) = w; }
            s = wave_sum(s); if (lane == 0) ss[r] = s;
        }
    }
    for (int it = gw; it < 2 * M; it += NGW) {
        const int i = it / M, r = it % M;
        const float* pr = (r < MP) ? F.in[I_PP] + ((size_t)i * MP + r) * PLE : F.in[I_PS] + ((size_t)i * MS + (r - MP)) * PLE;
        bf16* o = (bf16*)(ws + (i ? WS_PB1 : WS_PB0)) + (size_t)r * PLE;
        const f32x4 v = ld4(pr + 4 * lane); v2u w; w.x = pk2(v[0], v[1]); w.y = pk2(v[2], v[3]); *(v2u*)(o + 4 * lane) = w;
    }
}

__device__ __forceinline__ void p0_stream(Frame& F, int gw, int NGW, int e_lo, int e_hi, bool do_f) {
    const int lane = F.lane;
    unsigned char* ws = F.ws;
    {
        bf16* sels = (bf16*)(ws + WS_SELS); const float* ckv = F.in[I_CKV];
        for (int it = e_lo + gw * 8; it < e_hi; it += NGW * 8) {
            const int s = it >> 11, tok0 = it & 2047;
            const int page = F.pt[s * NPAGES + (tok0 >> 7)];
            const float* src = ckv + ((size_t)page * PAGE + (tok0 & 127)) * 1024 + 512 + 4 * lane;
            f32x4 v[8][2];
#pragma unroll
            for (int j = 0; j < 8; ++j) { v[j][0] = __builtin_nontemporal_load((const f32x4*)(src + j * 1024)); v[j][1] = __builtin_nontemporal_load((const f32x4*)(src + j * 1024 + 256)); }
            bf16* so = sels + ((size_t)s * (PAST + DS) + tok0) * 512 + 4 * lane;
#pragma unroll
            for (int j = 0; j < 8; ++j)
#pragma unroll
                for (int c = 0; c < 2; ++c) { v2u w; w.x = pk2(v[j][c][0], v[j][c][1]); w.y = pk2(v[j][c][2], v[j][c][3]); *(v2u*)(so + j * 512 + c * 256) = w; }
        }
    }
    if (do_f) {
        const float* cw = F.in[I_CWIN]; float* o = F.out + O_WINS; bf16* wins = (bf16*)(ws + WS_WINS);
        for (int it = gw * 4; it < DB * 512; it += NGW * 4) {
            const int s = it >> 9, i0 = it & 511;
            const float* src = cw + ((size_t)s * 512 + i0) * 512 + 4 * lane;
            f32x4 a[4], b[4];
#pragma unroll
            for (int j = 0; j < 4; ++j) { a[j] = __builtin_nontemporal_load((const f32x4*)(src + j * 512)); b[j] = __builtin_nontemporal_load((const f32x4*)(src + j * 512 + 256)); }
#pragma unroll
            for (int j = 0; j < 4; ++j) { const int i = i0 + j;
                v2u w; w.x = pk2(a[j][0], a[j][1]); w.y = pk2(a[j][2], a[j][3]); *(v2u*)(wins + ((size_t)s * 520 + i) * 512 + 4 * lane) = w;
                w.x = pk2(b[j][0], b[j][1]); w.y = pk2(b[j][2], b[j][3]); *(v2u*)(wins + ((size_t)s * 520 + i) * 512 + 256 + 4 * lane) = w;
                if (i >= 8) { float* dst = o + ((size_t)s * 512 + (i - 8)) * 512 + 4 * lane; __builtin_nontemporal_store(a[j], (f32x4*)dst); __builtin_nontemporal_store(b[j], (f32x4*)(dst + 256)); } }
        }
    }
}

__device__ __forceinline__ void cmp_finalize(Frame& F) {
    const float* PB = (const float*)(F.ws + WS_PBUF); const float* cvec = (const float*)(F.ws + WS_CVEC); const float* w2 = F.in[I_CW2];
    const int lane = F.lane, r = lane & 31, h = lane >> 5;
    constexpr int LP = NB * NCP * NG  , LS = DB * NCS * NG  , BP = (LP + 31) / 32, BS = (LS + 31) / 32, NBT = 2 * BP + 2 * BS;
    bf16x8 wf[2][4]; int wc_ = -1;
    for (int bt = F.gw; bt < NBT; bt += F.NGW) {
        int c, lb, len; bool prompt;
        if (bt < 2 * BP) { prompt = true; c = bt / BP; lb = bt % BP; len = LP; } else { const int q = bt - 2 * BP; prompt = false; c = q / BS; lb = q % BS; len = LS; }
        int idx = lb * 32 + r; const bool valid = idx < len; idx = valid ? idx : len - 1;
        const int g = idx & 3; int q = idx >> 2; size_t row0; bf16* dst;
        if (prompt) { const int n = q % NCP, sq = q / NCP; row0 = (((size_t)(c * NB + sq) * 512 + n) * NG + g); dst = (bf16*)(F.ws + (c ? WS_VCP : WS_KCP)) + ((size_t)(sq * NG + g) * 512 + n) * 64; }
        else { const int n = q % NCS, sq = q / NCS; row0 = CMP_ROWS_P + (((size_t)(c * DB + sq) * 128 + n) * NG + g); dst = (bf16*)(F.ws + (c ? WS_VCS : WS_KCS)) + ((size_t)(sq * NG + g) * 128 + n) * 64; }
        const float* p0 = PB + row0 * 128 + 8 * h; const float* p1 = PB + (row0 + NG) * 128 + 64 + 8 * h;
        f32x4 a[4][2], b[4][2];
#pragma unroll
        for (int ks = 0; ks < 4; ++ks) { a[ks][0] = ld4(p0 + 16 * ks); a[ks][1] = ld4(p0 + 16 * ks + 4); b[ks][0] = ld4(p1 + 16 * ks); b[ks][1] = ld4(p1 + 16 * ks + 4); }
        if (c != wc_) { wc_ = c;
#pragma unroll
            for (int fb = 0; fb < 2; ++fb)
#pragma unroll
                for (int ks = 0; ks < 4; ++ks) { const float* wp = w2 + ((size_t)c * 64 + 16 * ks + 8 * h) * 64 + 32 * fb + r;
                    v4u o; o.x = cvt_pk(wp[0], wp[64]); o.y = cvt_pk(wp[128], wp[192]); o.z = cvt_pk(wp[256], wp[320]); o.w = cvt_pk(wp[384], wp[448]); wf[fb][ks] = __builtin_bit_cast(bf16x8, o); } }
        f32x16 acc[2];
#pragma unroll
        for (int fb = 0; fb < 2; ++fb)
#pragma unroll
            for (int i = 0; i < 16; ++i) acc[fb][i] = 0.f;
#pragma unroll
        for (int ks = 0; ks < 4; ++ks) { const float* cv = cvec + c * 64 + 16 * ks + 8 * h; const f32x4 c0 = ld4(cv), c1 = ld4(cv + 4);
            const f32x4 x0 = a[ks][0] + b[ks][0] + c0, x1 = a[ks][1] + b[ks][1] + c1;
            v4u o; o.x = cvt_pk(gelu_tanh(x0[0]), gelu_tanh(x0[1])); o.y = cvt_pk(gelu_tanh(x0[2]), gelu_tanh(x0[3])); o.z = cvt_pk(gelu_tanh(x1[0]), gelu_tanh(x1[1])); o.w = cvt_pk(gelu_tanh(x1[2]), gelu_tanh(x1[3]));
            const bf16x8 hf = __builtin_bit_cast(bf16x8, o);
#pragma unroll
            for (int fb = 0; fb < 2; ++fb) acc[fb] = __builtin_amdgcn_mfma_f32_32x32x16_bf16(wf[fb][ks], hf, acc[fb], 0, 0, 0); }
        if (valid) {
#pragma unroll
            for (int fb = 0; fb < 2; ++fb)
#pragma unroll
                for (int q4 = 0; q4 < 4; ++q4) { v2u w; w.x = cvt_pk(acc[fb][4 * q4], acc[fb][4 * q4 + 1]); w.y = cvt_pk(acc[fb][4 * q4 + 2], acc[fb][4 * q4 + 3]);
                    *(v2u*)(dst + 32 * fb + 8 * q4 + 4 * h) = w; }
        }
    }
}

__device__ __forceinline__ void final_norm(Frame& F) {
    const bf16* X = (const bf16*)(F.ws + WS_XBA); const float* ss = F.SS(6); const float* gn = F.in[I_NFIN];
    for (int r = F.gw; r < M; r += F.NGW) {
        const float rstd = rsqrtf(ss[r] * (1.f / DM) + EPS);
        float* o = (r < MP) ? F.out + O_YP + (size_t)r * DM : F.out + O_YS + (size_t)(r - MP) * DM;
#pragma unroll
        for (int j = 0; j < 2; ++j) { const int c = 8 * F.lane + 512 * j; f32x4 v0, v1; unpk8(*(const v4u*)(X + (size_t)r * DM + c), v0, v1);
            __builtin_nontemporal_store(v0 * rstd * ld4(gn + c), (f32x4*)(o + c)); __builtin_nontemporal_store(v1 * rstd * ld4(gn + c + 4), (f32x4*)(o + c + 4)); }
    }
}
constexpr int SG_PITCH = 68;
struct SgPre { v4u a, b; float f; };
template <bool DUAL, class Pre, class Fn>
__device__ __forceinline__ void sgemm_tile(LAS unsigned char* lds, const bf16* A, int lda, const bf16* B0, const bf16* B1, int K, int wave, int lane, const Pre& pre, const Fn& fn) {
    LAS float* part = (LAS float*)lds;
    const int nsl = DUAL ? 4 : 8, sl = DUAL ? (wave & 3) : wave; const bf16* Bt = (DUAL && wave >= 4) ? B1 : B0;
    const int ksl = K / nsl, k0 = sl * ksl, steps = ksl / 16;
    const int r = lane & 31, h = lane >> 5;
    f32x16 acc[2][2];
#pragma unroll
    for (int a = 0; a < 2; ++a)
#pragma unroll
        for (int b = 0; b < 2; ++b)
#pragma unroll
            for (int i = 0; i < 16; ++i) acc[a][b][i] = 0.f;
    const bf16* ap = A + (size_t)r * lda + k0 + 8 * h; const bf16* bp = Bt + (size_t)r * K + k0 + 8 * h;
    for (int s0 = 0; s0 < steps; s0 += 8) {
        bf16x8 fa0[8], fa1[8], fb0[8], fb1[8];
#pragma unroll
        for (int j = 0; j < 8; ++j) { const int st = (s0 + j < steps) ? s0 + j : steps - 1;
            fa0[j] = *(const bf16x8*)(ap + 16 * st); fa1[j] = *(const bf16x8*)(ap + (size_t)32 * lda + 16 * st); fb0[j] = *(const bf16x8*)(bp + 16 * st); fb1[j] = *(const bf16x8*)(bp + (size_t)32 * K + 16 * st); }
        __builtin_amdgcn_sched_barrier(0);
#pragma unroll
        for (int j = 0; j < 8; ++j) if (s0 + j < steps) {
            acc[0][0] = __builtin_amdgcn_mfma_f32_32x32x16_bf16(fa0[j], fb0[j], acc[0][0], 0, 0, 0); acc[0][1] = __builtin_amdgcn_mfma_f32_32x32x16_bf16(fa0[j], fb1[j], acc[0][1], 0, 0, 0);
            acc[1][0] = __builtin_amdgcn_mfma_f32_32x32x16_bf16(fa1[j], fb0[j], acc[1][0], 0, 0, 0); acc[1][1] = __builtin_amdgcn_mfma_f32_32x32x16_bf16(fa1[j], fb1[j], acc[1][1], 0, 0, 0); }
    }
    const int t = wave * 64 + lane, row = t >> 3, c8 = (t & 7) * 8;
    const SgPre pv = pre(row, c8);
    LAS float* pw = part + wave * 64 * SG_PITCH;
#pragma unroll
    for (int a = 0; a < 2; ++a)
#pragma unroll
        for (int b = 0; b < 2; ++b)
#pragma unroll
            for (int i = 0; i < 16; ++i) pw[(32 * a + (i & 3) + 8 * (i >> 2) + 4 * h) * SG_PITCH + 32 * b + r] = acc[a][b][i];
    asm volatile("s_waitcnt lgkmcnt(0)" ::: "memory"); __syncthreads();
    f32x4 v0 = {0.f, 0.f, 0.f, 0.f}, v1 = v0, w0 = v0, w1 = v0;
#pragma unroll
    for (int p = 0; p < nsl; ++p) { const LAS float* q = part + (p * 64 + row) * SG_PITCH + c8; v0 += *(const LAS f32x4*)q; v1 += *(const LAS f32x4*)(q + 4); }
    if (DUAL) {
#pragma unroll
        for (int p = 4; p < 8; ++p) { const LAS float* q = part + (p * 64 + row) * SG_PITCH + c8; w0 += *(const LAS f32x4*)q; w1 += *(const LAS f32x4*)(q + 4); }
    }
    fn(row, c8, v0, v1, w0, w1, pv);
    asm volatile("s_waitcnt lgkmcnt(0)" ::: "memory"); __syncthreads();
}
__device__ __forceinline__ void ss_accum8(float* ssout, int r, float s, int lane) {
    s += __shfl_xor(s, 1); s += __shfl_xor(s, 2); s += __shfl_xor(s, 4);
    if ((lane & 7) == 0) atomicAdd(ssout + r, s);
}
__device__ __forceinline__ float sumsq8(f32x4 a, f32x4 b) { return (a[0] * a[0] + a[1] * a[1]) + (a[2] * a[2] + a[3] * a[3]) + (b[0] * b[0] + b[1] * b[1]) + (b[2] * b[2] + b[3] * b[3]); }

__device__ __forceinline__ void sample_resid(Frame& F, const bf16* A, int lda, const bf16* Bt, int K, const bf16* XI, bf16* XO, float* ssout) {
    for (int u = blockIdx.x; u < 256; u += gridDim.x) { const int rb = u >> 4, cbk = u & 15; const int lane = F.lane;
        sgemm_tile<false>(F.lds, A + (size_t)(MP + 64 * rb) * lda, lda, Bt + (size_t)(64 * cbk) * K, nullptr, K, F.wave, lane,
            [&](int row, int c8) { SgPre p; p.a = *(const v4u*)(XI + (size_t)(MP + 64 * rb + row) * DM + 64 * cbk + c8); p.b = p.a; p.f = 0.f; return p; },
            [&](int row, int c8, f32x4 v0, f32x4 v1, f32x4, f32x4, const SgPre& pv) { const int r = MP + 64 * rb + row, c0 = 64 * cbk + c8;
                f32x4 x0, x1; unpk8(pv.a, x0, x1); v0 += x0; v1 += x1;
                *(v4u*)(XO + (size_t)r * DM + c0) = pk8c(v0, v1);
                ss_accum8(ssout, r, sumsq8(v0, v1), lane); }); }
}
__device__ __forceinline__ void sample_gate(Frame& F, const bf16* A, const bf16* Bt, const float* ss, const bf16* PP, const bf16* XI, bf16* XO, bf16* XG, float* ssout) {
    for (int u = blockIdx.x; u < 256; u += gridDim.x) { const int rb = u >> 4, cbk = u & 15; const int lane = F.lane;
        sgemm_tile<false>(F.lds, A + (size_t)(MP + 64 * rb) * DM, DM, Bt + (size_t)(64 * cbk) * DM, nullptr, DM, F.wave, lane,
            [&](int row, int c8) { const int r = MP + 64 * rb + row, c0 = 64 * cbk + c8; SgPre p; p.a = *(const v4u*)(PP + (size_t)r * DM + c0); p.b = *(const v4u*)(XI + (size_t)r * DM + c0); p.f = ss[r]; return p; },
            [&](int row, int c8, f32x4 a0, f32x4 a1, f32x4, f32x4, const SgPre& pv) { const int r = MP + 64 * rb + row, c0 = 64 * cbk + c8;
                const float rstd = rsqrtf(pv.f * (1.f / DM) + EPS);
                f32x4 p0, p1, v0, v1; unpk8(pv.a, p0, p1); unpk8(pv.b, v0, v1);
                a0 = a0 * rstd; a1 = a1 * rstd;
#pragma unroll
                for (int e = 0; e < 4; ++e) { v0[e] += p0[e] * sigmoidf_(a0[e]); v1[e] += p1[e] * sigmoidf_(a1[e]); }
                const v4u wv = pk8c(v0, v1); *(v4u*)(XO + (size_t)r * DM + c0) = wv;
                if (XG) *(v4u*)(XG + ((size_t)(c0 >> 4) * M + r) * 16 + (c0 & 15)) = wv;
                ss_accum8(ssout, r, sumsq8(v0, v1), lane); }); }
}
__device__ __forceinline__ void sample_glu(Frame& F, const bf16* A, const bf16* WgluT, const bf16* XI, bf16* XO, float* ssout) {
    for (int u = blockIdx.x; u < 256; u += gridDim.x) { const int rb = u >> 4, cbk = u & 15; const int lane = F.lane; const int j0 = 64 * cbk;
        const bf16* B0 = WgluT + (size_t)((j0 >> 7) * 256 + (j0 & 127)) * DM;
        sgemm_tile<true>(F.lds, A + (size_t)(MP + 64 * rb) * DM, DM, B0, B0 + (size_t)128 * DM, DM, F.wave, lane,
            [&](int row, int c8) { SgPre p; p.a = *(const v4u*)(XI + (size_t)(MP + 64 * rb + row) * DM + j0 + c8); p.b = p.a; p.f = 0.f; return p; },
            [&](int row, int c8, f32x4 a0, f32x4 a1, f32x4 b0, f32x4 b1, const SgPre& pv) { const int r = MP + 64 * rb + row, c0 = j0 + c8;
                f32x4 v0, v1; unpk8(pv.a, v0, v1);
#pragma unroll
                for (int e = 0; e < 4; ++e) { v0[e] += a0[e] * sigmoidf_(b0[e]); v1[e] += a1[e] * sigmoidf_(b1[e]); }
                *(v4u*)(XO + (size_t)r * DM + c0) = pk8c(v0, v1);
                ss_accum8(ssout, r, sumsq8(v0, v1), lane); }); }
}

__device__ __forceinline__ void sample_plain(Frame& F, const bf16* A, int lda, const bf16* Bt, int K, bf16* O) {
    for (int u = blockIdx.x; u < 256; u += gridDim.x) { const int rb = u >> 4, cbk = u & 15;
        sgemm_tile<false>(F.lds, A + (size_t)(MP + 64 * rb) * lda, lda, Bt + (size_t)(64 * cbk) * K, nullptr, K, F.wave, F.lane,
            [&](int, int) { SgPre p; p.a = (v4u){0u, 0u, 0u, 0u}; p.b = p.a; p.f = 0.f; return p; },
            [&](int row, int c8, f32x4 v0, f32x4 v1, f32x4, f32x4, const SgPre&) { *(v4u*)(O + (size_t)(MP + 64 * rb + row) * DM + 64 * cbk + c8) = pk8c(v0, v1); }); }
}
__device__ __forceinline__ void sample_plain_sub(Frame& F, const bf16* A, int lda, const bf16* Bt, int K, bf16* O, int r, int n) {
    for (int u = r; u < 256; u += n) { const int rb = u >> 4, cbk = u & 15;
        sgemm_tile<false>(F.lds, A + (size_t)(MP + 64 * rb) * lda, lda, Bt + (size_t)(64 * cbk) * K, nullptr, K, F.wave, F.lane,
            [&](int, int) { SgPre p; p.a = (v4u){0u, 0u, 0u, 0u}; p.b = p.a; p.f = 0.f; return p; },
            [&](int row, int c8, f32x4 v0, f32x4 v1, f32x4, f32x4, const SgPre&) { *(v4u*)(O + (size_t)(MP + 64 * rb + row) * DM + 64 * cbk + c8) = pk8c(v0, v1); }); }
}
__device__ __forceinline__ void prompt_cmp(Frame& F) {
    const bf16* A = (const bf16*)(F.ws + WS_CMPA); const bf16* W = (const bf16*)(F.ws + WS_W1R_T); float* PB = (float*)(F.ws + WS_PBUF);
    for (int u = blockIdx.x; u < 256; u += gridDim.x) { const int rb = u >> 1, c2 = u & 1, c = (64 * rb) / (CMP_ROWS_P / 2);
        sgemm_tile<false>(F.lds, A + (size_t)(64 * rb) * 1024, 1024, W + (size_t)(128 * c + 64 * c2) * 1024, nullptr, 1024, F.wave, F.lane,
            [&](int, int) { SgPre p; p.a = (v4u){0u, 0u, 0u, 0u}; p.b = p.a; p.f = 0.f; return p; },
            [&](int row, int c8, f32x4 v0, f32x4 v1, f32x4, f32x4, const SgPre&) { float* o = PB + (size_t)(64 * rb + row) * 128 + 64 * c2 + c8; st4(o, v0); st4(o + 4, v1); }); }
}

constexpr int SC_PITCH = 2064, SC_BUF = 32 * SC_PITCH;
__device__ __forceinline__ void sample_cmp_pages(Frame& F) {
    LAS unsigned char* al = F.lds;
    const int lane = F.lane, w = F.wave, j16 = lane & 15, kq = lane >> 4;
    const int c = blockIdx.x & 1, u0 = blockIdx.x >> 1, ustep = gridDim.x >> 1;
    const float* ckv = F.in[I_CKV] + c * 256 + 4 * lane; float* PB = (float*)(F.ws + WS_PBUF);
    bf16x8 bq[32];
    { const bf16* bp = (const bf16*)(F.ws + WS_W1R_T) + (size_t)(c * 128 + 16 * w + j16) * 1024 + 8 * kq;
#pragma unroll
      for (int ks = 0; ks < 32; ++ks) bq[ks] = *(const bf16x8*)(bp + 32 * ks); }
    LAS unsigned char* aw = al + (lane >> 4) * SC_PITCH + 2 * (w * 64 + (lane & 15) * 4);
    LAS const unsigned char* ap = al + j16 * SC_PITCH + 16 * kq;
    f32x4 v[16];
    int u = u0;
    if (u < DB * NPAGES) { const float* src = ckv + ((size_t)F.pt[u] * PAGE + w) * 1024;
#pragma unroll
        for (int i = 0; i < 16; ++i) v[i] = __builtin_nontemporal_load((const f32x4*)(src + (size_t)i * 8192));
#pragma unroll
        for (int i = 0; i < 16; ++i) { v2u wv; wv.x = cvt_pk(v[i][0], v[i][1]); wv.y = cvt_pk(v[i][2], v[i][3]); *(LAS v2u*)(aw + (i >> 1) * 4 * SC_PITCH + (i & 1) * 1024) = wv; } }
    LDS_WAIT(); __syncthreads();
    for (int p = 0; u < DB * NPAGES; u += ustep, p ^= 1) {
        const int un = u + ustep; const bool more = un < DB * NPAGES;
        if (more) { const float* src = ckv + ((size_t)F.pt[un] * PAGE + w) * 1024;
#pragma unroll
            for (int i = 0; i < 16; ++i) v[i] = __builtin_nontemporal_load((const f32x4*)(src + (size_t)i * 8192)); }
        f32x4 acc0 = {0.f, 0.f, 0.f, 0.f}, acc1 = acc0;
        LAS const unsigned char* a = ap + p * SC_BUF;
#pragma unroll
        for (int ks = 0; ks < 32; ++ks) { const bf16x8 a0 = *(LAS const bf16x8*)(a + 64 * ks), a1 = *(LAS const bf16x8*)(a + 16 * SC_PITCH + 64 * ks);
            acc0 = __builtin_amdgcn_mfma_f32_16x16x32_bf16(a0, bq[ks], acc0, 0, 0, 0); acc1 = __builtin_amdgcn_mfma_f32_16x16x32_bf16(a1, bq[ks], acc1, 0, 0, 0); }
        const int s = u >> 4, pg = u & 15;
        float* po = PB + ((size_t)CMP_ROWS_P + (size_t)(c * DB + s) * 512 + 32 * pg + 4 * kq) * 128 + 16 * w + j16;
#pragma unroll
        for (int e = 0; e < 4; ++e) { po[e * 128] = acc0[e]; po[(16 + e) * 128] = acc1[e]; }
        if (more) { LAS unsigned char* d = aw + (p ^ 1) * SC_BUF;
#pragma unroll
            for (int i = 0; i < 16; ++i) { v2u wv; wv.x = cvt_pk(v[i][0], v[i][1]); wv.y = cvt_pk(v[i][2], v[i][3]); *(LAS v2u*)(d + (i >> 1) * 4 * SC_PITCH + (i & 1) * 1024) = wv; } }
        LDS_WAIT(); __syncthreads();
    }
}

typedef short s16x4 __attribute__((ext_vector_type(4)));
constexpr float NEGS = -3.0e38f;
constexpr int VBUF = 4096;
constexpr int AL_K = 0, AL_V = VBUF, AL_IMP = 2 * VBUF, AL_V1 = 2 * VBUF  , AL_SELM = 2 * VBUF + 8192, AL_END = AL_SELM + 256;
static_assert(AL_END <= WAVE_LDS, "attention LDS map");

struct ASeq {
    const bf16* kc; const bf16* vc; int nc;
    const bf16* ks; int spitch; int srows;
    const bf16* kw; int wpitch; int wrows; int wpos0;
    int qpos0; int ns;
};

__device__ __forceinline__ float ex2(float x) { return __builtin_amdgcn_exp2f(x); }
typedef unsigned v2uu __attribute__((ext_vector_type(2)));
__device__ __forceinline__ float xhalf_max(float v) { const unsigned b = __float_as_uint(v); const v2uu r = __builtin_amdgcn_permlane32_swap(b, b, false, false); float o; asm("v_max_f32 %0, %1, %2" : "=v"(o) : "v"(r[0]), "v"(r[1])); return o; }
__device__ __forceinline__ float xhalf_sum(float v) { const unsigned b = __float_as_uint(v); const v2uu r = __builtin_amdgcn_permlane32_swap(b, b, false, false); return __uint_as_float(r[0]) + __uint_as_float(r[1]); }
template <int CTRL> __device__ __forceinline__ float dpp_f(float v) { return __uint_as_float((unsigned)__builtin_amdgcn_update_dpp(0, (int)__float_as_uint(v), CTRL, 0xf, 0xf, true)); }
__device__ __forceinline__ float quad_sum(float v) { v += dpp_f<0xB1>(v); v += dpp_f<0x4E>(v); return v; }

__device__ __forceinline__ void issue_k(LAS unsigned char* kbuf, const bf16* kbase, int pitch, int row0, int nrows, int lane) {
#pragma unroll
    for (int i = 0; i < 4; ++i) { int row = row0 + 8 * i + (lane >> 3); row = row < nrows ? row : nrows - 1;
        const int ch = (lane & 7) ^ ((lane >> 3) & 7);
        __builtin_amdgcn_global_load_lds((const unsigned*)(kbase + (size_t)row * pitch + 8 * ch), (LAS unsigned*)(kbuf + i * 1024), 16, 0, 0); }
}
__device__ __forceinline__ void read_kf(bf16x8 (&kf)[4], LAS const unsigned char* kbuf, int lane) {
    const int key = lane & 31, h = lane >> 5;
#pragma unroll
    for (int ks = 0; ks < 4; ++ks) kf[ks] = *(LAS const bf16x8*)(kbuf + key * 128 + (((2 * ks + h) ^ (key & 7)) << 4));
}
__device__ __forceinline__ void issue_v(LAS unsigned char* vbuf, const bf16* vbase, int pitch, int row0, int nrows, int lane) {
#pragma unroll
    for (int i = 0; i < 4; ++i) { int row = row0 + 8 * i + (lane >> 3); row = row < nrows ? row : nrows - 1;
        const int ch = (lane & 7) ^ (((lane >> 4) & 1) << 2);
        __builtin_amdgcn_global_load_lds((const unsigned*)(vbase + (size_t)row * pitch + 8 * ch), (LAS unsigned*)(vbuf + i * 1024), 16, 0, 0); }
}
__device__ __forceinline__ s16x4 vtr(LAS const unsigned char* p) { return __builtin_bit_cast(s16x4, __builtin_amdgcn_ds_read_tr16_b64_v4i16((LAS s16x4*)p)); }
__device__ __forceinline__ bf16x8 vfrag(LAS const unsigned char* va, int ks) {
    const s16x4 lo = vtr(va + ks * 2048), hi = vtr(va + ks * 2048 + 1024);
    bf16x8 r; r[0] = lo[0]; r[1] = lo[1]; r[2] = lo[2]; r[3] = lo[3]; r[4] = hi[0]; r[5] = hi[1]; r[6] = hi[2]; r[7] = hi[3]; return r;
}

template <int NQB> struct AState { float m[NQB], l[NQB]; f32x16 o[2][NQB]; };

#define OFFI(i) (((i) & 3) + 8 * ((i) >> 2))
__device__ __forceinline__ void qk_raw(f32x16& acc, const bf16x8 (&kf)[4], const bf16x8 (&qf)[4]) {
#pragma unroll
    for (int i = 0; i < 16; ++i) acc[i] = 0.f;
#pragma unroll
    for (int ks = 0; ks < 4; ++ks) acc = __builtin_amdgcn_mfma_f32_32x32x16_bf16(kf[ks], qf[ks], acc, 0, 0, 0);
}
__device__ __forceinline__ void mask_bias(f32x16& s, float sl_alpha, float fb, int lo_rel, int hi_rel, bool extra) {
#pragma unroll
    for (int i = 0; i < 16; ++i) { const bool ok = extra && (OFFI(i) <= hi_rel) && (OFFI(i) >= lo_rel); s[i] = ok ? __builtin_fmaf(sl_alpha, (float)OFFI(i), s[i] + fb) : NEGS; }
}
template <int NQB>
__device__ __forceinline__ void scores(f32x16& s, const bf16x8 (&kf)[4], const bf16x8 (&qf)[4], float sl_alpha, float fb, int lo_rel, int hi_rel, bool extra) {
    qk_raw(s, kf, qf); mask_bias(s, sl_alpha, fb, lo_rel, hi_rel, extra);
}
__device__ __forceinline__ float max16(const f32x16& s) {
    float a = fmaxf(fmaxf(s[0], s[1]), fmaxf(s[2], s[3])), b = fmaxf(fmaxf(s[4], s[5]), fmaxf(s[6], s[7])), c = fmaxf(fmaxf(s[8], s[9]), fmaxf(s[10], s[11])), d = fmaxf(fmaxf(s[12], s[13]), fmaxf(s[14], s[15]));
    return fmaxf(fmaxf(a, b), fmaxf(c, d));
}
__device__ __forceinline__ void pack_p(bf16x8 (&pf)[2], const f32x16& p) {
#pragma unroll
    for (int ks = 0; ks < 2; ++ks) { v4u w; w.x = cvt_pk(p[8 * ks + 0], p[8 * ks + 1]); w.y = cvt_pk(p[8 * ks + 2], p[8 * ks + 3]); w.z = cvt_pk(p[8 * ks + 4], p[8 * ks + 5]); w.w = cvt_pk(p[8 * ks + 6], p[8 * ks + 7]); pf[ks] = __builtin_bit_cast(bf16x8, w); }
}

template <int NQB>
__device__ __forceinline__ void attn_unit(Frame& F, const ASeq& A, int qrow0, int g, int tl0, LAS unsigned char* wl) {
    int lane_ = F.lane; asm volatile("" : "+v"(lane_));
    const int lane = lane_ & 63, h = lane >> 5, c = lane & 31, head = c & 3;
    LAS unsigned char* kl = wl + AL_K; LAS unsigned char* vl = wl + AL_V; LAS float* imp = (LAS float*)(wl + AL_IMP); LAS unsigned* selm = (LAS unsigned*)(wl + AL_SELM);
    unsigned* stash0 = (unsigned*)(F.ws + WS_STASH) + (size_t)F.gw * 2048 + lane;
    const int vq = (lane & 15) >> 2, vfq = (vq >> 1) & 1;
    const int vbase_off = (4 * h + vq) * 128 + (2 * ((lane >> 4) & 1) + ((lane & 3) >> 1)) * 16 + (lane & 1) * 8;
    const int voff0 = vbase_off + vfq * 64, voff1 = vbase_off + (1 - vfq) * 64;
    const bf16* Qb = (const bf16*)(F.ws + WS_QB); bf16* Ob = (bf16*)(F.ws + WS_OB); const float* gates = (const float*)(F.ws + WS_GATES);
    bf16x8 qf[NQB][4]; int qpos[NQB];
#pragma unroll
    for (int qb = 0; qb < NQB; ++qb) {
        const int tok = qb * 8 + (c >> 2); const size_t r = (size_t)qrow0 + tok;
        const bf16* qp = Qb + r * DM + (4 * g + head) * 64 + 8 * h;
#pragma unroll
        for (int ks = 0; ks < 4; ++ks) qf[qb][ks] = *(const bf16x8*)(qp + 16 * ks);
        qpos[qb] = A.qpos0 + tl0 + tok;
    }
    const float sl = exp2f(-0.5f * (float)(4 * g + head + 1)) * LOG2E;
    const int qmin = A.qpos0 + tl0, qmax = qmin + 8 * NQB - 1;
    AState<NQB> st;

#pragma unroll
    for (int i = 0; i < 8; ++i) *(LAS f32x4*)(imp + (i * 64 + lane) * 4) = (f32x4){0.f, 0.f, 0.f, 0.f};

    int lim[NQB];
#pragma unroll
    for (int qb = 0; qb < NQB; ++qb) { int nv = qpos[qb] >= 31 ? (qpos[qb] - 31) / 16 + 1 : 0; nv = nv < A.nc ? nv : A.nc; lim[qb] = nv - 1; }
    int nvmax = qmax >= 31 ? (qmax - 31) / 16 + 1 : 0; nvmax = nvmax < A.nc ? nvmax : A.nc;
    const int ntc = (nvmax + 31) >> 5;
#pragma unroll
    for (int qb = 0; qb < NQB; ++qb) { st.m[qb] = -1.0e30f; st.l[qb] = 0.f; }
    if (ntc > 0) issue_k(kl, A.kc, 64, 0, A.nc, lane);
    for (int tile = 0; tile < ntc; ++tile) {
        bf16x8 kf[4];
        asm volatile("s_waitcnt vmcnt(0)" ::: "memory"); read_kf(kf, kl, lane); LDS_WAIT(); asm volatile("" ::: "memory");
        if (tile + 1 < ntc) issue_k(kl, A.kc, 64, (tile + 1) * 32, A.nc, lane);
        const int nb = tile * 32 + 4 * h;
#pragma unroll
        for (int qb = 0; qb < NQB; ++qb) {
            f32x16 s; scores<NQB>(s, kf, qf[qb], sl * 16.f, sl * (16.f * (float)nb + 15.5f - (float)qpos[qb]), 0, lim[qb] - nb, true);
            float tm = xhalf_max(max16(s));
            const float mn = fmaxf(st.m[qb], tm); float sum = 0.f;
#pragma unroll
            for (int i = 0; i < 16; ++i) sum += ex2(s[i] - mn);
            st.l[qb] = st.l[qb] * ex2(st.m[qb] - mn) + sum; st.m[qb] = mn;
        }
    }
    float invl[NQB];
#pragma unroll
    for (int qb = 0; qb < NQB; ++qb) { const float lt = xhalf_sum(st.l[qb]); invl[qb] = (lim[qb] >= 0 && lt > 0.f) ? 1.f / lt : 0.f; }
#pragma unroll
    for (int db = 0; db < 2; ++db)
#pragma unroll
        for (int qb = 0; qb < NQB; ++qb)
#pragma unroll
            for (int i = 0; i < 16; ++i) st.o[db][qb][i] = 0.f;
    if (ntc > 0) { issue_k(kl, A.kc, 64, 0, A.nc, lane); issue_v(vl, A.vc, 64, 0, A.nc, lane); }
    for (int tile = 0; tile < ntc; ++tile) {
        const bool more = tile + 1 < ntc;
        bf16x8 kf[4];
        asm volatile("s_waitcnt vmcnt(4)" ::: "memory"); read_kf(kf, kl, lane); LDS_WAIT(); asm volatile("" ::: "memory");
        if (more) issue_k(kl, A.kc, 64, (tile + 1) * 32, A.nc, lane);
        const int nb = tile * 32 + 4 * h;
        bf16x8 pf[NQB][2];
#pragma unroll
        for (int qb = 0; qb < NQB; ++qb) {
            f32x16 s; scores<NQB>(s, kf, qf[qb], sl * 16.f, sl * (16.f * (float)nb + 15.5f - (float)qpos[qb]), 0, lim[qb] - nb, true);
            f32x16 p;
#pragma unroll
            for (int i = 0; i < 16; ++i) p[i] = ex2(s[i] - st.m[qb]) * invl[qb];
#pragma unroll
            for (int q = 0; q < 4; ++q) { const float v = quad_sum((p[4 * q] + p[4 * q + 1]) + (p[4 * q + 2] + p[4 * q + 3]));
                if (head == 0) imp[(qb * 8 + (c >> 2)) * 128 + 8 * tile + 2 * q + h] = v; }
            pack_p(pf[qb], p);
        }
        if (more) asm volatile("s_waitcnt vmcnt(4) lgkmcnt(0)" ::: "memory"); else asm volatile("s_waitcnt vmcnt(0) lgkmcnt(0)" ::: "memory");
#pragma unroll
        for (int db = 0; db < 2; ++db)
#pragma unroll
            for (int ks = 0; ks < 2; ++ks) { const bf16x8 vf = vfrag(vl + (db ? voff1 : voff0), ks);
#pragma unroll
                for (int qb = 0; qb < NQB; ++qb) st.o[db][qb] = __builtin_amdgcn_mfma_f32_32x32x16_bf16(vf, pf[qb][ks], st.o[db][qb], 0, 0, 0); }
        LDS_WAIT(); asm volatile("" ::: "memory");
        if (more) issue_v(vl, A.vc, 64, (tile + 1) * 32, A.nc, lane);
    }
    asm volatile("s_waitcnt vmcnt(0) lgkmcnt(0)" ::: "memory");

    unsigned taken = 0u;
    {
        const int tok = lane >> 2, part = lane & 3; const bool live = tok < 8 * NQB;
        const int cur = (A.qpos0 + tl0 + tok) >> 6;
        float v[32];
#pragma unroll
        for (int j4 = 0; j4 < 8; ++j4) { const f32x4 t = *(LAS const f32x4*)(imp + (live ? tok : 0) * 128 + 32 * part + 4 * j4); v[4 * j4] = t[0]; v[4 * j4 + 1] = t[1]; v[4 * j4 + 2] = t[2]; v[4 * j4 + 3] = t[3]; }
        const int rel = cur - 32 * part, nsrel = A.ns - 32 * part;
#pragma unroll
        for (int j = 0; j < 32; ++j) { const bool forced = (j == rel) || (j == rel - 1) || (j == 0 && part == 0);
            v[j] = (j < nsrel) ? ((j <= rel) ? v[j] + (forced ? 1.0e4f : 0.f) : -1.0e30f) : NEGS; }
        for (int k = 0; k < 16; ++k) {
            float bv = -__builtin_inff(); int bj = 0;
#pragma unroll
            for (int j = 0; j < 32; ++j) { const float cnd = ((taken >> j) & 1u) ? NEGS : v[j]; if (cnd > bv) { bv = cnd; bj = j; } }
            int bi = 32 * part + bj;
            { const float ov = dpp_f<0xB1>(bv); const int oi = __builtin_amdgcn_update_dpp(0, bi, 0xB1, 0xf, 0xf, true); if (ov > bv || (ov == bv && oi < bi)) { bv = ov; bi = oi; } }
            { const float ov = dpp_f<0x4E>(bv); const int oi = __builtin_amdgcn_update_dpp(0, bi, 0x4E, 0xf, 0xf, true); if (ov > bv || (ov == bv && oi < bi)) { bv = ov; bi = oi; } }
            if ((bi >> 5) == part) taken |= 1u << (bi & 31);
        }
        if (!live) taken = 0u;
        selm[lane] = taken;
    }
    LDS_WAIT(); asm volatile("" ::: "memory");
    { unsigned* stash = stash0; asm volatile("" : "+v"(stash));
#pragma unroll
    for (int db = 0; db < 2; ++db)
#pragma unroll
        for (int qb = 0; qb < NQB; ++qb)
#pragma unroll
            for (int k = 0; k < 8; ++k) { const float g0 = gates[((size_t)qrow0 + qb * 8 + (c >> 2)) * 48 + (4 * g + head) * 3];
                stash[((db * NQB + qb) * 8 + k) * 64] = cvt_pk(st.o[db][qb][2 * k] * g0, st.o[db][qb][2 * k + 1] * g0); } }
    unsigned un[4], unq[NQB][4];
    { unsigned u = taken; u |= __shfl_xor(u, 4); u |= __shfl_xor(u, 8); u |= __shfl_xor(u, 16);
#pragma unroll
      for (int qb = 0; qb < NQB; ++qb)
#pragma unroll
          for (int p = 0; p < 4; ++p) unq[qb][p] = __builtin_amdgcn_readlane(u, 32 * qb + p);
#pragma unroll
      for (int p = 0; p < 4; ++p) { un[p] = unq[0][p]; if (NQB > 1) un[p] |= unq[NQB - 1][p]; } }
    LDS_WAIT(); asm volatile("" ::: "memory");

    f32x16 sbase;
#pragma unroll
    for (int i = 0; i < 16; ++i) sbase[i] = sl * (float)OFFI(i);
#pragma unroll
    for (int br = 0; br < 2; ++br) {
#pragma unroll
        for (int qb = 0; qb < NQB; ++qb) { st.m[qb] = -1.0e30f; st.l[qb] = 0.f; }
#pragma unroll
        for (int db = 0; db < 2; ++db)
#pragma unroll
            for (int qb = 0; qb < NQB; ++qb)
#pragma unroll
                for (int i = 0; i < 16; ++i) st.o[db][qb][i] = 0.f;
        const bf16* kb_ = br == 0 ? A.ks : A.kw; const int pitch = br == 0 ? A.spitch : A.wpitch, nrows = br == 0 ? A.srows : A.wrows, pos0 = br == 0 ? 0 : A.wpos0;
        const int curblk = qmin >> 6;
        unsigned ub[4];
#pragma unroll
        for (int p = 0; p < 4; ++p) { const int hi = curblk - 32 * p; ub[p] = hi < 0 ? 0u : (hi >= 31 ? un[p] : (un[p] & ((2u << hi) - 1u))); }
        int wrow_min = 0, wrow_cur = -1, ublk = 0, upart = 3, hcnt = 0; unsigned ubits = ub[3];
        if (br == 1) { int lo = qmin - 511 - pos0; lo = lo > 0 ? lo : 0; wrow_min = lo & ~31; wrow_cur = (qmax - pos0) & ~31; }
#define NEXT_TILE(ROW, BLK, OK) do { OK = false; \
            if (br == 0) { for (;;) { \
                if (hcnt == 0) { while (ubits == 0u && upart > 0) { --upart; ubits = upart == 2 ? ub[2] : (upart == 1 ? ub[1] : ub[0]); } \
                    if (ubits == 0u) break; \
                    const int j_ = 31 - __builtin_clz(ubits); ubits &= ~(1u << j_); ublk = 32 * upart + j_; hcnt = 2; } \
                --hcnt; const int r_ = ublk * 64 + 32 * hcnt; if (r_ > qmax) continue; \
                ROW = r_; BLK = ublk; OK = true; break; } } \
            else if (wrow_cur >= wrow_min) { ROW = wrow_cur; BLK = 0; wrow_cur -= 32; OK = true; } } while (0)
        int crow = 0, cblk = 0; bool cok; NEXT_TILE(crow, cblk, cok);
        int pb = 0;
        if (cok) { issue_k(kl, kb_, pitch, crow, nrows, lane); issue_v(vl, kb_ + 256, pitch, crow, nrows, lane); }
        while (cok) {
            int nrow = 0, nblk = 0; bool nok; NEXT_TILE(nrow, nblk, nok);
            bf16x8 kf[4];
            asm volatile("s_waitcnt vmcnt(4)" ::: "memory"); read_kf(kf, kl, lane); LDS_WAIT(); asm volatile("" ::: "memory");
            if (nok) { issue_k(kl, kb_, pitch, nrow, nrows, lane); issue_v(pb ? vl : wl + AL_V1, kb_ + 256, pitch, nrow, nrows, lane); }
            bool sb[NQB], act[NQB];
#pragma unroll
            for (int qb = 0; qb < NQB; ++qb) { sb[qb] = true; act[qb] = true;
                if (br == 0) { const unsigned w = selm[(qb * 8 + (c >> 2)) * 4 + (cblk >> 5)]; sb[qb] = (w >> (cblk & 31)) & 1u;
                    const int pp = cblk >> 5; const unsigned uw = pp == 0 ? unq[qb][0] : (pp == 1 ? unq[qb][1] : (pp == 2 ? unq[qb][2] : unq[qb][3])); act[qb] = (uw >> (cblk & 31)) & 1u; } }
            const int nb = pos0 + crow + 4 * h;
            const bool interior = (pos0 + crow + 31 <= qmin) && (br == 0 || qmax - (pos0 + crow) < 512);
            bf16x8 pf[NQB][2];
#pragma unroll
            for (int qb = 0; qb < NQB; ++qb) if (act[qb]) {
                const bool un_ = st.m[qb] < -1.0e29f; const float mref = un_ ? 0.f : st.m[qb];
                const float fb = sl * (float)(nb - qpos[qb]);
                const float c0 = ((interior && !sb[qb]) ? NEGS : fb) - mref;
                f32x16 s;
#pragma unroll
                for (int i = 0; i < 16; ++i) s[i] = sbase[i] + c0;
#pragma unroll
                for (int ks = 0; ks < 4; ++ks) s = __builtin_amdgcn_mfma_f32_32x32x16_bf16(kf[ks], qf[qb][ks], s, 0, 0, 0);
                if (!interior) { const int lo_rel = (br == 1) ? (qpos[qb] - 511 - nb) : -64, hi_rel = qpos[qb] - nb;
#pragma unroll
                    for (int i = 0; i < 16; ++i) { const bool ok = sb[qb] && (OFFI(i) <= hi_rel) && (OFFI(i) >= lo_rel); s[i] = ok ? s[i] : NEGS; } }
                float tm = xhalf_max(max16(s));
                const bool dead = tm < -1.0e37f;
                const float shift = dead ? 0.f : (un_ ? tm : (tm > 8.f ? tm : 0.f));
                if (__any(shift != 0.f)) {
                    const float al = un_ ? 1.f : ex2(-shift);
#pragma unroll
                    for (int i = 0; i < 16; ++i) s[i] -= shift;
                    st.l[qb] *= al;
#pragma unroll
                    for (int db = 0; db < 2; ++db)
#pragma unroll
                        for (int i = 0; i < 16; ++i) st.o[db][qb][i] *= al;
                }
                if (!dead) st.m[qb] = mref + shift;
                float sum = 0.f;
#pragma unroll
                for (int i = 0; i < 16; ++i) { s[i] = ex2(s[i]); sum += s[i]; }
                st.l[qb] += sum;
                pack_p(pf[qb], s);
                __builtin_amdgcn_sched_barrier(0);
            }
            if (nok) asm volatile("s_waitcnt vmcnt(8) lgkmcnt(0)" ::: "memory"); else asm volatile("s_waitcnt vmcnt(0) lgkmcnt(0)" ::: "memory");
#pragma unroll
            for (int db = 0; db < 2; ++db)
#pragma unroll
                for (int ks = 0; ks < 2; ++ks) { const bf16x8 vf = vfrag((pb ? wl + AL_V1 : vl) + (db ? voff1 : voff0), ks);
#pragma unroll
                    for (int qb = 0; qb < NQB; ++qb) if (act[qb]) st.o[db][qb] = __builtin_amdgcn_mfma_f32_32x32x16_bf16(vf, pf[qb][ks], st.o[db][qb], 0, 0, 0); }
            LDS_WAIT(); asm volatile("" ::: "memory");
            crow = nrow; cblk = nblk; cok = nok; pb ^= 1;
        }
#undef NEXT_TILE
        unsigned* stash = stash0; asm volatile("s_waitcnt vmcnt(0)" : "+v"(stash) :: "memory");
#pragma unroll
        for (int qb = 0; qb < NQB; ++qb) {
            const int tok = qb * 8 + (c >> 2);
            const float gbr = gates[((size_t)qrow0 + tok) * 48 + (4 * g + head) * 3 + 1 + br];
            const float lt = xhalf_sum(st.l[qb]); const float sc = lt > 0.f ? gbr / lt : 0.f;
            bf16* orow = Ob + ((size_t)qrow0 + tok) * DM + (4 * g + head) * 64;
#pragma unroll
            for (int db = 0; db < 2; ++db)
#pragma unroll
                for (int k = 0; k < 8; k += 2) {
                    const unsigned w0 = stash[((db * NQB + qb) * 8 + k) * 64], w1 = stash[((db * NQB + qb) * 8 + k + 1) * 64];
                    const float e0 = __uint_as_float(w0 << 16) + st.o[db][qb][2 * k] * sc, e1 = __uint_as_float(w0 & 0xffff0000u) + st.o[db][qb][2 * k + 1] * sc;
                    const float e2 = __uint_as_float(w1 << 16) + st.o[db][qb][2 * k + 2] * sc, e3 = __uint_as_float(w1 & 0xffff0000u) + st.o[db][qb][2 * k + 3] * sc;
                    if (br == 0) { stash[((db * NQB + qb) * 8 + k) * 64] = cvt_pk(e0, e1); stash[((db * NQB + qb) * 8 + k + 1) * 64] = cvt_pk(e2, e3); }
                    else { v2u w; w.x = cvt_pk(e0, e1); w.y = cvt_pk(e2, e3); *(v2u*)(orow + 32 * db + 8 * (k >> 1) + 4 * h) = w; }
                }
        }
        LDS_WAIT(); asm volatile("" ::: "memory");
    }
}

constexpr int CW_AQ = 8192;
__device__ __forceinline__ void attn_phase_v2(Frame& F, int qslot = 0) {
    LAS unsigned char* wl = F.lds + F.wave * WAVE_LDS;
    unsigned* qh = (unsigned*)(F.ws + WS_CTL) + CW_AQ + 64 * qslot;
    constexpr int NUP = NB * NG * (SEQ / 16), NUS = DB * NG;
    for (;;) {
        unsigned u = 0; if (F.lane == 0) u = atomicAdd(qh, 1u); u = __builtin_amdgcn_readfirstlane(u);
        if (u >= (unsigned)(NUP + NUS)) break;
        ASeq A;
        if (u >= (unsigned)NUS) {
            const unsigned v_ = u - NUS; const int tt = (SEQ / 16 - 1) - (int)(v_ >> 3), b = (v_ >> 2) & 1, g = v_ & 3;
            A.kc = (const bf16*)(F.ws + WS_KCP) + (size_t)(b * NG + g) * 512 * 64; A.vc = (const bf16*)(F.ws + WS_VCP) + (size_t)(b * NG + g) * 512 * 64; A.nc = NCP;
            A.ks = (const bf16*)(F.ws + WS_KVB) + (size_t)b * SEQ * 1024 + 512 + g * 64; A.spitch = 1024; A.srows = SEQ;
            A.kw = (const bf16*)(F.ws + WS_WINB) + (size_t)b * SEQ * 512 + g * 64; A.wpitch = 512; A.wrows = SEQ; A.wpos0 = 0; A.qpos0 = 0; A.ns = NSP;
            attn_unit<2>(F, A, b * SEQ + tt * 16, g, tt * 16, wl);
        } else {
            const int v = (int)u, s = v >> 2, g = v & 3;
            A.kc = (const bf16*)(F.ws + WS_KCS) + (size_t)(s * NG + g) * 128 * 64; A.vc = (const bf16*)(F.ws + WS_VCS) + (size_t)(s * NG + g) * 128 * 64; A.nc = NCS;
            A.ks = (const bf16*)(F.ws + WS_SELS) + (size_t)s * (PAST + DS) * 512 + g * 64; A.spitch = 512; A.srows = PAST + DS;
            A.kw = (const bf16*)(F.ws + WS_WINS) + (size_t)s * 520 * 512 + g * 64; A.wpitch = 512; A.wrows = 520; A.wpos0 = PAST - 512; A.qpos0 = PAST; A.ns = NSS;
            attn_unit<1>(F, A, MP + s * DS, g, 0, wl);
        }
    }
}
constexpr int S5L = 32;
__device__ __forceinline__ void cmul(float& r, float& i, float ar, float ai) { const float t = r * ar - i * ai; i = r * ai + i * ar; r = t; }

__device__ __forceinline__ void s5_tables_part(Frame& F, int g, int q, LAS float* sl) {
    LAS float* Bbr = sl; LAS float* Bbi = sl + 1024; LAS float* Cr = sl + 2048; LAS float* Ci = sl + 3072; LAS float* Ar = sl + 4096; LAS float* Ai = sl + 4160; LAS float* Qr = sl + 4224; LAS float* Qi = sl + 4288;
    const int tid = F.tid;
    bf16* KT = (bf16*)(F.ws + WS_S5K) + (size_t)g * 32 * 256; bf16* WE = (bf16*)(F.ws + WS_S5W) + (size_t)g * 128 * 512; bf16* VI = (bf16*)(F.ws + WS_S5V) + (size_t)g * 512 * 128;
    float* AL = (float*)(F.ws + WS_S5A) + (size_t)g * 128; float* A8 = (float*)(F.ws + WS_S5A) + 64 * 128 + (size_t)g * 128;
    const float* gn = F.in[I_NMIX] + DM;
    __syncthreads();
    if (tid < 64) {
        const int p = tid;
        const float are = F.in[I_ARE][g * 64 + p], aim = F.in[I_AIM][g * 64 + p], dt = expf(F.in[I_LDT][g]);
        const float er = expf(are * dt); float sn, cs; sincosf(aim * dt, &sn, &cs);
        const float abr = er * cs, abi = er * sn;
        const float nr = abr - 1.f, ni = abi, den = are * are + aim * aim;
        const float fr_ = (nr * are + ni * aim) / den, fi_ = (ni * are - nr * aim) / den;
        Ar[p] = abr; Ai[p] = abi;
#pragma unroll
        for (int c = 0; c < 16; ++c) { const float br = F.in[I_BRE][(g * 64 + p) * 16 + c], bi = F.in[I_BIM][(g * 64 + p) * 16 + c], gg = gn[g * 16 + c];
            Bbr[p * 16 + c] = (fr_ * br - fi_ * bi) * gg; Bbi[p * 16 + c] = (fr_ * bi + fi_ * br) * gg; }
        float r = abr, i = abi; cmul(r, i, r, i); cmul(r, i, r, i); cmul(r, i, r, i);
        float qr = 1.f, qi = 0.f;
        for (int k = 0; k < q; ++k) cmul(qr, qi, r, i);
        Qr[p] = qr; Qi[p] = qi;
        if (q == 0) { A8[p] = r; A8[64 + p] = i; cmul(r, i, r, i); cmul(r, i, r, i); AL[p] = r; AL[64 + p] = i; }
    }
    for (int e = tid; e < 1024; e += 512) { Cr[e] = F.in[I_CRE][g * 1024 + e]; Ci[e] = F.in[I_CIM][g * 1024 + e]; }
    __syncthreads();
    if (tid < 256) {
        const int c = tid >> 4, cp = tid & 15;
        float acc[8];
#pragma unroll
        for (int t = 0; t < 8; ++t) acc[t] = 0.f;
        for (int p = 0; p < 64; ++p) {
            const float cr = Cr[c * 64 + p], ci = Ci[c * 64 + p], br = Bbr[p * 16 + cp], bi = Bbi[p * 16 + cp], ar = Ar[p], ai = Ai[p];
            float mr = cr * br - ci * bi, mi = cr * bi + ci * br; cmul(mr, mi, Qr[p], Qi[p]);
#pragma unroll
            for (int t = 0; t < 8; ++t) { acc[t] += mr; cmul(mr, mi, ar, ai); }
        }
        if (q == 0 && c == cp) acc[0] += F.in[I_SD][g * 16 + c] * gn[g * 16 + c];
#pragma unroll
        for (int t = 0; t < 8; ++t) KT[(8 * q + t) * 256 + tid] = (bf16)f2bf(acc[t]);
    }
    {
        const int p = tid & 63, j = tid >> 6, sidx = 31 - 8 * q - j; const float ar = Ar[p], ai = Ai[p];
        float pr = Qr[p], pi = Qi[p];
        for (int k = 0; k < j; ++k) cmul(pr, pi, ar, ai);
        float wre[16], wim[16];
#pragma unroll
        for (int cp = 0; cp < 16; ++cp) { const float br = Bbr[p * 16 + cp], bi = Bbi[p * 16 + cp]; wre[cp] = pr * br - pi * bi; wim[cp] = pr * bi + pi * br; }
        v4u o;
        o.x = pk2(wre[0], wre[1]); o.y = pk2(wre[2], wre[3]); o.z = pk2(wre[4], wre[5]); o.w = pk2(wre[6], wre[7]); *(v4u*)(WE + (size_t)p * 512 + 16 * sidx) = o;
        o.x = pk2(wre[8], wre[9]); o.y = pk2(wre[10], wre[11]); o.z = pk2(wre[12], wre[13]); o.w = pk2(wre[14], wre[15]); *(v4u*)(WE + (size_t)p * 512 + 16 * sidx + 8) = o;
        o.x = pk2(wim[0], wim[1]); o.y = pk2(wim[2], wim[3]); o.z = pk2(wim[4], wim[5]); o.w = pk2(wim[6], wim[7]); *(v4u*)(WE + (size_t)(64 + p) * 512 + 16 * sidx) = o;
        o.x = pk2(wim[8], wim[9]); o.y = pk2(wim[10], wim[11]); o.z = pk2(wim[12], wim[13]); o.w = pk2(wim[14], wim[15]); *(v4u*)(WE + (size_t)(64 + p) * 512 + 16 * sidx + 8) = o;
    }
    {
        const int p = tid & 63, cq = tid >> 6; const float ar = Ar[p], ai = Ai[p];
        float pr = Qr[p], pi = Qi[p]; cmul(pr, pi, ar, ai);
        for (int j = 0; j < 8; ++j) { const int t = 8 * q + j;
#pragma unroll
            for (int k = 0; k < 2; ++k) { const int c = 2 * cq + k; const float cr = Cr[c * 64 + p], ci = Ci[c * 64 + p];
                VI[(size_t)(16 * t + c) * 128 + p] = (bf16)f2bf(cr * pr - ci * pi); VI[(size_t)(16 * t + c) * 128 + 64 + p] = (bf16)f2bf(-(cr * pi + ci * pr)); }
            cmul(pr, pi, ar, ai);
        }
    }
    __syncthreads();
}
__device__ __forceinline__ void s5_tables(Frame& F) { for (int u = blockIdx.x; u < 256; u += gridDim.x) s5_tables_part(F, u >> 2, u & 3, (LAS float*)F.lds); }

__device__ __forceinline__ bf16x8 s5_ufrag(const bf16* XG, const float* ss, int row, int col) {
    const v4u w = *(const v4u*)(XG + ((size_t)(col >> 4) * M + row) * 16 + (col & 15)); const float rs = rsqrtf(ss[row] * (1.f / DM) + EPS);
    v4u o; o.x = cvt_pk(__uint_as_float(w.x << 16) * rs, __uint_as_float(w.x & 0xffff0000u) * rs); o.y = cvt_pk(__uint_as_float(w.y << 16) * rs, __uint_as_float(w.y & 0xffff0000u) * rs);
    o.z = cvt_pk(__uint_as_float(w.z << 16) * rs, __uint_as_float(w.z & 0xffff0000u) * rs); o.w = cvt_pk(__uint_as_float(w.w << 16) * rs, __uint_as_float(w.w & 0xffff0000u) * rs);
    return __builtin_bit_cast(bf16x8, o);
}
__device__ __forceinline__ bf16x8 ldfrag(const bf16* p) { return *(const bf16x8*)p; }
__device__ __forceinline__ void s5_store_z(bf16* Z, const f32x16& y, size_t row_t0, int g, int h) {
#pragma unroll
    for (int q = 0; q < 4; ++q) { v2u w; w.x = cvt_pk(gelu_tanh_div(y[4 * q]), gelu_tanh_div(y[4 * q + 1])); w.y = cvt_pk(gelu_tanh_div(y[4 * q + 2]), gelu_tanh_div(y[4 * q + 3]));
        *(v2u*)(Z + (row_t0 + (q >> 1)) * DM + g * 16 + 8 * (q & 1) + 4 * h) = w; }
}

constexpr int S5_EP = 65;
constexpr int S5_HP = 136;
constexpr int S5_XP = 1040;
constexpr int S5_LE = 0, S5_LH = 128 * S5_EP * 4, S5_LX = S5_LH + 64 * S5_HP * 2, S5_LK = S5_LX + 64 * S5_XP, S5_LEND = S5_LK + 16384;
static_assert(S5_LEND <= MISC_OFF, "S5 LDS map");
__device__ __forceinline__ void s5_prompt_unit(Frame& F, int b, int g, const bf16* XG, const float* ss) {
    LAS float* E = (LAS float*)(F.lds + S5_LE); LAS bf16* Hp = (LAS bf16*)(F.lds + S5_LH); LAS unsigned char* xs = F.lds + S5_LX; LAS unsigned char* kt = F.lds + S5_LK;
    const int w = F.wave;
    const bf16* KT = (const bf16*)(F.ws + WS_S5K) + (size_t)g * 32 * 256; const bf16* WE = (const bf16*)(F.ws + WS_S5W) + (size_t)g * 128 * 512; const bf16* VI = (const bf16*)(F.ws + WS_S5V) + (size_t)g * 512 * 128;
    const float* AL = (const float*)(F.ws + WS_S5A) + (size_t)g * 128;
    bf16* Z = (bf16*)(F.ws + WS_Z);
    float hr = 0.f, hi = 0.f, alr = 0.f, ali = 0.f;
    if (w == 0) { alr = AL[F.lane]; ali = AL[64 + F.lane]; }
    const int cb = w >> 2, rq = w & 3;
    __syncthreads();
    { const int tid = F.tid; const v4u* src = (const v4u*)KT; LAS v4u* dst = (LAS v4u*)kt; dst[tid] = src[tid]; dst[tid + 512] = src[tid + 512]; }
    v4u xv[8]; float rv[8];
    { const int tid = F.tid; const bf16* xsrc = XG + ((size_t)g * M + (size_t)b * SEQ) * 16;
#pragma unroll
      for (int k = 0; k < 8; ++k) { const int e = tid + 512 * k; xv[k] = *(const v4u*)(xsrc + (size_t)e * 8); rv[k] = ss[b * SEQ + (e >> 1)]; } }
    for (int seg = 0; seg < 4; ++seg) {
        int lane_ = F.lane; asm volatile("" : "+v"(lane_));
        const int lane = lane_ & 63, tid = w * 64 + lane, h = lane >> 5, c31 = lane & 31;
        const int srow0 = b * SEQ + seg * 2048;
        bf16x8 wfr[32];
        { const bf16* wp = WE + (size_t)(32 * rq + c31) * 512 + 8 * h;
#pragma unroll
          for (int s = 0; s < 32; ++s) wfr[s] = ldfrag(wp + 16 * s); }
        {
#pragma unroll
            for (int k = 0; k < 8; ++k) { const int e = tid + 512 * k, tok = e >> 1; const float rs = rsqrtf(rv[k] * (1.f / DM) + EPS); const v4u w4 = xv[k];
                v4u o; o.x = cvt_pk(__uint_as_float(w4.x << 16) * rs, __uint_as_float(w4.x & 0xffff0000u) * rs); o.y = cvt_pk(__uint_as_float(w4.y << 16) * rs, __uint_as_float(w4.y & 0xffff0000u) * rs);
                o.z = cvt_pk(__uint_as_float(w4.z << 16) * rs, __uint_as_float(w4.z & 0xffff0000u) * rs); o.w = cvt_pk(__uint_as_float(w4.w << 16) * rs, __uint_as_float(w4.w & 0xffff0000u) * rs);
                *(LAS v4u*)(xs + (tok >> 5) * S5_XP + (tok & 31) * 32 + (e & 1) * 16) = o; }
        }
        __syncthreads();
        LAS const unsigned char* xl = xs + (32 * cb + c31) * S5_XP + 16 * h;
        const int row0 = srow0 + (32 * cb + c31) * S5L;
        {
            f32x16 acc;
#pragma unroll
            for (int i = 0; i < 16; ++i) acc[i] = 0.f;
#pragma unroll
            for (int s = 0; s < 32; ++s) acc = __builtin_amdgcn_mfma_f32_32x32x16_bf16(wfr[s], *(LAS const bf16x8*)(xl + 32 * s), acc, 0, 0, 0);
#pragma unroll
            for (int i = 0; i < 16; ++i) E[(32 * rq + (i & 3) + 8 * (i >> 2) + 4 * h) * S5_EP + 32 * cb + c31] = acc[i];
        }
        __syncthreads();
        if (w == 0) {
            for (int j0 = 0; j0 < 64; j0 += 8) {
                float er[8], ei[8];
#pragma unroll
                for (int j = 0; j < 8; ++j) { er[j] = E[lane * S5_EP + j0 + j]; ei[j] = E[(64 + lane) * S5_EP + j0 + j]; }
#pragma unroll
                for (int j = 0; j < 8; ++j) {
                    Hp[(j0 + j) * S5_HP + lane] = (bf16)f2bf(hr); Hp[(j0 + j) * S5_HP + 64 + lane] = (bf16)f2bf(hi);
                    cmul(hr, hi, alr, ali); hr += er[j]; hi += ei[j];
                }
            }
        }
        __syncthreads();
        if (seg < 3) {
            const bf16* xsrc = XG + ((size_t)g * M + srow0 + 2048) * 16;
#pragma unroll
            for (int k = 0; k < 8; ++k) { const int e = tid + 512 * k; xv[k] = *(const v4u*)(xsrc + (size_t)e * 8); rv[k] = ss[srow0 + 2048 + (e >> 1)]; }
        }
        {
            f32x16 acc[4];
#pragma unroll
            for (int i4 = 0; i4 < 4; ++i4)
#pragma unroll
                for (int i = 0; i < 16; ++i) acc[i4][i] = 0.f;
            const int tin = c31 >> 4, cc = c31 & 15;
            bf16x8 vi[4][4];
#pragma unroll
            for (int ks = 0; ks < 4; ++ks)
#pragma unroll
                for (int i4 = 0; i4 < 4; ++i4) vi[ks][i4] = ldfrag(VI + (size_t)(32 * (rq + 4 * i4) + c31) * 128 + 16 * ks + 8 * h);
#pragma unroll 4
            for (int s = 0; s < 32; ++s) {
                const bf16x8 uf = *(LAS const bf16x8*)(xl + 32 * s);
#pragma unroll
                for (int i4 = 0; i4 < 4; ++i4) { const int tau = 2 * (rq + 4 * i4) + tin - s;
                    if (s <= 2 * (rq + 4 * i4) + 1) {
                        bf16x8 a = *(LAS const bf16x8*)(kt + (tau < 0 ? 0 : tau) * 512 + cc * 32 + 16 * h);
                        if (tau < 0) a = (bf16x8){0, 0, 0, 0, 0, 0, 0, 0};
                        acc[i4] = __builtin_amdgcn_mfma_f32_32x32x16_bf16(a, uf, acc[i4], 0, 0, 0); } }
            }
#pragma unroll
            for (int ks = 0; ks < 4; ++ks) {
                const bf16x8 hf = *(LAS const bf16x8*)(Hp + (32 * cb + c31) * S5_HP + 16 * ks + 8 * h);
#pragma unroll
                for (int i4 = 0; i4 < 4; ++i4) acc[i4] = __builtin_amdgcn_mfma_f32_32x32x16_bf16(vi[ks][i4], hf, acc[i4], 0, 0, 0);
            }
#pragma unroll
            for (int ks = 0; ks < 4; ++ks)
#pragma unroll
                for (int i4 = 0; i4 < 4; ++i4) vi[ks][i4] = ldfrag(VI + (size_t)(32 * (rq + 4 * i4) + c31) * 128 + 16 * (ks + 4) + 8 * h);
#pragma unroll
            for (int ks = 0; ks < 4; ++ks) {
                const bf16x8 hf = *(LAS const bf16x8*)(Hp + (32 * cb + c31) * S5_HP + 16 * (ks + 4) + 8 * h);
#pragma unroll
                for (int i4 = 0; i4 < 4; ++i4) acc[i4] = __builtin_amdgcn_mfma_f32_32x32x16_bf16(vi[ks][i4], hf, acc[i4], 0, 0, 0);
            }
#pragma unroll
            for (int i4 = 0; i4 < 4; ++i4) s5_store_z(Z, acc[i4], (size_t)row0 + 2 * (rq + 4 * i4), g, h);
        }
        __syncthreads();
    }
    if (w == 0) { F.out[O_SREP + ((size_t)b * 64 + g) * 64 + F.lane] = hr; F.out[O_SIMP + ((size_t)b * 64 + g) * 64 + F.lane] = hi; }
}

__device__ __forceinline__ void s5_sample_unit(Frame& F, int g, int cb, const bf16* XB, const float* ss) {
    const int lane = F.lane, h = lane >> 5, c31 = lane & 31, seq = 32 * cb + c31;
    const bf16* KT = (const bf16*)(F.ws + WS_S5K) + (size_t)g * 32 * 256; const bf16* WE = (const bf16*)(F.ws + WS_S5W) + (size_t)g * 128 * 512; const bf16* VI = (const bf16*)(F.ws + WS_S5V) + (size_t)g * 512 * 128;
    const float* A8 = (const float*)(F.ws + WS_S5A) + 64 * 128 + (size_t)g * 128;
    bf16* Z = (bf16*)(F.ws + WS_Z);
    const int row0 = MP + seq * DS;
    bf16x8 uf[8];
#pragma unroll
    for (int s = 0; s < 8; ++s) uf[s] = s5_ufrag(XB, ss, row0 + s, g * 16 + 8 * h);
    const float* h0r = F.in[I_SRE] + ((size_t)seq * 64 + g) * 64; const float* h0i = F.in[I_SIM] + ((size_t)seq * 64 + g) * 64;
    {
        f32x16 acc[4];
#pragma unroll
        for (int rb = 0; rb < 4; ++rb)
#pragma unroll
            for (int i = 0; i < 16; ++i) acc[rb][i] = 0.f;
        const int tin = c31 >> 4, cc = c31 & 15;
#pragma unroll
        for (int s = 0; s < 8; ++s)
#pragma unroll
            for (int rb = 0; rb < 4; ++rb) if (s <= 2 * rb + 1) { const int tau = 2 * rb + tin - s;
                bf16x8 a = ldfrag(KT + (size_t)(tau < 0 ? 0 : tau) * 256 + cc * 16 + 8 * h); if (tau < 0) a = (bf16x8){0, 0, 0, 0, 0, 0, 0, 0};
                acc[rb] = __builtin_amdgcn_mfma_f32_32x32x16_bf16(a, uf[s], acc[rb], 0, 0, 0); }
#pragma unroll
        for (int ks = 0; ks < 8; ++ks) {
            const float* hp = (ks < 4 ? h0r : h0i) + 16 * (ks & 3) + 8 * h;
            const f32x4 x0 = ld4(hp), x1 = ld4(hp + 4);
            v4u o; o.x = cvt_pk(x0[0], x0[1]); o.y = cvt_pk(x0[2], x0[3]); o.z = cvt_pk(x1[0], x1[1]); o.w = cvt_pk(x1[2], x1[3]);
            const bf16x8 hf = __builtin_bit_cast(bf16x8, o);
#pragma unroll
            for (int rb = 0; rb < 4; ++rb) acc[rb] = __builtin_amdgcn_mfma_f32_32x32x16_bf16(ldfrag(VI + (size_t)(32 * rb + c31) * 128 + 16 * ks + 8 * h), hf, acc[rb], 0, 0, 0);
        }
#pragma unroll
        for (int rb = 0; rb < 4; ++rb) s5_store_z(Z, acc[rb], (size_t)row0 + 2 * rb, g, h);
    }
    {
        f32x16 acc[4];
#pragma unroll
        for (int rb = 0; rb < 4; ++rb)
#pragma unroll
            for (int i = 0; i < 16; ++i) acc[rb][i] = 0.f;
#pragma unroll
        for (int s = 0; s < 8; ++s)
#pragma unroll
            for (int rb = 0; rb < 4; ++rb) acc[rb] = __builtin_amdgcn_mfma_f32_32x32x16_bf16(ldfrag(WE + (size_t)(32 * rb + c31) * 512 + 16 * (24 + s) + 8 * h), uf[s], acc[rb], 0, 0, 0);
        float* ore = F.out + O_SRES + ((size_t)seq * 64 + g) * 64; float* oim = F.out + O_SIMS + ((size_t)seq * 64 + g) * 64;
#pragma unroll
        for (int rb = 0; rb < 2; ++rb)
#pragma unroll
            for (int i = 0; i < 16; ++i) { const int p = 32 * rb + (i & 3) + 8 * (i >> 2) + 4 * h;
                const float xr = h0r[p], xi = h0i[p], ar = A8[p], ai = A8[64 + p];
                ore[p] = acc[rb][i] + (ar * xr - ai * xi); oim[p] = acc[rb + 2][i] + (ar * xi + ai * xr); }
    }
}

__device__ __forceinline__ void s5_phase_v2(Frame& F) {
    const bf16* XB = (const bf16*)(F.ws + WS_XG); const float* ss = F.SS(3);
    const int G = gridDim.x, bid = blockIdx.x;
    const int npw = (G >= 256) ? 128 : G;
    if (bid < npw) { for (int u = bid; u < NB * 64; u += npw) s5_prompt_unit(F, u >> 6, u & 63, XB, ss); }
    const int ws0 = (G >= 256) ? 128 : 0, nsw = (G - ws0) * NWAVES;
    if (bid >= ws0) { for (int u = (bid - ws0) * NWAVES + F.wave; u < 64 * 4; u += nsw) s5_sample_unit(F, u >> 2, u & 3, XB, ss); }
}
#ifndef MK_ONE_LAUNCH
#define MK_ONE_LAUNCH 0
#endif
constexpr int N_PHASES = 17;
#define GP(EPI) pg8::gemm_phase<EPI, pg8::StaticOrder, true, true>
#define REFRESH() do { F.lane = mk_lane(); F.tid = F.wave * 64 + F.lane; } while (0)

__global__ void __launch_bounds__(NWAVES * 64, 2) nsa_s5_fwd(Args args) {
    extern __shared__ __attribute__((aligned(16))) unsigned char lds[];
    Frame F;
    F.lds = (LAS unsigned char*)lds;
    F.wave = __builtin_amdgcn_readfirstlane((int)(threadIdx.x >> 6)); F.lane = mk_lane(); F.tid = F.wave * 64 + F.lane;
    F.gw = blockIdx.x * NWAVES + F.wave; F.NGW = gridDim.x * NWAVES;
    F.ws = args.ws; F.out = args.out; F.in = args.in; F.pt = args.page_table;
    volatile LAS unsigned* MISC = (volatile LAS unsigned*)(F.lds + MISC_OFF);
    if (F.tid < 64) MISC[F.tid] = 0u;
    __syncthreads();
#if MK_ONE_LAUNCH
    XcdBarrier bar = xcd_barrier_post((unsigned*)(F.ws + WS_CTL) + CW_BAR, MISC + 8, (unsigned)F.wave);
#define GRID_BAR() xcd_barrier(bar)
#else
#define GRID_BAR() do {} while (0)
#endif
    const int lo = args.ph_lo, hi = args.ph_hi;
#ifndef PHMASK
#define PHMASK 0x1ffff
#endif
#define IN(k) ((((PHMASK) >> (k)) & 1) && lo <= (k) && (k) < hi)
#define SEAM(k) do { if (IN(k) && IN((k) + 1)) GRID_BAR(); } while (0)
    unsigned char* ws = F.ws;
    LAS unsigned char* ring = F.lds;
    const int G = gridDim.x, cid = blockIdx.x;

    const bool split1 = (G == 256); const int j1 = cid >> 3; const bool streamer = split1 && (j1 & 1) == 0;
    const int G1 = split1 ? 128 : G, c1 = split1 ? ((j1 >> 1) * 8 + (cid & 7)) : cid;
    if (IN(0)) { REFRESH(); p0_prologue(F); if (!split1) p0_stream(F, F.gw, F.NGW, 0, DB * PAST, true); SEAM(0); }

    if (IN(1)) {
        if (streamer) { REFRESH(); p0_stream(F, c1 * NWAVES + F.wave, 128 * NWAVES, 0, DB * PAST / 8 * 7, true); }
        else {
        { pg8::Gemm g{(const bf16*)(ws + WS_XBA), (const bf16*)(ws + WS_WIN_T), M, NINP, DM}; pg8::StaticOrder S; S.init(M, NINP, G1, c1);
          EpiAttnIn E{ws, F.out};
          GP(EpiAttnIn)(ring, g, S, E, F.wave); }
        { int kp = PLE; asm volatile("" : "+s"(kp));
          { pg8::Gemm g{(const bf16*)(ws + WS_PB0), (const bf16*)(ws + WS_WP_T0), MP, DM, kp}; pg8::StaticOrder S; S.init(MP, DM, G1, c1);
            EpiPlain E{(bf16*)(ws + WS_PP0), DM}; GP(EpiPlain)(ring, g, S, E, F.wave); }
          REFRESH(); sample_plain_sub(F, (const bf16*)(ws + WS_PB0), PLE, (const bf16*)(ws + WS_WP_T0), kp, (bf16*)(ws + WS_PP0), c1, G1); }
          if (split1) { REFRESH(); p0_stream(F, c1 * NWAVES + F.wave, 128 * NWAVES, DB * PAST / 8 * 7, DB * PAST, false); }
        }
        SEAM(1);
    }
    if (IN(2)) {
        REFRESH(); sample_cmp_pages(F);
        REFRESH(); prompt_cmp(F);
        SEAM(2);
    }
    if (IN(3)) { REFRESH(); cmp_finalize(F); s5_tables(F); SEAM(3); }
    if (IN(4)) { REFRESH(); attn_phase_v2(F); SEAM(4); }
    if (IN(5)) {
        pg8::Gemm g{(const bf16*)(ws + WS_OB), (const bf16*)(ws + WS_WOUT_T), MP, DM, DM}; pg8::StaticOrder S; S.init(MP, DM, G, cid);
        EpiResid E{(const bf16*)(ws + WS_XBA), (bf16*)(ws + WS_XBB), F.SS(1)};
        GP(EpiResid)(ring, g, S, E, F.wave);
        REFRESH(); sample_resid(F, (const bf16*)(ws + WS_OB), DM, (const bf16*)(ws + WS_WOUT_T), DM, (const bf16*)(ws + WS_XBA), (bf16*)(ws + WS_XBB), F.SS(1));
        SEAM(5);
    }
#define LAYER_BODY(layer) do { \
        const int pb = layer ? 12 : 6; \
        bf16* xb_up = (bf16*)(ws + (layer ? WS_XBA : WS_XBB)); \
        bf16* xb_dn = (bf16*)(ws + (layer ? WS_XBB : WS_XBA)); \
        if (layer == 1) { \
            if (IN(10)) { REFRESH(); s5_phase_v2(F); \
                if (G >= 256 && cid >= 128) {     \
                    int kp = PLE; asm volatile("" : "+s"(kp)); \
                    pg8::Gemm g{(const bf16*)(ws + WS_PB1), (const bf16*)(ws + WS_WP_T1), MP, DM, kp}; pg8::StaticOrder S; S.init(MP, DM, 128, cid - 128); \
                    EpiPlain E{(bf16*)(ws + WS_PP1), DM}; GP(EpiPlain)(ring, g, S, E, F.wave); \
                    REFRESH(); sample_plain_sub(F, (const bf16*)(ws + WS_PB1), PLE, (const bf16*)(ws + WS_WP_T1), kp, (bf16*)(ws + WS_PP1), cid - 128, 128); \
                } else if (G < 256) { \
                    int kp = PLE; asm volatile("" : "+s"(kp)); \
                    pg8::Gemm g{(const bf16*)(ws + WS_PB1), (const bf16*)(ws + WS_WP_T1), MP, DM, kp}; pg8::StaticOrder S; S.init(MP, DM, G, cid); \
                    EpiPlain E{(bf16*)(ws + WS_PP1), DM}; GP(EpiPlain)(ring, g, S, E, F.wave); \
                    REFRESH(); sample_plain_sub(F, (const bf16*)(ws + WS_PB1), PLE, (const bf16*)(ws + WS_WP_T1), kp, (bf16*)(ws + WS_PP1), cid, G); \
                } \
                SEAM(10); } \
            if (IN(11)) { \
                pg8::Gemm g{(const bf16*)(ws + WS_Z), (const bf16*)(ws + WS_WGLU_T), MP, 2 * DM, DM}; pg8::StaticOrder S; S.init(MP, 2 * DM, G, cid); \
                EpiGlu E{xb_dn, xb_up, F.SS(4)}; \
                GP(EpiGlu)(ring, g, S, E, F.wave); \
                REFRESH(); sample_glu(F, (const bf16*)(ws + WS_Z), (const bf16*)(ws + WS_WGLU_T), xb_dn, xb_up, F.SS(4)); \
                SEAM(11); \
            } \
        } \
        if (IN(pb)) { \
            pg8::Gemm g{xb_up, (const bf16*)(ws + (layer ? WS_WUP_T1 : WS_WUP_T0)), M, 2 * FF, DM}; pg8::StaticOrder S; S.init(M, 2 * FF, G, cid); \
            EpiUpFused E{ws, F.out, F.in[I_CONVW] + (size_t)layer * 3 * FF, F.in[I_CONVB] + (size_t)layer * FF, F.in[I_SCONV] + (size_t)layer * DB * 2 * FF, layer, F.lds}; \
            GP(EpiUpFused)(ring, g, S, E, F.wave); \
            SEAM(pb); \
        } \
        if (IN(pb + 2)) { \
            pg8::Gemm g{(const bf16*)(ws + WS_ACT), (const bf16*)(ws + (layer ? WS_WDN_T1 : WS_WDN_T0)), MP, DM, FF}; pg8::StaticOrder S; S.init(MP, DM, G, cid); \
            { REFRESH(); pg8::Unit uu; for (int i = 0; S.next(i, uu); ++i) { if (uu.pm < MP / 256 && (uu.pm & 31) != 0) up_fix(ws, F.in[I_CONVW] + (size_t)layer * 3 * FF, F.in[I_CONVB] + (size_t)layer * FF, uu.pm, F.tid); } \
              VM_WAIT(); __syncthreads(); } \
            EpiResid E{xb_up, xb_dn, F.SS(layer ? 5 : 2)}; \
            GP(EpiResid)(ring, g, S, E, F.wave); \
            REFRESH(); sample_resid(F, (const bf16*)(ws + WS_ACT), FF, (const bf16*)(ws + (layer ? WS_WDN_T1 : WS_WDN_T0)), FF, xb_up, xb_dn, F.SS(layer ? 5 : 2)); \
            SEAM(pb + 2); \
        } \
        if (IN(pb + 3)) { \
            pg8::Gemm g{xb_dn, (const bf16*)(ws + (layer ? WS_WG_T1 : WS_WG_T0)), MP, DM, DM}; pg8::StaticOrder S; S.init(MP, DM, G, cid); \
            EpiGate E{F.SS(layer ? 5 : 2), (const bf16*)(ws + (layer ? WS_PP1 : WS_PP0)), xb_dn, xb_up, F.SS(layer ? 6 : 3), layer ? (bf16*)nullptr : (bf16*)(ws + WS_XG)}; \
            GP(EpiGate)(ring, g, S, E, F.wave); \
            REFRESH(); sample_gate(F, xb_dn, (const bf16*)(ws + (layer ? WS_WG_T1 : WS_WG_T0)), F.SS(layer ? 5 : 2), (const bf16*)(ws + (layer ? WS_PP1 : WS_PP0)), xb_dn, xb_up, layer ? (bf16*)nullptr : (bf16*)(ws + WS_XG), F.SS(layer ? 6 : 3)); \
            SEAM(pb + 3); \
        } \
    } while (0)
    LAYER_BODY(0);
    LAYER_BODY(1);
#undef LAYER_BODY
    if (IN(16)) { REFRESH(); final_norm(F); }
#undef IN
#undef SEAM
}

extern "C" void kernel_launch(void* const* d_in, const int* in_sizes, int n_in, void* d_out, int out_size, void* d_ws, size_t ws_size, hipStream_t stream) {
    static int grid = 0;
    if (grid == 0) {
        if (n_in != 34 || out_size != (int)O_END || ws_size < WS_END) { fprintf(stderr, "kernel_launch: unexpected sizes n_in %d out %d ws %zu\n", n_in, out_size, ws_size); grid = -1; return; }
        int dev = 0, cus = 0, per_cu = 0;
        if (hipGetDevice(&dev) != hipSuccess || hipDeviceGetAttribute(&cus, hipDeviceAttributeMultiprocessorCount, dev) != hipSuccess) { grid = -1; return; }
        if (hipFuncSetAttribute((const void*)nsa_s5_fwd, hipFuncAttributeMaxDynamicSharedMemorySize, LDS_BYTES) != hipSuccess) { fprintf(stderr, "kernel_launch: hipFuncSetAttribute failed\n"); grid = -1; return; }
        if (hipOccupancyMaxActiveBlocksPerMultiprocessor(&per_cu, (const void*)nsa_s5_fwd, NWAVES * 64, LDS_BYTES) != hipSuccess || per_cu < 1)
            fprintf(stderr, "kernel_launch: occupancy query reports %d blocks per CU\n", per_cu);
        (void)hipGetLastError();
        grid = cus;
    }
    if (grid < 0) return;
    (void)hipMemsetAsync((char*)d_ws + WS_CTL, 0, CTL_ZERO_BYTES, stream);
    Args a{};
    for (int i = 0; i < 34; ++i) a.in[i] = (const float*)d_in[i];
    a.page_table = (const int*)d_in[I_PT]; a.out = (float*)d_out; a.ws = (unsigned char*)d_ws;
#if MK_ONE_LAUNCH
    a.ph_lo = 0; a.ph_hi = N_PHASES;
    hipLaunchKernelGGL(nsa_s5_fwd, dim3(grid), dim3(NWAVES * 64), LDS_BYTES, stream, a);
#else
    for (int p = 0; p < N_PHASES; ++p) { a.ph_lo = p; a.ph_hi = p + 1; hipLaunchKernelGGL(nsa_s5_fwd, dim3(grid), dim3(NWAVES * 64), LDS_BYTES, stream, a); }
#endif
}
```

```cpp
#include <hip/hip_runtime.h>
#include <cstdio>
#include <cstdint>

#define GAS __attribute__((address_space(1)))
#define LAS __attribute__((address_space(3)))
typedef unsigned short bf16;
typedef unsigned v4u __attribute__((ext_vector_type(4)));
typedef unsigned v2u __attribute__((ext_vector_type(2)));
typedef float f32x4 __attribute__((ext_vector_type(4)));
typedef float f32x2 __attribute__((ext_vector_type(2)));
typedef short bf16x8 __attribute__((ext_vector_type(8)));
typedef float f32x16 __attribute__((ext_vector_type(16)));

constexpr int DM = 1024, SEQ = 8192, NB = 2, MP = NB * SEQ  , DB = 128, DS = 8, MS = DB * DS  , M = MP + MS  ;
constexpr int PAST = 2048, PAGE = 128, NPAGES = PAST / PAGE  ;
constexpr int NH = 16, HD = 64, NG = 4;
constexpr int NIN = 2608, NINP = 2816;
constexpr int FF = 2816, PLE = 256;
constexpr int NCP = 511, NCS = 127;
constexpr int NSP = 128, NSS = 33;
constexpr float EPS = 1e-6f;
constexpr int CMP_ROWS_P = 2 * NB * 512 * NG;
constexpr int CMP_ROWS_S = 2 * DB * 128 * NG;
constexpr int CMP_ROWS = CMP_ROWS_P + CMP_ROWS_S;

constexpr size_t MiB = 1u << 20;
constexpr size_t WS_CTL = 0, CTL_ZERO_BYTES = 2 * MiB;
constexpr size_t WS_WIN_T = 2 * MiB, WS_WOUT_T = 8 * MiB, WS_WUP_T0 = 10 * MiB, WS_WUP_T1 = 21 * MiB, WS_WDN_T0 = 32 * MiB, WS_WDN_T1 = 38 * MiB;
constexpr size_t WS_WP_T0 = 44 * MiB, WS_WP_T1 = 45 * MiB, WS_WG_T0 = 47 * MiB, WS_WG_T1 = 49 * MiB, WS_WGLU_T = 51 * MiB, WS_W1R_T = 55 * MiB, WS_CVEC = 55 * MiB + 768 * 1024, WS_S5TAB = 56 * MiB;
constexpr size_t WS_XBA = 64 * MiB, WS_XBB = 98 * MiB, WS_XR = 132 * MiB, WS_QB = 200 * MiB, WS_OB = 234 * MiB, WS_KVB = 268 * MiB, WS_WINB = 302 * MiB, WS_GATES = 319 * MiB;
constexpr size_t WS_KCP = 323 * MiB, WS_VCP = 323 * MiB + 512 * 1024, WS_KCS = 324 * MiB, WS_VCS = 332 * MiB, WS_CMPA = 340 * MiB, WS_PBUF = 612 * MiB;
constexpr size_t WS_HG = 680 * MiB, WS_ACT = 867 * MiB, WS_PB0 = 961 * MiB, WS_PB1 = 970 * MiB, WS_PP0 = 979 * MiB, WS_PP1 = 1013 * MiB, WS_Z = 1047 * MiB, WS_SELS = 1081 * MiB, WS_WINS = 1340 * MiB, WS_S5K = 1407 * MiB, WS_S5W = 1408 * MiB, WS_S5V = 1416 * MiB, WS_S5A = 1424 * MiB, WS_HALOA = 1425 * MiB, WS_HALOB = 1429 * MiB, WS_S5E = 1431 * MiB, WS_S5H = 1448 * MiB, WS_STASH = 1457 * MiB, WS_XG = 1474 * MiB, WS_END = 1509 * MiB;
constexpr int CW_TMO = 0, CW_BAR = 4096, CW_SS = 65536;
static_assert((CW_SS + 7 * M) * 4 <= (int)CTL_ZERO_BYTES, "ctl words inside the memset region");

constexpr int NWAVES = 8;
constexpr int RING_BYTES = 131072;
constexpr int WAVE_LDS = 18432;
constexpr int MISC_OFF = NWAVES * WAVE_LDS;
constexpr int LDS_BYTES = MISC_OFF + 256;

#define RLX_AGENT __ATOMIC_RELAXED, __HIP_MEMORY_SCOPE_AGENT
#define LDS_WAIT() asm volatile("s_waitcnt lgkmcnt(0)" ::: "memory")
#define VM_WAIT() asm volatile("s_waitcnt vmcnt(0)" ::: "memory")

__device__ __forceinline__ float bf2f(bf16 v) { return __uint_as_float(((unsigned)v) << 16); }
__device__ __forceinline__ unsigned f2bf(float f) { unsigned u = __builtin_bit_cast(unsigned, f); return (u + 0x7fffu + ((u >> 16) & 1u)) >> 16; }
__device__ __forceinline__ unsigned cvt_pk(float lo, float hi) { unsigned r; asm("v_cvt_pk_bf16_f32 %0, %1, %2" : "=v"(r) : "v"(lo), "v"(hi)); return r; }
__device__ __forceinline__ unsigned pk2(float lo, float hi) { return cvt_pk(lo, hi); }
__device__ __forceinline__ v4u pk8(f32x4 a, f32x4 b) { v4u w; w.x = pk2(a[0], a[1]); w.y = pk2(a[2], a[3]); w.z = pk2(b[0], b[1]); w.w = pk2(b[2], b[3]); return w; }
__device__ __forceinline__ float wave_sum(float v) {
#pragma unroll
    for (int o = 1; o < 64; o <<= 1) v += __shfl_xor(v, o);
    return v;
}
__device__ __forceinline__ float wave_max(float v) {
#pragma unroll
    for (int o = 1; o < 64; o <<= 1) v = fmaxf(v, __shfl_xor(v, o));
    return v;
}
__device__ __forceinline__ float sigmoidf_(float x) { return __builtin_amdgcn_rcpf(1.f + __builtin_amdgcn_exp2f(-1.4426950408889634f * x)); }
__device__ __forceinline__ float gelu_tanh(float x) { constexpr float K1 = -2.f * 0.7978845608028654f * 1.4426950408889634f, K2 = K1 * 0.044715f;
    const float t = x * __builtin_fmaf(x * x, K2, K1); return x * __builtin_amdgcn_rcpf(1.f + __builtin_amdgcn_exp2f(t)); }
__device__ __forceinline__ float gelu_tanh_div(float x) { const float y = 0.7978845608028654f * (x + 0.044715f * x * x * x); return x / (1.f + __expf(-2.f * y)); }
__device__ __forceinline__ f32x4 ld4(const float* p) { return *(const f32x4*)p; }
__device__ __forceinline__ void st4(float* p, f32x4 v) { *(f32x4*)p = v; }
constexpr size_t O_YP = 0, O_YS = O_YP + (size_t)MP * DM, O_KVP = O_YS + (size_t)MS * DM, O_KVS = O_KVP + (size_t)MP * 1024, O_WINP = O_KVS + (size_t)MS * 1024,
                 O_WINS = O_WINP + (size_t)NB * 512 * 512, O_SREP = O_WINS + (size_t)DB * 512 * 512, O_SIMP = O_SREP + NB * 64 * 64, O_SRES = O_SIMP + NB * 64 * 64,
                 O_SIMS = O_SRES + (size_t)DB * 64 * 64, O_CONVP = O_SIMS + (size_t)DB * 64 * 64, O_CONVS = O_CONVP + 2 * NB * 2 * FF, O_END = O_CONVS + (size_t)2 * DB * 2 * FF;
static_assert(O_END == 72259584, "output size");
__device__ __forceinline__ int mk_lane() { int l; asm volatile("v_mbcnt_lo_u32_b32 %0, -1, 0\n\tv_mbcnt_hi_u32_b32 %0, -1, %0" : "=v"(l)); return l & 63; }
__device__ __forceinline__ void unpk8(v4u w, f32x4& a, f32x4& b) { a[0] = __uint_as_float(w.x << 16); a[1] = __uint_as_float(w.x & 0xffff0000u); a[2] = __uint_as_float(w.y << 16); a[3] = __uint_as_float(w.y & 0xffff0000u);
    b[0] = __uint_as_float(w.z << 16); b[1] = __uint_as_float(w.z & 0xffff0000u); b[2] = __uint_as_float(w.w << 16); b[3] = __uint_as_float(w.w & 0xffff0000u); }
__device__ __forceinline__ v4u pk8c(f32x4 a, f32x4 b) { v4u w; w.x = cvt_pk(a[0], a[1]); w.y = cvt_pk(a[2], a[3]); w.z = cvt_pk(b[0], b[1]); w.w = cvt_pk(b[2], b[3]); return w; }
#define MK_ONE_LAUNCH 1
namespace pg8 {
#define PG8_LAS __attribute__((address_space(3)))
typedef unsigned short bf16_t;
typedef short bf16x8 __attribute__((ext_vector_type(8)));
typedef float f32x4 __attribute__((ext_vector_type(4)));
typedef unsigned u32x4 __attribute__((ext_vector_type(4)));
constexpr int BM = 256, BK = 64, HALF = 128, HTB = HALF * BK * 2  , STAGE_BYTES = 8 * HTB, NXCD = 8, WGM = 8;

__host__ __device__ __forceinline__ int lds_byte(int r, int c) { const int st = (r >> 4) * 2 + (c >> 5), rr = r & 15, cc = c & 31, ob = rr * 64 + cc * 2; return st * 1024 + (ob ^ (((ob >> 9) & 1) << 5)); }
__host__ __device__ __forceinline__ void stage_rc(int b, int& R, int& C) { const int st = b / 1024, sb = b % 1024, swz = sb ^ (((sb >> 9) & 1) << 5); R = (st >> 1) * 16 + swz / 64; C = (st & 1) * 32 + (swz % 64) / 2; }
__host__ __device__ __forceinline__ int perm32(int rho) { const int n = rho >> 4, i = rho & 15; return 8 * (i >> 2) + 4 * n + (i & 3); }

struct Unit { int pm, pn; };
struct Gemm { const bf16_t* A; const bf16_t* Bt; int M, N, K; };

struct StaticOrder {
    int nM, nN, nwg, G, c;
    __host__ __device__ void init(int M, int N, int G_, int c_) { nM = M / BM; nN = N / BM; nwg = nM * nN; G = G_; c = c_; }
    __host__ __device__ __forceinline__ bool next(int i, Unit& u) const {
        const long L = (long)i * G + c; if (L >= nwg) return false;
        int wgid = (int)L; { const int q = nwg / NXCD, r = nwg % NXCD, xcd = wgid % NXCD, off = wgid / NXCD; wgid = (xcd < r ? xcd * (q + 1) : r * (q + 1) + (xcd - r) * q) + off; }
        const int nig = WGM * nN, gid = wgid / nig, fm = gid * WGM, gsz = (nM - fm) < WGM ? (nM - fm) : WGM;
        u.pm = fm + ((wgid % nig) % gsz); u.pn = (wgid % nig) / gsz; return true;
    }
    __device__ __forceinline__ void a_ready(const Unit&) const {}
    __device__ __forceinline__ void done(const Unit&) const {}
};

__device__ __forceinline__ unsigned cvt_pk_bf16(float lo, float hi) { unsigned r; asm volatile("v_cvt_pk_bf16_f32 %0, %1, %2" : "=v"(r) : "v"(lo), "v"(hi)); return r; }
template <class Epi, class Sched, bool ALIGN_EPI = false, bool SP2 = false>
__device__ __forceinline__ void gemm_phase(PG8_LAS unsigned char* lds, const Gemm g, const Sched& S, const Epi& E, const int wid) {
    const int lane = mk_lane(), tid = wid * 64 + lane, wr = wid >> 2, wc = wid & 3, fr = lane & 15, fq = lane >> 4;
    const int K = g.K, nt = K / BK;
    unsigned voffA[2], voffB[2];
#pragma unroll
    for (int i = 0; i < 2; ++i) { int R, C; stage_rc(tid * 16 + i * 8192, R, C); const int Rb = Epi::PERM ? ((R & ~31) + perm32(R & 31)) : R;
        voffA[i] = (unsigned)(R * K + C) * 2u; voffB[i] = (unsigned)(Rb * K + C) * 2u; }
    const size_t kstep = (size_t)(BK * 2);
    const size_t hstep = (size_t)HALF * K * 2;
    const size_t tstep = 2 * hstep;
    const unsigned ldsw = (unsigned)wid * 1024u;
    const int aoff = lds_byte(wr * 64 + fr, fq * 8), boff = lds_byte(wc * 32 + fr, fq * 8);
#define PG8_SA(b, h) (((b) * 2 + (h)) * HTB)
#define PG8_SB(b, h) ((4 + (b) * 2 + (h)) * HTB)
#define PG8_STAGE(bufoff, gbase, voff) do { _Pragma("unroll") for (int _i = 0; _i < 2; ++_i) \
        __builtin_amdgcn_global_load_lds((const unsigned*)((const char*)(gbase) + (voff)[_i]), (PG8_LAS unsigned*)(lds + (bufoff) + ldsw + _i * 8192), 16, 0, 0); } while (0)
#define PG8_LDA(dst, b, h) do { _Pragma("unroll") for (int m = 0; m < 4; ++m) _Pragma("unroll") for (int k = 0; k < 2; ++k) dst[m][k] = *(const PG8_LAS bf16x8*)(lds + PG8_SA(b, h) + aoff + m * 2048 + k * 1024); } while (0)
#define PG8_LDB(dst, b, h) do { _Pragma("unroll") for (int n = 0; n < 2; ++n) _Pragma("unroll") for (int k = 0; k < 2; ++k) dst[n][k] = *(const PG8_LAS bf16x8*)(lds + PG8_SB(b, h) + boff + n * 2048 + k * 1024); } while (0)
#define PG8_MMA(ai, bj, At, Bt) do { __builtin_amdgcn_s_setprio(1); _Pragma("unroll") for (int m = 0; m < 4; ++m) _Pragma("unroll") for (int n = 0; n < 2; ++n) _Pragma("unroll") for (int k = 0; k < 2; ++k) \
        acc[ai][bj][m][n] = __builtin_amdgcn_mfma_f32_16x16x32_bf16(Bt[n][k], At[m][k], acc[ai][bj][m][n], 0, 0, 0); __builtin_amdgcn_s_setprio(0); } while (0)
#define PG8_WAIT_V(n) asm volatile("s_waitcnt vmcnt(" #n ")" ::: "memory")
#define PG8_WAIT_L(n) asm volatile("s_waitcnt lgkmcnt(" #n ")" ::: "memory")
#define PG8_BAR __builtin_amdgcn_s_barrier()
#define PG8_SCHED __builtin_amdgcn_sched_barrier(0)
    Unit cur, nxt; int ui = 0;
    if (!S.next(0, cur)) return;
    f32x4 acc[2][2][4][2];
#pragma unroll
    for (int a = 0; a < 2; ++a)
#pragma unroll
        for (int b = 0; b < 2; ++b)
#pragma unroll
            for (int m = 0; m < 4; ++m)
#pragma unroll
                for (int n = 0; n < 2; ++n) acc[a][b][m][n] = (f32x4){0.f, 0.f, 0.f, 0.f};
    bf16x8 At[4][2], B0[2][2], B1[2][2];
    const char* cA = (const char*)g.A + (size_t)cur.pm * tstep; const char* cB = (const char*)g.Bt + (size_t)cur.pn * tstep;
    S.a_ready(cur);
    if constexpr (SP2) {
        PG8_STAGE(PG8_SB(0, 0), cB, voffB); PG8_STAGE(PG8_SB(0, 1), cB + hstep, voffB); PG8_STAGE(PG8_SA(0, 0), cA, voffA); PG8_STAGE(PG8_SA(0, 1), cA + hstep, voffA);
        if (wr == 1) PG8_BAR;
        PG8_WAIT_V(2); PG8_BAR;
        PG8_STAGE(PG8_SB(1, 0), cB + kstep, voffB); PG8_STAGE(PG8_SA(1, 0), cA + kstep, voffA); PG8_STAGE(PG8_SB(1, 1), cB + hstep + kstep, voffB);
        PG8_WAIT_V(6); PG8_BAR;
    } else {
        PG8_STAGE(PG8_SB(0, 0), cB, voffB); PG8_STAGE(PG8_SA(0, 0), cA, voffA); PG8_STAGE(PG8_SB(0, 1), cB + hstep, voffB); PG8_STAGE(PG8_SA(0, 1), cA + hstep, voffA);
        if (wr == 1) PG8_BAR;
        PG8_WAIT_V(4); PG8_BAR;
        PG8_STAGE(PG8_SB(1, 0), cB + kstep, voffB); PG8_STAGE(PG8_SA(1, 0), cA + kstep, voffA); PG8_STAGE(PG8_SB(1, 1), cB + hstep + kstep, voffB);
        PG8_WAIT_V(6); PG8_BAR;
    }
    for (;;) {
        const bool has_next = S.next(ui + 1, nxt);
        const char* nA = has_next ? (const char*)g.A + (size_t)nxt.pm * tstep : cA; const char* nB = has_next ? (const char*)g.Bt + (size_t)nxt.pn * tstep : cB;
        for (int t = 0; t < nt; t += 2) {
            const bool last = (t == nt - 2);
            const char* a1 = cA + (size_t)(t + 1) * kstep;
            const char* a2 = last ? nA : cA + (size_t)(t + 2) * kstep; const char* b2 = last ? nB : cB + (size_t)(t + 2) * kstep;
            const char* a3 = a2 + kstep; const char* b3 = b2 + kstep;
            if (last && has_next) S.a_ready(nxt);
            if constexpr (SP2) {
            PG8_LDB(B0, 0, 0); PG8_LDB(B1, 0, 1); PG8_SCHED; PG8_LDA(At, 0, 0); PG8_STAGE(PG8_SA(1, 1), a1 + hstep, voffA);
            PG8_WAIT_V(8); PG8_WAIT_L(0); PG8_BAR; PG8_MMA(0, 0, At, B0); PG8_MMA(0, 1, At, B1); PG8_BAR; PG8_SCHED;
            PG8_LDA(At, 0, 1); PG8_STAGE(PG8_SB(0, 0), b2, voffB); PG8_STAGE(PG8_SB(0, 1), b2 + hstep, voffB); PG8_STAGE(PG8_SA(0, 0), a2, voffA);
            PG8_WAIT_V(8); PG8_WAIT_L(0); PG8_BAR; PG8_MMA(1, 0, At, B0); PG8_MMA(1, 1, At, B1); PG8_BAR; PG8_SCHED;
            PG8_LDB(B0, 1, 0); PG8_LDB(B1, 1, 1); PG8_SCHED; PG8_LDA(At, 1, 0); PG8_STAGE(PG8_SA(0, 1), a2 + hstep, voffA);
            PG8_WAIT_V(8); PG8_WAIT_L(0); PG8_BAR; PG8_MMA(0, 0, At, B0); PG8_MMA(0, 1, At, B1); PG8_BAR; PG8_SCHED;
            PG8_LDA(At, 1, 1); PG8_STAGE(PG8_SB(1, 0), b3, voffB); PG8_STAGE(PG8_SB(1, 1), b3 + hstep, voffB); PG8_STAGE(PG8_SA(1, 0), a3, voffA);
            PG8_WAIT_V(8); PG8_WAIT_L(0); PG8_BAR; PG8_MMA(1, 0, At, B0); PG8_MMA(1, 1, At, B1); PG8_BAR; PG8_SCHED;
            } else {
            PG8_LDB(B0, 0, 0); PG8_SCHED; PG8_LDA(At, 0, 0); PG8_STAGE(PG8_SA(1, 1), a1 + hstep, voffA);
            PG8_WAIT_L(8); PG8_BAR; PG8_WAIT_L(0); PG8_MMA(0, 0, At, B0); PG8_BAR; PG8_SCHED;
            PG8_LDB(B1, 0, 1); PG8_STAGE(PG8_SB(0, 0), b2, voffB);
            PG8_BAR; PG8_WAIT_L(0); PG8_MMA(0, 1, At, B1); PG8_BAR;
            PG8_LDA(At, 0, 1); PG8_STAGE(PG8_SA(0, 0), a2, voffA);
            PG8_BAR; PG8_WAIT_L(0); PG8_MMA(1, 0, At, B0); PG8_BAR; PG8_SCHED;
            PG8_STAGE(PG8_SB(0, 1), b2 + hstep, voffB);
            PG8_WAIT_V(6); PG8_BAR; PG8_MMA(1, 1, At, B1); PG8_BAR;
            PG8_LDB(B0, 1, 0); PG8_SCHED; PG8_LDA(At, 1, 0); PG8_STAGE(PG8_SA(0, 1), a2 + hstep, voffA);
            PG8_WAIT_L(8); PG8_BAR; PG8_WAIT_L(0); PG8_MMA(0, 0, At, B0); PG8_BAR; PG8_SCHED;
            PG8_LDB(B1, 1, 1); PG8_STAGE(PG8_SB(1, 0), b3, voffB);
            PG8_BAR; PG8_WAIT_L(0); PG8_MMA(0, 1, At, B1); PG8_BAR;
            PG8_LDA(At, 1, 1); PG8_STAGE(PG8_SA(1, 0), a3, voffA);
            PG8_BAR; PG8_WAIT_L(0); PG8_MMA(1, 0, At, B0); PG8_BAR; PG8_SCHED;
            PG8_STAGE(PG8_SB(1, 1), b3 + hstep, voffB);
            PG8_WAIT_V(6); PG8_BAR; PG8_MMA(1, 1, At, B1); PG8_BAR;
            }
        }
        if constexpr (ALIGN_EPI) { if (wr == 0) PG8_BAR; }
        if constexpr (!Epi::AFTER_DRAIN) { E(acc, cur, wr, wc, fr, fq); S.done(cur); }
        if (!has_next) break;
#pragma unroll
        for (int a = 0; a < 2; ++a)
#pragma unroll
            for (int b = 0; b < 2; ++b)
#pragma unroll
                for (int m = 0; m < 4; ++m)
#pragma unroll
                    for (int n = 0; n < 2; ++n) acc[a][b][m][n] = (f32x4){0.f, 0.f, 0.f, 0.f};
        cur = nxt; cA = nA; cB = nB; ++ui;
        if constexpr (ALIGN_EPI) { if (wr == 1) PG8_BAR; }
    }
    PG8_WAIT_V(0);
    if constexpr (!ALIGN_EPI) { if (wr == 0) PG8_BAR; }
    PG8_BAR;
    if constexpr (Epi::AFTER_DRAIN) { E.fused(acc, cur, wr, wc, fr, fq, lds, wid, lane); S.done(cur); }
#undef PG8_SA
#undef PG8_SB
#undef PG8_STAGE
#undef PG8_LDA
#undef PG8_LDB
#undef PG8_MMA
#undef PG8_WAIT_V
#undef PG8_WAIT_L
#undef PG8_BAR
#undef PG8_SCHED
}
}

#define XB_TMO      128
#define XB_XCNT(j)  (256  + 64 * (j))
#define XB_XSUB(j)  (1280 + 64 * (j))
#define XB_XGEN(j)  (2304 + 64 * (j))
#define XB_TOP      3328
#define XB_TOPGEN   3392
#define XCD_BAR_WORDS 3456
#define XB_SPIN_CAP (1u << 18)

__device__ __forceinline__ unsigned xb_ld(unsigned* p)              { return __hip_atomic_load(p, __ATOMIC_RELAXED, __HIP_MEMORY_SCOPE_AGENT); }
__device__ __forceinline__ unsigned xb_add(unsigned* p, unsigned v) { return __hip_atomic_fetch_add(p, v, __ATOMIC_RELAXED, __HIP_MEMORY_SCOPE_AGENT); }
__device__ __forceinline__ unsigned xb_xcc_id() { return (unsigned)__builtin_amdgcn_s_getreg((3 << 11) | 20) & 0xFu; }
#define XB_SPIN(cond, bar) do { unsigned _sp = 0; while (cond) { __builtin_amdgcn_s_sleep(1); \
    if ((++_sp & 255u) == 0u) { if (xb_ld(&(bar)[XB_TMO])) break; if (_sp > XB_SPIN_CAP) { atomicAdd(&(bar)[XB_TMO], 1u); break; } } } } while (0)

struct XcdBarrier {
    unsigned* bar; unsigned x; unsigned wid;
    volatile LAS unsigned* st;
};

__device__ __forceinline__ XcdBarrier xcd_barrier_post(unsigned* bar, volatile LAS unsigned* st, unsigned wid) {
    XcdBarrier b; b.bar = bar; b.x = xb_xcc_id(); b.st = st; b.wid = wid;
    if (wid == 0u && mk_lane() == 0) (void)xb_add(&bar[XB_XCNT(b.x)], 1u);
    return b;
}
__device__ __forceinline__ void xcd_barrier_complete(unsigned* bar, unsigned x, unsigned& nloc, unsigned& nx) {
    const unsigned G = gridDim.x * gridDim.y * gridDim.z;
    unsigned sum, cnt, mine, sp = 0u;
    for (;;) {
        sum = 0u; cnt = 0u; mine = 0u;
#pragma unroll
        for (unsigned j = 0; j < 16; ++j) { const unsigned c = xb_ld(&bar[XB_XCNT(j)]); sum += c; cnt += (c > 0u) ? 1u : 0u; mine = (j == x) ? c : mine; }
        if (sum == G) break;
        __builtin_amdgcn_s_sleep(1);
        if ((++sp & 255u) == 0u) { if (xb_ld(&bar[XB_TMO])) break; if (sp > XB_SPIN_CAP) { atomicAdd(&bar[XB_TMO], 1u); break; } }
    }
    nloc = mine > 0u ? mine : 1u; nx = cnt > 0u ? cnt : 1u;
}

__device__ __forceinline__ void xcd_barrier(const XcdBarrier& b) {
    asm volatile("s_waitcnt vmcnt(0)" ::: "memory");
    __syncthreads();
    if (b.wid == 0u && mk_lane() == 0) {
        unsigned* bar = b.bar;
        __builtin_amdgcn_s_waitcnt(0);
        unsigned nloc = b.st[0], nx = b.st[1];
        if (nloc == 0u) { xcd_barrier_complete(bar, b.x, nloc, nx); b.st[0] = nloc; b.st[1] = nx; }
        const unsigned old = xb_add(&bar[XB_XSUB(b.x)], 1u);
        const unsigned gen = old / nloc;
        if (old + 1u == (gen + 1u) * nloc) {
            __builtin_amdgcn_fence(__ATOMIC_RELEASE, "agent");
            asm volatile("s_waitcnt vmcnt(0)" ::: "memory");
            const unsigned og = xb_add(&bar[XB_TOP], 1u);
            const unsigned tg = og / nx;
            if (og + 1u == (tg + 1u) * nx) xb_add(&bar[XB_TOPGEN], 1u);
            else XB_SPIN(xb_ld(&bar[XB_TOPGEN]) == tg, bar);
            __builtin_amdgcn_fence(__ATOMIC_ACQUIRE, "agent");
            xb_add(&bar[XB_XGEN(b.x)], 1u);
            asm volatile("s_waitcnt vmcnt(0)" ::: "memory");
        } else {
            XB_SPIN(xb_ld(&bar[XB_XGEN(b.x)]) == gen, bar);
            __builtin_amdgcn_fence(__ATOMIC_ACQUIRE, "agent");
            asm volatile("s_waitcnt vmcnt(0)" ::: "memory");
        }
    }
    __syncthreads();
}

constexpr float LOG2E = 1.4426950408889634f;
constexpr float QSCALE = 0.125f * LOG2E;
typedef const f32x4 (&AccRef)[2][2][4][2];
using pg8::Unit;

struct EpiAttnIn {
    static constexpr bool PERM = true, AFTER_DRAIN = false;
    unsigned char* ws; float* out;
    __device__ __forceinline__ void operator()(AccRef acc, const Unit& u, int wr, int wc, int fr, int fq) const {
        const int pn = u.pn;
        const float* ss = (const float*)(ws + WS_CTL) + CW_SS;
        const int rbase = u.pm * 256 + wr * 64 + fr, cw = wc * 32 + 8 * fq;
#define EAI_LOOP(...) _Pragma("unroll") for (int ai = 0; ai < 2; ++ai) _Pragma("unroll") for (int m = 0; m < 4; ++m) { const int r = rbase + ai * 128 + m * 16; const float rstd = rsqrtf(ss[r] * (1.f / DM) + EPS); \
            _Pragma("unroll") for (int bj = 0; bj < 2; ++bj) { const f32x4 v0 = acc[ai][bj][m][0] * rstd, v1 = acc[ai][bj][m][1] * rstd; __VA_ARGS__ } asm volatile("" ::: "memory"); }
        if (pn < 4) {
            bf16* Qb = (bf16*)(ws + WS_QB) + pn * 256 + cw;
            EAI_LOOP({ *(v4u*)(Qb + (size_t)r * DM + bj * 128) = pk8(v0 * QSCALE, v1 * QSCALE); })
        } else if (pn < 8) {
            const int cc0 = (pn - 4) * 256 + cw;
            bf16* KVb = (bf16*)(ws + WS_KVB) + cc0; bf16* cmpa = (bf16*)(ws + WS_CMPA);
            float* okv = (rbase < MP) ? out + O_KVP + cc0 : out + O_KVS - (size_t)MP * 1024 + cc0;
            EAI_LOOP({ float* o = okv + (size_t)r * 1024 + bj * 128; st4(o, v0); st4(o + 4, v1);
                const v4u w = pk8(v0, v1); *(v4u*)(KVb + (size_t)r * 1024 + bj * 128) = w;
                if (pn < 6 && r < MP) { const int cc = cc0 + bj * 128; const int c = pn - 4, g = (cc & 255) >> 6, d = cc & 63, b = r >> 13, t = r & 8191, mb = t >> 4, l = t & 15;
                    *(v4u*)(cmpa + ((((size_t)(c * NB + b) * 512 + mb) * NG + g) * 16 + l) * 64 + d) = w; }
                if (pn >= 6 && r >= MP) { const int rs = r - MP; *(v4u*)((bf16*)(ws + WS_SELS) + ((size_t)(rs >> 3) * (PAST + DS) + PAST + (rs & 7)) * 512 + (cc0 - 512) + bj * 128) = w; } })
        } else if (pn < 10) {
            const int cc0 = (pn - 8) * 256 + cw;
            bf16* WINb = (bf16*)(ws + WS_WINB) + cc0;
            EAI_LOOP({ const int cc = cc0 + bj * 128; const v4u w = pk8(v0, v1); *(v4u*)(WINb + (size_t)r * 512 + bj * 128) = w;
                if (r >= MP) { const int rs = r - MP; *(v4u*)((bf16*)(ws + WS_WINS) + ((size_t)(rs >> 3) * 520 + 512 + (rs & 7)) * 512 + cc) = w; }
                if (r < MP) { const int t = r & 8191; if (t >= SEQ - 512) { float* o = out + O_WINP + ((size_t)(r >> 13) * 512 + (t - (SEQ - 512))) * 512 + cc; st4(o, v0); st4(o + 4, v1); } }
                else { const int rs = r - MP, s = rs >> 3, t = rs & 7; float* o = out + O_WINS + ((size_t)s * 512 + 504 + t) * 512 + cc; st4(o, v0); st4(o + 4, v1); } })
        } else {
            float* gates = (float*)(ws + WS_GATES);
            EAI_LOOP({ const int cc = bj * 128 + cw; if (cc < 48) { float* o = gates + (size_t)r * 48 + cc;
                f32x4 a, b2; a[0] = sigmoidf_(v0[0]); a[1] = sigmoidf_(v0[1]); a[2] = sigmoidf_(v0[2]); a[3] = sigmoidf_(v0[3]);
                b2[0] = sigmoidf_(v1[0]); b2[1] = sigmoidf_(v1[1]); b2[2] = sigmoidf_(v1[2]); b2[3] = sigmoidf_(v1[3]); st4(o, a); st4(o + 4, b2); } })
        }
#undef EAI_LOOP
    }
};

struct EpiPlain {
    static constexpr bool PERM = true, AFTER_DRAIN = false;
    bf16* O; int ldc;
    __device__ __forceinline__ void operator()(AccRef acc, const Unit& u, int wr, int wc, int fr, int fq) const {
#pragma unroll
        for (int ai = 0; ai < 2; ++ai)
#pragma unroll
            for (int m = 0; m < 4; ++m) {
                const int r = u.pm * 256 + ai * 128 + wr * 64 + m * 16 + fr;
#pragma unroll
                for (int bj = 0; bj < 2; ++bj) { const int c0 = u.pn * 256 + bj * 128 + wc * 32 + 8 * fq; *(v4u*)(O + (size_t)r * ldc + c0) = pk8(acc[ai][bj][m][0], acc[ai][bj][m][1]); }
            }
    }
};

__device__ __forceinline__ void ss_accum(float* ssout, int r, float s, int fq) {
    s += __shfl_xor(s, 16); s += __shfl_xor(s, 32);
    if (fq == 0) atomicAdd(ssout + r, s);
}

struct EpiResid {
    static constexpr bool PERM = true, AFTER_DRAIN = false;
    const bf16* XI; bf16* XO; float* ssout;
    __device__ __forceinline__ void operator()(AccRef acc, const Unit& u, int wr, int wc, int fr, int fq) const {
#pragma unroll
        for (int ai = 0; ai < 2; ++ai)
#pragma unroll
            for (int m = 0; m < 4; ++m) {
                const int r = u.pm * 256 + ai * 128 + wr * 64 + m * 16 + fr;
                float s = 0.f;
#pragma unroll
                for (int bj = 0; bj < 2; ++bj) {
                    const int c0 = u.pn * 256 + bj * 128 + wc * 32 + 8 * fq;
                    f32x4 v0, v1; unpk8(*(const v4u*)(XI + (size_t)r * DM + c0), v0, v1); v0 += acc[ai][bj][m][0]; v1 += acc[ai][bj][m][1];
                    *(v4u*)(XO + (size_t)r * DM + c0) = pk8c(v0, v1);
                    s += (v0[0] * v0[0] + v0[1] * v0[1]) + (v0[2] * v0[2] + v0[3] * v0[3]) + (v1[0] * v1[0] + v1[1] * v1[1]) + (v1[2] * v1[2] + v1[3] * v1[3]);
                }
                ss_accum(ssout, r, s, fq);
            }
    }
};

template <int CTRL> __device__ __forceinline__ float dppf(float v) { return __uint_as_float((unsigned)__builtin_amdgcn_update_dpp(0, (int)__float_as_uint(v), CTRL, 0xf, 0xf, false)); }
template <int CTRL> __device__ __forceinline__ f32x4 dpp4(f32x4 v) { f32x4 r; r[0] = dppf<CTRL>(v[0]); r[1] = dppf<CTRL>(v[1]); r[2] = dppf<CTRL>(v[2]); r[3] = dppf<CTRL>(v[3]); return r; }
__device__ __forceinline__ f32x4 sel4(bool c, f32x4 a, f32x4 b) { f32x4 r; r[0] = c ? a[0] : b[0]; r[1] = c ? a[1] : b[1]; r[2] = c ? a[2] : b[2]; r[3] = c ? a[3] : b[3]; return r; }
__device__ __forceinline__ f32x4 gelu4(f32x4 v) { f32x4 r; r[0] = gelu_tanh(v[0]); r[1] = gelu_tanh(v[1]); r[2] = gelu_tanh(v[2]); r[3] = gelu_tanh(v[3]); return r; }
constexpr int XCH_OFF = RING_BYTES;
struct EpiUpFused {
    static constexpr bool PERM = true, AFTER_DRAIN = false;
    unsigned char* ws; float* out; const float* cw; const float* cb; const float* sconv; int layer; LAS unsigned char* lds;
    __device__ __forceinline__ void operator()(AccRef acc, const Unit& u, int wr, int wc, int fr, int fq) const {
        const float* ss = (const float*)(ws + WS_CTL) + CW_SS + (size_t)(layer ? 4 : 1) * M;
        bf16* ACT = (bf16*)(ws + WS_ACT); float* haloA = (float*)(ws + WS_HALOA); float* haloB = (float*)(ws + WS_HALOB);
        LAS float* xch = (LAS float*)(lds + XCH_OFF);
        const int j0 = u.pn * 128 + wc * 32 + 8 * fq;
        const f32x4 w0a = ld4(cw + j0), w0b = ld4(cw + j0 + 4), w1a = ld4(cw + FF + j0), w1b = ld4(cw + FF + j0 + 4), w2a = ld4(cw + 2 * FF + j0), w2b = ld4(cw + 2 * FF + j0 + 4), bba = ld4(cb + j0), bbb = ld4(cb + j0 + 4);
        const int rs0 = u.pm * 256 + wr * 64 + fr;
        const bool sample = u.pm >= MP / 256;
        if (fr >= 14) {
#pragma unroll
            for (int ai = 0; ai < 2; ++ai) { const int r = rs0 + ai * 128 + 48; const float rstd = rsqrtf(ss[r] * (1.f / DM) + EPS);
                LAS float* d = xch + ((((ai * 2 + wr) * 4 + wc) * 2 + (fr - 14)) * 32) + 8 * fq;
                *(LAS f32x4*)d = acc[ai][0][3][0] * rstd; *(LAS f32x4*)(d + 4) = acc[ai][0][3][1] * rstd; }
        }
        asm volatile("s_waitcnt lgkmcnt(0)" ::: "memory"); __builtin_amdgcn_s_barrier(); asm volatile("" ::: "memory");
#pragma unroll
        for (int ai = 0; ai < 2; ++ai) {
            f32x4 hpa = {0.f, 0.f, 0.f, 0.f}, hpb = {0.f, 0.f, 0.f, 0.f};
            const bool first = (ai == 0 && wr == 0);
            if (!first && fr >= 14) { const int sa = wr ? ai : ai - 1, sw = wr ? 0 : 1;
                const LAS float* s = xch + ((((sa * 2 + sw) * 4 + wc) * 2 + (fr - 14)) * 32) + 8 * fq; hpa = *(const LAS f32x4*)s; hpb = *(const LAS f32x4*)(s + 4); }
            const bool defer = first && !sample && (u.pm & 31) != 0;
#pragma unroll
            for (int m = 0; m < 4; ++m) {
                const int r = rs0 + ai * 128 + m * 16; const float rstd = rsqrtf(ss[r] * (1.f / DM) + EPS);
                const f32x4 ha = acc[ai][0][m][0] * rstd, hb = acc[ai][0][m][1] * rstd, ga = acc[ai][1][m][0] * rstd, gb = acc[ai][1][m][1] * rstd;
                f32x4 p1a, p1b, p2a, p2b;
                if (!sample) {
                    p1a = sel4(fr == 0, dpp4<0x121>(hpa), dpp4<0x121>(ha)); p1b = sel4(fr == 0, dpp4<0x121>(hpb), dpp4<0x121>(hb));
                    p2a = sel4(fr < 2, dpp4<0x122>(hpa), dpp4<0x122>(ha)); p2b = sel4(fr < 2, dpp4<0x122>(hpb), dpp4<0x122>(hb));
                } else {
                    const int t = fr & 7; const float* sc = sconv + (size_t)((r - MP) >> 3) * 2 * FF + j0;
                    f32x4 s0a = {0.f, 0.f, 0.f, 0.f}, s0b = s0a, s1a = s0a, s1b = s0a;
                    if (t < 2) { s1a = ld4(sc + FF); s1b = ld4(sc + FF + 4); if (t == 0) { s0a = ld4(sc); s0b = ld4(sc + 4); } }
                    p1a = sel4(t >= 1, dpp4<0x121>(ha), s1a); p1b = sel4(t >= 1, dpp4<0x121>(hb), s1b);
                    p2a = sel4(t >= 2, dpp4<0x122>(ha), sel4(t == 1, s1a, s0a)); p2b = sel4(t >= 2, dpp4<0x122>(hb), sel4(t == 1, s1b, s0b));
                }
                if (defer && m == 0 && fr < 2) {
                    float* d = haloA + ((size_t)(u.pm * 2 + fr) * 2) * FF + j0; st4(d, ha); st4(d + 4, hb); st4(d + FF, ga); st4(d + FF + 4, gb);
                } else {
                    const f32x4 oa = gelu4(bba + w0a * p2a + w1a * p1a + w2a * ha) * ga, ob = gelu4(bbb + w0b * p2b + w1b * p1b + w2b * hb) * gb;
                    *(v4u*)(ACT + (size_t)r * FF + j0) = pk8(oa, ob);
                }
                if (!sample) { const int t = r & 8191; if (t >= SEQ - 2) { float* o = out + O_CONVP + ((size_t)(layer * NB + (r >> 13)) * 2 + (t - (SEQ - 2))) * FF + j0; st4(o, ha); st4(o + 4, hb); }
                    if (ai == 1 && wr == 1 && m == 3 && fr >= 14) { float* d = haloB + (size_t)(u.pm * 2 + (fr - 14)) * FF + j0; st4(d, ha); st4(d + 4, hb); } }
                else { const int rs = r - MP, t = rs & 7; if (t >= 6) { float* o = out + O_CONVS + ((size_t)(layer * DB + (rs >> 3)) * 2 + (t - 6)) * FF + j0; st4(o, ha); st4(o + 4, hb); } }
                hpa = ha; hpb = hb;
            }
        }
    }
};
__device__ __forceinline__ void up_fix(unsigned char* ws, const float* cw, const float* cb, int pm, int tid) {
    const float* haloA = (const float*)(ws + WS_HALOA) + (size_t)pm * 4 * FF; const float* haloB = (const float*)(ws + WS_HALOB) + (size_t)(pm - 1) * 2 * FF; bf16* ACT = (bf16*)(ws + WS_ACT) + (size_t)pm * 256 * FF;
    for (int j = tid; j < FF; j += NWAVES * 64) {
        const float hm2 = haloB[j], hm1 = haloB[FF + j], h0 = haloA[j], g0 = haloA[FF + j], h1 = haloA[2 * FF + j], g1 = haloA[3 * FF + j];
        const float w0 = cw[j], w1 = cw[FF + j], w2 = cw[2 * FF + j], bb = cb[j];
        ACT[j] = (bf16)f2bf(gelu_tanh(bb + w0 * hm2 + w1 * hm1 + w2 * h0) * g0);
        ACT[FF + j] = (bf16)f2bf(gelu_tanh(bb + w0 * hm1 + w1 * h0 + w2 * h1) * g1);
    }
}

struct EpiGate {
    static constexpr bool PERM = true, AFTER_DRAIN = false;
    const float* ss; const bf16* PP; const bf16* XI; bf16* XO; float* ssout; bf16* XG;
    __device__ __forceinline__ void operator()(AccRef acc, const Unit& u, int wr, int wc, int fr, int fq) const {
#pragma unroll
        for (int ai = 0; ai < 2; ++ai)
#pragma unroll
            for (int m = 0; m < 4; ++m) {
                const int r = u.pm * 256 + ai * 128 + wr * 64 + m * 16 + fr;
                const float rstd = rsqrtf(ss[r] * (1.f / DM) + EPS);
                float s = 0.f;
#pragma unroll
                for (int bj = 0; bj < 2; ++bj) {
                    const int c0 = u.pn * 256 + bj * 128 + wc * 32 + 8 * fq;
                    f32x4 p0, p1, v0, v1; unpk8(*(const v4u*)(PP + (size_t)r * DM + c0), p0, p1); unpk8(*(const v4u*)(XI + (size_t)r * DM + c0), v0, v1);
                    const f32x4 a0 = acc[ai][bj][m][0] * rstd, a1 = acc[ai][bj][m][1] * rstd;
#pragma unroll
                    for (int e = 0; e < 4; ++e) { v0[e] += p0[e] * sigmoidf_(a0[e]); v1[e] += p1[e] * sigmoidf_(a1[e]); }
                    const v4u wv = pk8c(v0, v1);
                    *(v4u*)(XO + (size_t)r * DM + c0) = wv;
                    if (XG) *(v4u*)(XG + ((size_t)(c0 >> 4) * M + r) * 16 + (c0 & 15)) = wv;
                    s += (v0[0] * v0[0] + v0[1] * v0[1]) + (v0[2] * v0[2] + v0[3] * v0[3]) + (v1[0] * v1[0] + v1[1] * v1[1]) + (v1[2] * v1[2] + v1[3] * v1[3]);
                }
                ss_accum(ssout, r, s, fq);
            }
    }
};

struct EpiGlu {
    static constexpr bool PERM = true, AFTER_DRAIN = false;
    const bf16* XI; bf16* XO; float* ssout;
    __device__ __forceinline__ void operator()(AccRef acc, const Unit& u, int wr, int wc, int fr, int fq) const {
#pragma unroll
        for (int ai = 0; ai < 2; ++ai)
#pragma unroll
            for (int m = 0; m < 4; ++m) {
                const int r = u.pm * 256 + ai * 128 + wr * 64 + m * 16 + fr;
                const int c0 = u.pn * 128 + wc * 32 + 8 * fq;
                f32x4 v0, v1; unpk8(*(const v4u*)(XI + (size_t)r * DM + c0), v0, v1);
                const f32x4 a0 = acc[ai][0][m][0], a1 = acc[ai][0][m][1], b0 = acc[ai][1][m][0], b1 = acc[ai][1][m][1];
#pragma unroll
                for (int e = 0; e < 4; ++e) { v0[e] += a0[e] * sigmoidf_(b0[e]); v1[e] += a1[e] * sigmoidf_(b1[e]); }
                *(v4u*)(XO + (size_t)r * DM + c0) = pk8c(v0, v1);
                const float s = (v0[0] * v0[0] + v0[1] * v0[1]) + (v0[2] * v0[2] + v0[3] * v0[3]) + (v1[0] * v1[0] + v1[1] * v1[1]) + (v1[2] * v1[2] + v1[3] * v1[3]);
                ss_accum(ssout, r, s, fq);
            }
    }
};

struct EpiCmp {
    static constexpr bool PERM = true, AFTER_DRAIN = false;
    float* PBUF;
    __device__ __forceinline__ void operator()(AccRef acc, const Unit& u, int wr, int wc, int fr, int fq) const {
        const int row0 = u.pm * 256;
        const int c = row0 / (CMP_ROWS_S / 2);
#pragma unroll
        for (int ai = 0; ai < 2; ++ai)
#pragma unroll
            for (int m = 0; m < 4; ++m) {
                const int r = row0 + ai * 128 + wr * 64 + m * 16 + fr;
                float* o = PBUF + (size_t)r * 128 + wc * 32 + 8 * fq;
                const f32x4 v0 = c ? acc[ai][1][m][0] : acc[ai][0][m][0], v1 = c ? acc[ai][1][m][1] : acc[ai][0][m][1];
                st4(o, v0); st4(o + 4, v1);
            }
    }
};
struct Args {
    const float* in[34]; const int* page_table; float* out; unsigned char* ws; int ph_lo, ph_hi;
};
static_assert(sizeof(Args) == 34 * 8 + 8 + 8 + 8 + 8, "Args has no padding");
enum { I_XP = 0, I_XS, I_CKV, I_CWIN, I_SRE, I_SIM, I_SCONV, I_PT, I_PP, I_PS, I_NMIX, I_NFFN, I_NPLE, I_NFIN, I_WIN, I_WOUT, I_CPE, I_CW1, I_CW2,
       I_ARE, I_AIM, I_LDT, I_BRE, I_BIM, I_CRE, I_CIM, I_SD, I_WGLU, I_WUP, I_CONVW, I_CONVB, I_WDN, I_WPP, I_WPG };

struct Frame {
    LAS unsigned char* lds;
    int tid, lane, wave, gw, NGW;
    unsigned char* ws; float* out; const float* const* in; const int* pt;
    __device__ __forceinline__ float* SS(int k) const { return (float*)(ws + WS_CTL) + CW_SS + (size_t)k * M; }
};

template <int MODE>
__device__ __forceinline__ void transpose_item(const float* W, int K, int N, int nblk, bf16* WT, const float* gain, LAS float* scr, int item, int lane) {
    const int kb = item / nblk, nb = item % nblk, k0 = 32 * kb, n0 = 128 * nb;
    const int nn = n0 + 4 * (lane & 31);
#pragma unroll 8
    for (int i = 0; i < 16; ++i) { const int kk = 2 * i + (lane >> 5); f32x4 v = {0.f, 0.f, 0.f, 0.f};
        if (nn + 3 < N) v = ld4(W + (size_t)(k0 + kk) * N + nn);
        else { if (nn < N) v[0] = W[(size_t)(k0 + kk) * N + nn]; if (nn + 1 < N) v[1] = W[(size_t)(k0 + kk) * N + nn + 1]; if (nn + 2 < N) v[2] = W[(size_t)(k0 + kk) * N + nn + 2]; }
        if (gain) v = v * gain[k0 + kk];
        *(LAS f32x4*)(scr + kk * 132 + 4 * (lane & 31)) = v; }
    LDS_WAIT(); asm volatile("" ::: "memory");
    const int c4 = lane >> 4;
#pragma unroll
    for (int j = 0; j < 8; ++j) { const int n = (lane & 15) + 16 * j; const LAS float* s = scr + (8 * c4) * 132 + n;
        v4u o; o.x = pk2(s[0 * 132], s[1 * 132]); o.y = pk2(s[2 * 132], s[3 * 132]); o.z = pk2(s[4 * 132], s[5 * 132]); o.w = pk2(s[6 * 132], s[7 * 132]);
        int ns = n0 + n, dr = ns;
        if (MODE == 1) { const int half = ns >> 10, jj = ns & 1023; dr = (jj >> 7) * 256 + half * 128 + (jj & 127); }
        if (MODE == 2) { const int half = ns >= FF ? 1 : 0, jj = ns - half * FF; dr = (jj >> 7) * 256 + half * 128 + (jj & 127); }
        *(v4u*)(WT + (size_t)dr * K + k0 + 8 * c4) = o; }
    LDS_WAIT(); asm volatile("" ::: "memory");
}

__device__ __forceinline__ void p0_prologue(Frame& F) {
    LAS float* scr = (LAS float*)(F.lds + F.wave * WAVE_LDS);
    const int gw = F.gw, NGW = F.NGW, lane = F.lane;
    unsigned char* ws = F.ws;
    {
        constexpr int I_IN = 32 * 22, I_OUT = 32 * 8, I_UP = 32 * 44, I_DN = 88 * 8, I_P = 8 * 8, I_G = 32 * 8, I_GLU = 32 * 16;
        constexpr int NITEMS = I_IN + I_OUT + 2 * I_UP + 2 * I_DN + 2 * I_P + 2 * I_G + I_GLU;
        for (int it = gw; it < NITEMS; it += NGW) {
            int r = it;
            if (r < I_IN) { transpose_item<0>(F.in[I_WIN], DM, NIN, 22, (bf16*)(ws + WS_WIN_T), F.in[I_NMIX], scr, r, lane); continue; } r -= I_IN;
            if (r < I_OUT) { transpose_item<0>(F.in[I_WOUT], DM, DM, 8, (bf16*)(ws + WS_WOUT_T), nullptr, scr, r, lane); continue; } r -= I_OUT;
            if (r < I_UP) { transpose_item<2>(F.in[I_WUP], DM, 2 * FF, 44, (bf16*)(ws + WS_WUP_T0), F.in[I_NFFN], scr, r, lane); continue; } r -= I_UP;
            if (r < I_UP) { transpose_item<2>(F.in[I_WUP] + (size_t)DM * 2 * FF, DM, 2 * FF, 44, (bf16*)(ws + WS_WUP_T1), F.in[I_NFFN] + DM, scr, r, lane); continue; } r -= I_UP;
            if (r < I_DN) { transpose_item<0>(F.in[I_WDN], FF, DM, 8, (bf16*)(ws + WS_WDN_T0), nullptr, scr, r, lane); continue; } r -= I_DN;
            if (r < I_DN) { transpose_item<0>(F.in[I_WDN] + (size_t)FF * DM, FF, DM, 8, (bf16*)(ws + WS_WDN_T1), nullptr, scr, r, lane); continue; } r -= I_DN;
            if (r < I_P) { transpose_item<0>(F.in[I_WPP], PLE, DM, 8, (bf16*)(ws + WS_WP_T0), nullptr, scr, r, lane); continue; } r -= I_P;
            if (r < I_P) { transpose_item<0>(F.in[I_WPP] + (size_t)PLE * DM, PLE, DM, 8, (bf16*)(ws + WS_WP_T1), nullptr, scr, r, lane); continue; } r -= I_P;
            if (r < I_G) { transpose_item<0>(F.in[I_WPG], DM, DM, 8, (bf16*)(ws + WS_WG_T0), F.in[I_NPLE], scr, r, lane); continue; } r -= I_G;
            if (r < I_G) { transpose_item<0>(F.in[I_WPG] + (size_t)DM * DM, DM, DM, 8, (bf16*)(ws + WS_WG_T1), F.in[I_NPLE] + DM, scr, r, lane); continue; } r -= I_G;
            transpose_item<1>(F.in[I_WGLU], DM, 2 * DM, 16, (bf16*)(ws + WS_WGLU_T), nullptr, scr, r, lane);
        }
    }
    {
        bf16* W1rT = (bf16*)(ws + WS_W1R_T); const float* w1 = F.in[I_CW1];
        for (int it = gw; it < 256 * 16; it += NGW) {
            const int np = it >> 4, lp = it & 15, c = np >> 7, a = (np >> 6) & 1, e = np & 63;
            W1rT[(size_t)np * 1024 + lp * 64 + lane] = (bf16)f2bf(w1[(((size_t)c * 32 + 16 * a + lp) * 64 + lane) * 64 + e]);
        }
        float* cvec = (float*)(ws + WS_CVEC); const float* pe = F.in[I_CPE];
        for (int it = gw; it < 128; it += NGW) {
            const int c = it >> 6, e = it & 63; float s = 0.f;
            for (int i = lane; i < 2048; i += 64) s += pe[c * 2048 + i] * w1[((size_t)c * 2048 + i) * 64 + e];
            s = wave_sum(s); if (lane == 0) cvec[it] = s;
        }
    }
    {
        bf16* XB = (bf16*)(ws + WS_XBA); float* ss = F.SS(0);
        for (int r = gw; r < M; r += NGW) {
            const float* xr = (r < MP) ? F.in[I_XP] + (size_t)r * DM : F.in[I_XS] + (size_t)(r - MP) * DM;
            float s = 0.f;
#pragma unroll
            for (int j = 0; j < 4; ++j) { const f32x4 v = ld4(xr + 4 * lane + 256 * j); s += (v[0] * v[0] + v[1] * v[1]) + (v[2] * v[2] + v[3] * v[3]);
                v2u w; w.x = pk2(v[0], v[1]); w.y = pk2(v[2], v[3]); *(v2u*)(XB + (size_t)r * DM + 4 * lane + 256 * j) = w; }
            s = wave_sum(s); if (lane == 0) ss[r] = s;
        }
    }
    for (int it = gw; it < 2 * M; it += NGW) {
        const int i = it / M, r = it % M;
        const float* pr = (r < MP) ? F.in[I_PP] + ((size_t)i * MP + r) * PLE : F.in[I_PS] + ((size_t)i * MS + (r - MP)) * PLE;
        bf16* o = (bf16*)(ws + (i ? WS_PB1 : WS_PB0)) + (size_t)r * PLE;
        const f32x4 v = ld4(pr + 4 * lane); v2u w; w.x = pk2(v[0], v[1]); w.y = pk2(v[2], v[3]); *(v2u*)(o + 4 * lane) = w;
    }
}

__device__ __forceinline__ void p0_stream(Frame& F, int gw, int NGW, int e_lo, int e_hi, bool do_f) {
    const int lane = F.lane;
    unsigned char* ws = F.ws;
    {
        bf16* sels = (bf16*)(ws + WS_SELS); const float* ckv = F.in[I_CKV];
        for (int it = e_lo + gw * 8; it < e_hi; it += NGW * 8) {
            const int s = it >> 11, tok0 = it & 2047;
            const int page = F.pt[s * NPAGES + (tok0 >> 7)];
            const float* src = ckv + ((size_t)page * PAGE + (tok0 & 127)) * 1024 + 512 + 4 * lane;
            f32x4 v[8][2];
#pragma unroll
            for (int j = 0; j < 8; ++j) { v[j][0] = __builtin_nontemporal_load((const f32x4*)(src + j * 1024)); v[j][1] = __builtin_nontemporal_load((const f32x4*)(src + j * 1024 + 256)); }
            bf16* so = sels + ((size_t)s * (PAST + DS) + tok0) * 512 + 4 * lane;
#pragma unroll
            for (int j = 0; j < 8; ++j)
#pragma unroll
                for (int c = 0; c < 2; ++c) { v2u w; w.x = pk2(v[j][c][0], v[j][c][1]); w.y = pk2(v[j][c][2], v[j][c][3]); *(v2u*)(so + j * 512 + c * 256) = w; }
        }
    }
    if (do_f) {
        const float* cw = F.in[I_CWIN]; float* o = F.out + O_WINS; bf16* wins = (bf16*)(ws + WS_WINS);
        for (int it = gw * 4; it < DB * 512; it += NGW * 4) {
            const int s = it >> 9, i0 = it & 511;
            const float* src = cw + ((size_t)s * 512 + i0) * 512 + 4 * lane;
            f32x4 a[4], b[4];
#pragma unroll
            for (int j = 0; j < 4; ++j) { a[j] = __builtin_nontemporal_load((const f32x4*)(src + j * 512)); b[j] = __builtin_nontemporal_load((const f32x4*)(src + j * 512 + 256)); }
#pragma unroll
            for (int j = 0; j < 4; ++j) { const int i = i0 + j;
                v2u w; w.x = pk2(a[j][0], a[j][1]); w.y = pk2(a[j][2], a[j][3]); *(v2u*)(wins + ((size_t)s * 520 + i) * 512 + 4 * lane) = w;
                w.x = pk2(b[j][0], b[j][1]); w.y = pk2(b[j][2], b[j][3]); *(v2u*)(wins + ((size_t)s * 520 + i) * 512 + 256 + 4 * lane) = w;
                if (i >= 8) { float* dst = o + ((size_t)s * 512 + (i - 8)) * 512 + 4 * lane; __builtin_nontemporal_store(a[j], (f32x4*)dst); __builtin_nontemporal_store(b[j], (f32x4*)(dst + 256)); } }
        }
    }
}

__device__ __forceinline__ void cmp_finalize(Frame& F) {
    const float* PB = (const float*)(F.ws + WS_PBUF); const float* cvec = (const float*)(F.ws + WS_CVEC); const float* w2 = F.in[I_CW2];
    const int lane = F.lane, r = lane & 31, h = lane >> 5;
    constexpr int LP = NB * NCP * NG  , LS = DB * NCS * NG  , BP = (LP + 31) / 32, BS = (LS + 31) / 32, NBT = 2 * BP + 2 * BS;
    bf16x8 wf[2][4]; int wc_ = -1;
    for (int bt = F.gw; bt < NBT; bt += F.NGW) {
        int c, lb, len; bool prompt;
        if (bt < 2 * BP) { prompt = true; c = bt / BP; lb = bt % BP; len = LP; } else { const int q = bt - 2 * BP; prompt = false; c = q / BS; lb = q % BS; len = LS; }
        int idx = lb * 32 + r; const bool valid = idx < len; idx = valid ? idx : len - 1;
        const int g = idx & 3; int q = idx >> 2; size_t row0; bf16* dst;
        if (prompt) { const int n = q % NCP, sq = q / NCP; row0 = (((size_t)(c * NB + sq) * 512 + n) * NG + g); dst = (bf16*)(F.ws + (c ? WS_VCP : WS_KCP)) + ((size_t)(sq * NG + g) * 512 + n) * 64; }
        else { const int n = q % NCS, sq = q / NCS; row0 = CMP_ROWS_P + (((size_t)(c * DB + sq) * 128 + n) * NG + g); dst = (bf16*)(F.ws + (c ? WS_VCS : WS_KCS)) + ((size_t)(sq * NG + g) * 128 + n) * 64; }
        const float* p0 = PB + row0 * 128 + 8 * h; const float* p1 = PB + (row0 + NG) * 128 + 64 + 8 * h;
        f32x4 a[4][2], b[4][2];
#pragma unroll
        for (int ks = 0; ks < 4; ++ks) { a[ks][0] = ld4(p0 + 16 * ks); a[ks][1] = ld4(p0 + 16 * ks + 4); b[ks][0] = ld4(p1 + 16 * ks); b[ks][1] = ld4(p1 + 16 * ks + 4); }
        if (c != wc_) { wc_ = c;
#pragma unroll
            for (int fb = 0; fb < 2; ++fb)
#pragma unroll
                for (int ks = 0; ks < 4; ++ks) { const float* wp = w2 + ((size_t)c * 64 + 16 * ks + 8 * h) * 64 + 32 * fb + r;
                    v4u o; o.x = cvt_pk(wp[0], wp[64]); o.y = cvt_pk(wp[128], wp[192]); o.z = cvt_pk(wp[256], wp[320]); o.w = cvt_pk(wp[384], wp[448]); wf[fb][ks] = __builtin_bit_cast(bf16x8, o); } }
        f32x16 acc[2];
#pragma unroll
        for (int fb = 0; fb < 2; ++fb)
#pragma unroll
            for (int i = 0; i < 16; ++i) acc[fb][i] = 0.f;
#pragma unroll
        for (int ks = 0; ks < 4; ++ks) { const float* cv = cvec + c * 64 + 16 * ks + 8 * h; const f32x4 c0 = ld4(cv), c1 = ld4(cv + 4);
            const f32x4 x0 = a[ks][0] + b[ks][0] + c0, x1 = a[ks][1] + b[ks][1] + c1;
            v4u o; o.x = cvt_pk(gelu_tanh(x0[0]), gelu_tanh(x0[1])); o.y = cvt_pk(gelu_tanh(x0[2]), gelu_tanh(x0[3])); o.z = cvt_pk(gelu_tanh(x1[0]), gelu_tanh(x1[1])); o.w = cvt_pk(gelu_tanh(x1[2]), gelu_tanh(x1[3]));
            const bf16x8 hf = __builtin_bit_cast(bf16x8, o);
#pragma unroll
            for (int fb = 0; fb < 2; ++fb) acc[fb] = __builtin_amdgcn_mfma_f32_32x32x16_bf16(wf[fb][ks], hf, acc[fb], 0, 0, 0); }
        if (valid) {
#pragma unroll
            for (int fb = 0; fb < 2; ++fb)
#pragma unroll
                for (int q4 = 0; q4 < 4; ++q4) { v2u w; w.x = cvt_pk(acc[fb][4 * q4], acc[fb][4 * q4 + 1]); w.y = cvt_pk(acc[fb][4 * q4 + 2], acc[fb][4 * q4 + 3]);
                    *(v2u*)(dst + 32 * fb + 8 * q4 + 4 * h) = w; }
        }
    }
}

__device__ __forceinline__ void final_norm(Frame& F) {
    const bf16* X = (const bf16*)(F.ws + WS_XBA); const float* ss = F.SS(6); const float* gn = F.in[I_NFIN];
    for (int r = F.gw; r < M; r += F.NGW) {
        const float rstd = rsqrtf(ss[r] * (1.f / DM) + EPS);
        float* o = (r < MP) ? F.out + O_YP + (size_t)r * DM : F.out + O_YS + (size_t)(r - MP) * DM;
#pragma unroll
        for (int j = 0; j < 2; ++j) { const int c = 8 * F.lane + 512 * j; f32x4 v0, v1; unpk8(*(const v4u*)(X + (size_t)r * DM + c), v0, v1);
            __builtin_nontemporal_store(v0 * rstd * ld4(gn + c), (f32x4*)(o + c)); __builtin_nontemporal_store(v1 * rstd * ld4(gn + c + 4), (f32x4*)(o + c + 4)); }
    }
}
constexpr int SG_PITCH = 68;
struct SgPre { v4u a, b; float f; };
template <bool DUAL, class Pre, class Fn>
__device__ __forceinline__ void sgemm_tile(LAS unsigned char* lds, const bf16* A, int lda, const bf16* B0, const bf16* B1, int K, int wave, int lane, const Pre& pre, const Fn& fn) {
    LAS float* part = (LAS float*)lds;
    const int nsl = DUAL ? 4 : 8, sl = DUAL ? (wave & 3) : wave; const bf16* Bt = (DUAL && wave >= 4) ? B1 : B0;
    const int ksl = K / nsl, k0 = sl * ksl, steps = ksl / 16;
    const int r = lane & 31, h = lane >> 5;
    f32x16 acc[2][2];
#pragma unroll
    for (int a = 0; a < 2; ++a)
#pragma unroll
        for (int b = 0; b < 2; ++b)
#pragma unroll
            for (int i = 0; i < 16; ++i) acc[a][b][i] = 0.f;
    const bf16* ap = A + (size_t)r * lda + k0 + 8 * h; const bf16* bp = Bt + (size_t)r * K + k0 + 8 * h;
    for (int s0 = 0; s0 < steps; s0 += 8) {
        bf16x8 fa0[8], fa1[8], fb0[8], fb1[8];
#pragma unroll
        for (int j = 0; j < 8; ++j) { const int st = (s0 + j < steps) ? s0 + j : steps - 1;
            fa0[j] = *(const bf16x8*)(ap + 16 * st); fa1[j] = *(const bf16x8*)(ap + (size_t)32 * lda + 16 * st); fb0[j] = *(const bf16x8*)(bp + 16 * st); fb1[j] = *(const bf16x8*)(bp + (size_t)32 * K + 16 * st); }
        __builtin_amdgcn_sched_barrier(0);
#pragma unroll
        for (int j = 0; j < 8; ++j) if (s0 + j < steps) {
            acc[0][0] = __builtin_amdgcn_mfma_f32_32x32x16_bf16(fa0[j], fb0[j], acc[0][0], 0, 0, 0); acc[0][1] = __builtin_amdgcn_mfma_f32_32x32x16_bf16(fa0[j], fb1[j], acc[0][1], 0, 0, 0);
            acc[1][0] = __builtin_amdgcn_mfma_f32_32x32x16_bf16(fa1[j], fb0[j], acc[1][0], 0, 0, 0); acc[1][1] = __builtin_amdgcn_mfma_f32_32x32x16_bf16(fa1[j], fb1[j], acc[1][1], 0, 0, 0); }
    }
    const int t = wave * 64 + lane, row = t >> 3, c8 = (t & 7) * 8;
    const SgPre pv = pre(row, c8);
    LAS float* pw = part + wave * 64 * SG_PITCH;
#pragma unroll
    for (int a = 0; a < 2; ++a)
#pragma unroll
        for (int b = 0; b < 2; ++b)
#pragma unroll
            for (int i = 0; i < 16; ++i) pw[(32 * a + (i & 3) + 8 * (i >> 2) + 4 * h) * SG_PITCH + 32 * b + r] = acc[a][b][i];
    asm volatile("s_waitcnt lgkmcnt(0)" ::: "memory"); __syncthreads();
    f32x4 v0 = {0.f, 0.f, 0.f, 0.f}, v1 = v0, w0 = v0, w1 = v0;
#pragma unroll
    for (int p = 0; p < nsl; ++p) { const LAS float* q = part + (p * 64 + row) * SG_PITCH + c8; v0 += *(const LAS f32x4*)q; v1 += *(const LAS f32x4*)(q + 4); }
    if (DUAL) {
#pragma unroll
        for (int p = 4; p < 8; ++p) { const LAS float* q = part + (p * 64 + row) * SG_PITCH + c8; w0 += *(const LAS f32x4*)q; w1 += *(const LAS f32x4*)(q + 4); }
    }
    fn(row, c8, v0, v1, w0, w1, pv);
    asm volatile("s_waitcnt lgkmcnt(0)" ::: "memory"); __syncthreads();
}
__device__ __forceinline__ void ss_accum8(float* ssout, int r, float s, int lane) {
    s += __shfl_xor(s, 1); s += __shfl_xor(s, 2); s += __shfl_xor(s, 4);
    if ((lane & 7) == 0) atomicAdd(ssout + r, s);
}
__device__ __forceinline__ float sumsq8(f32x4 a, f32x4 b) { return (a[0] * a[0] + a[1] * a[1]) + (a[2] * a[2] + a[3] * a[3]) + (b[0] * b[0] + b[1] * b[1]) + (b[2] * b[2] + b[3] * b[3]); }

__device__ __forceinline__ void sample_resid(Frame& F, const bf16* A, int lda, const bf16* Bt, int K, const bf16* XI, bf16* XO, float* ssout) {
    for (int u = blockIdx.x; u < 256; u += gridDim.x) { const int rb = u >> 4, cbk = u & 15; const int lane = F.lane;
        sgemm_tile<false>(F.lds, A + (size_t)(MP + 64 * rb) * lda, lda, Bt + (size_t)(64 * cbk) * K, nullptr, K, F.wave, lane,
            [&](int row, int c8) { SgPre p; p.a = *(const v4u*)(XI + (size_t)(MP + 64 * rb + row) * DM + 64 * cbk + c8); p.b = p.a; p.f = 0.f; return p; },
            [&](int row, int c8, f32x4 v0, f32x4 v1, f32x4, f32x4, const SgPre& pv) { const int r = MP + 64 * rb + row, c0 = 64 * cbk + c8;
                f32x4 x0, x1; unpk8(pv.a, x0, x1); v0 += x0; v1 += x1;
                *(v4u*)(XO + (size_t)r * DM + c0) = pk8c(v0, v1);
                ss_accum8(ssout, r, sumsq8(v0, v1), lane); }); }
}
__device__ __forceinline__ void sample_gate(Frame& F, const bf16* A, const bf16* Bt, const float* ss, const bf16* PP, const bf16* XI, bf16* XO, bf16* XG, float* ssout) {
    for (int u = blockIdx.x; u < 256; u += gridDim.x) { const int rb = u >> 4, cbk = u & 15; const int lane = F.lane;
        sgemm_tile<false>(F.lds, A + (size_t)(MP + 64 * rb) * DM, DM, Bt + (size_t)(64 * cbk) * DM, nullptr, DM, F.wave, lane,
            [&](int row, int c8) { const int r = MP + 64 * rb + row, c0 = 64 * cbk + c8; SgPre p; p.a = *(const v4u*)(PP + (size_t)r * DM + c0); p.b = *(const v4u*)(XI + (size_t)r * DM + c0); p.f = ss[r]; return p; },
            [&](int row, int c8, f32x4 a0, f32x4 a1, f32x4, f32x4, const SgPre& pv) { const int r = MP + 64 * rb + row, c0 = 64 * cbk + c8;
                const float rstd = rsqrtf(pv.f * (1.f / DM) + EPS);
                f32x4 p0, p1, v0, v1; unpk8(pv.a, p0, p1); unpk8(pv.b, v0, v1);
                a0 = a0 * rstd; a1 = a1 * rstd;
#pragma unroll
                for (int e = 0; e < 4; ++e) { v0[e] += p0[e] * sigmoidf_(a0[e]); v1[e] += p1[e] * sigmoidf_(a1[e]); }
                const v4u wv = pk8c(v0, v1); *(v4u*)(XO + (size_t)r * DM + c0) = wv;
                if (XG) *(v4u*)(XG + ((size_t)(c0 >> 4) * M + r) * 16 + (c0 & 15)) = wv;
                ss_accum8(ssout, r, sumsq8(v0, v1), lane); }); }
}
__device__ __forceinline__ void sample_glu(Frame& F, const bf16* A, const bf16* WgluT, const bf16* XI, bf16* XO, float* ssout) {
    for (int u = blockIdx.x; u < 256; u += gridDim.x) { const int rb = u >> 4, cbk = u & 15; const int lane = F.lane; const int j0 = 64 * cbk;
        const bf16* B0 = WgluT + (size_t)((j0 >> 7) * 256 + (j0 & 127)) * DM;
        sgemm_tile<true>(F.lds, A + (size_t)(MP + 64 * rb) * DM, DM, B0, B0 + (size_t)128 * DM, DM, F.wave, lane,
            [&](int row, int c8) { SgPre p; p.a = *(const v4u*)(XI + (size_t)(MP + 64 * rb + row) * DM + j0 + c8); p.b = p.a; p.f = 0.f; return p; },
            [&](int row, int c8, f32x4 a0, f32x4 a1, f32x4 b0, f32x4 b1, const SgPre& pv) { const int r = MP + 64 * rb + row, c0 = j0 + c8;
                f32x4 v0, v1; unpk8(pv.a, v0, v1);
#pragma unroll
                for (int e = 0; e < 4; ++e) { v0[e] += a0[e] * sigmoidf_(b0[e]); v1[e] += a1[e] * sigmoidf_(b1[e]); }
                *(v4u*)(XO + (size_t)r * DM + c0) = pk8c(v0, v1);
                ss_accum8(ssout, r, sumsq8(v0, v1), lane); }); }
}

__device__ __forceinline__ void sample_plain(Frame& F, const bf16* A, int lda, const bf16* Bt, int K, bf16* O) {
    for (int u = blockIdx.x; u < 256; u += gridDim.x) { const int rb = u >> 4, cbk = u & 15;
        sgemm_tile<false>(F.lds, A + (size_t)(MP + 64 * rb) * lda, lda, Bt + (size_t)(64 * cbk) * K, nullptr, K, F.wave, F.lane,
            [&](int, int) { SgPre p; p.a = (v4u){0u, 0u, 0u, 0u}; p.b = p.a; p.f = 0.f; return p; },
            [&](int row, int c8, f32x4 v0, f32x4 v1, f32x4, f32x4, const SgPre&) { *(v4u*)(O + (size_t)(MP + 64 * rb + row) * DM + 64 * cbk + c8) = pk8c(v0, v1); }); }
}
__device__ __forceinline__ void sample_plain_sub(Frame& F, const bf16* A, int lda, const bf16* Bt, int K, bf16* O, int r, int n) {
    for (int u = r; u < 256; u += n) { const int rb = u >> 4, cbk = u & 15;
        sgemm_tile<false>(F.lds, A + (size_t)(MP + 64 * rb) * lda, lda, Bt + (size_t)(64 * cbk) * K, nullptr, K, F.wave, F.lane,
            [&](int, int) { SgPre p; p.a = (v4u){0u, 0u, 0u, 0u}; p.b = p.a; p.f = 0.f; return p; },
            [&](int row, int c8, f32x4 v0, f32x4 v1, f32x4, f32x4, const SgPre&) { *(v4u*)(O + (size_t)(MP + 64 * rb + row) * DM + 64 * cbk + c8) = pk8c(v0, v1); }); }
}
__device__ __forceinline__ void prompt_cmp(Frame& F) {
    const bf16* A = (const bf16*)(F.ws + WS_CMPA); const bf16* W = (const bf16*)(F.ws + WS_W1R_T); float* PB = (float*)(F.ws + WS_PBUF);
    for (int u = blockIdx.x; u < 256; u += gridDim.x) { const int rb = u >> 1, c2 = u & 1, c = (64 * rb) / (CMP_ROWS_P / 2);
        sgemm_tile<false>(F.lds, A + (size_t)(64 * rb) * 1024, 1024, W + (size_t)(128 * c + 64 * c2) * 1024, nullptr, 1024, F.wave, F.lane,
            [&](int, int) { SgPre p; p.a = (v4u){0u, 0u, 0u, 0u}; p.b = p.a; p.f = 0.f; return p; },
            [&](int row, int c8, f32x4 v0, f32x4 v1, f32x4, f32x4, const SgPre&) { float* o = PB + (size_t)(64 * rb + row) * 128 + 64 * c2 + c8; st4(o, v0); st4(o + 4, v1); }); }
}

constexpr int SC_PITCH = 2064, SC_BUF = 32 * SC_PITCH;
__device__ __forceinline__ void sample_cmp_pages(Frame& F) {
    LAS unsigned char* al = F.lds;
    const int lane = F.lane, w = F.wave, j16 = lane & 15, kq = lane >> 4;
    const int c = blockIdx.x & 1, u0 = blockIdx.x >> 1, ustep = gridDim.x >> 1;
    const float* ckv = F.in[I_CKV] + c * 256 + 4 * lane; float* PB = (float*)(F.ws + WS_PBUF);
    bf16x8 bq[32];
    { const bf16* bp = (const bf16*)(F.ws + WS_W1R_T) + (size_t)(c * 128 + 16 * w + j16) * 1024 + 8 * kq;
#pragma unroll
      for (int ks = 0; ks < 32; ++ks) bq[ks] = *(const bf16x8*)(bp + 32 * ks); }
    LAS unsigned char* aw = al + (lane >> 4) * SC_PITCH + 2 * (w * 64 + (lane & 15) * 4);
    LAS const unsigned char* ap = al + j16 * SC_PITCH + 16 * kq;
    f32x4 v[16];
    int u = u0;
    if (u < DB * NPAGES) { const float* src = ckv + ((size_t)F.pt[u] * PAGE + w) * 1024;
#pragma unroll
        for (int i = 0; i < 16; ++i) v[i] = __builtin_nontemporal_load((const f32x4*)(src + (size_t)i * 8192));
#pragma unroll
        for (int i = 0; i < 16; ++i) { v2u wv; wv.x = cvt_pk(v[i][0], v[i][1]); wv.y = cvt_pk(v[i][2], v[i][3]); *(LAS v2u*)(aw + (i >> 1) * 4 * SC_PITCH + (i & 1) * 1024) = wv; } }
    LDS_WAIT(); __syncthreads();
    for (int p = 0; u < DB * NPAGES; u += ustep, p ^= 1) {
        const int un = u + ustep; const bool more = un < DB * NPAGES;
        if (more) { const float* src = ckv + ((size_t)F.pt[un] * PAGE + w) * 1024;
#pragma unroll
            for (int i = 0; i < 16; ++i) v[i] = __builtin_nontemporal_load((const f32x4*)(src + (size_t)i * 8192)); }
        f32x4 acc0 = {0.f, 0.f, 0.f, 0.f}, acc1 = acc0;
        LAS const unsigned char* a = ap + p * SC_BUF;
#pragma unroll
        for (int ks = 0; ks < 32; ++ks) { const bf16x8 a0 = *(LAS const bf16x8*)(a + 64 * ks), a1 = *(LAS const bf16x8*)(a + 16 * SC_PITCH + 64 * ks);
            acc0 = __builtin_amdgcn_mfma_f32_16x16x32_bf16(a0, bq[ks], acc0, 0, 0, 0); acc1 = __builtin_amdgcn_mfma_f32_16x16x32_bf16(a1, bq[ks], acc1, 0, 0, 0); }
        const int s = u >> 4, pg = u & 15;
        float* po = PB + ((size_t)CMP_ROWS_P + (size_t)(c * DB + s) * 512 + 32 * pg + 4 * kq) * 128 + 16 * w + j16;
#pragma unroll
        for (int e = 0; e < 4; ++e) { po[e * 128] = acc0[e]; po[(16 + e) * 128] = acc1[e]; }
        if (more) { LAS unsigned char* d = aw + (p ^ 1) * SC_BUF;
#pragma unroll
            for (int i = 0; i < 16; ++i) { v2u wv; wv.x = cvt_pk(v[i][0], v[i][1]); wv.y = cvt_pk(v[i][2], v[i][3]); *(LAS v2u*)(d + (i >> 1) * 4 * SC_PITCH + (i & 1) * 1024) = wv; } }
        LDS_WAIT(); __syncthreads();
    }
}

typedef short s16x4 __attribute__((ext_vector_type(4)));
constexpr float NEGS = -3.0e38f;
constexpr int VBUF = 4096;
constexpr int AL_K = 0, AL_V = VBUF, AL_IMP = 2 * VBUF, AL_V1 = 2 * VBUF  , AL_SELM = 2 * VBUF + 8192, AL_END = AL_SELM + 256;
static_assert(AL_END <= WAVE_LDS, "attention LDS map");

struct ASeq {
    const bf16* kc; const bf16* vc; int nc;
    const bf16* ks; int spitch; int srows;
    const bf16* kw; int wpitch; int wrows; int wpos0;
    int qpos0; int ns;
};

__device__ __forceinline__ float ex2(float x) { return __builtin_amdgcn_exp2f(x); }
typedef unsigned v2uu __attribute__((ext_vector_type(2)));
__device__ __forceinline__ float xhalf_max(float v) { const unsigned b = __float_as_uint(v); const v2uu r = __builtin_amdgcn_permlane32_swap(b, b, false, false); float o; asm("v_max_f32 %0, %1, %2" : "=v"(o) : "v"(r[0]), "v"(r[1])); return o; }
__device__ __forceinline__ float xhalf_sum(float v) { const unsigned b = __float_as_uint(v); const v2uu r = __builtin_amdgcn_permlane32_swap(b, b, false, false); return __uint_as_float(r[0]) + __uint_as_float(r[1]); }
template <int CTRL> __device__ __forceinline__ float dpp_f(float v) { return __uint_as_float((unsigned)__builtin_amdgcn_update_dpp(0, (int)__float_as_uint(v), CTRL, 0xf, 0xf, true)); }
__device__ __forceinline__ float quad_sum(float v) { v += dpp_f<0xB1>(v); v += dpp_f<0x4E>(v); return v; }

__device__ __forceinline__ void issue_k(LAS unsigned char* kbuf, const bf16* kbase, int pitch, int row0, int nrows, int lane) {
#pragma unroll
    for (int i = 0; i < 4; ++i) { int row = row0 + 8 * i + (lane >> 3); row = row < nrows ? row : nrows - 1;
        const int ch = (lane & 7) ^ ((lane >> 3) & 7);
        __builtin_amdgcn_global_load_lds((const unsigned*)(kbase + (size_t)row * pitch + 8 * ch), (LAS unsigned*)(kbuf + i * 1024), 16, 0, 0); }
}
__device__ __forceinline__ void read_kf(bf16x8 (&kf)[4], LAS const unsigned char* kbuf, int lane) {
    const int key = lane & 31, h = lane >> 5;
#pragma unroll
    for (int ks = 0; ks < 4; ++ks) kf[ks] = *(LAS const bf16x8*)(kbuf + key * 128 + (((2 * ks + h) ^ (key & 7)) << 4));
}
__device__ __forceinline__ void issue_v(LAS unsigned char* vbuf, const bf16* vbase, int pitch, int row0, int nrows, int lane) {
#pragma unroll
    for (int i = 0; i < 4; ++i) { int row = row0 + 8 * i + (lane >> 3); row = row < nrows ? row : nrows - 1;
        const int ch = (lane & 7) ^ (((lane >> 4) & 1) << 2);
        __builtin_amdgcn_global_load_lds((const unsigned*)(vbase + (size_t)row * pitch + 8 * ch), (LAS unsigned*)(vbuf + i * 1024), 16, 0, 0); }
}
__device__ __forceinline__ s16x4 vtr(LAS const unsigned char* p) { return __builtin_bit_cast(s16x4, __builtin_amdgcn_ds_read_tr16_b64_v4i16((LAS s16x4*)p)); }
__device__ __forceinline__ bf16x8 vfrag(LAS const unsigned char* va, int ks) {
    const s16x4 lo = vtr(va + ks * 2048), hi = vtr(va + ks * 2048 + 1024);
    bf16x8 r; r[0] = lo[0]; r[1] = lo[1]; r[2] = lo[2]; r[3] = lo[3]; r[4] = hi[0]; r[5] = hi[1]; r[6] = hi[2]; r[7] = hi[3]; return r;
}

template <int NQB> struct AState { float m[NQB], l[NQB]; f32x16 o[2][NQB]; };

#define OFFI(i) (((i) & 3) + 8 * ((i) >> 2))
__device__ __forceinline__ void qk_raw(f32x16& acc, const bf16x8 (&kf)[4], const bf16x8 (&qf)[4]) {
#pragma unroll
    for (int i = 0; i < 16; ++i) acc[i] = 0.f;
#pragma unroll
    for (int ks = 0; ks < 4; ++ks) acc = __builtin_amdgcn_mfma_f32_32x32x16_bf16(kf[ks], qf[ks], acc, 0, 0, 0);
}
__device__ __forceinline__ void mask_bias(f32x16& s, float sl_alpha, float fb, int lo_rel, int hi_rel, bool extra) {
#pragma unroll
    for (int i = 0; i < 16; ++i) { const bool ok = extra && (OFFI(i) <= hi_rel) && (OFFI(i) >= lo_rel); s[i] = ok ? __builtin_fmaf(sl_alpha, (float)OFFI(i), s[i] + fb) : NEGS; }
}
template <int NQB>
__device__ __forceinline__ void scores(f32x16& s, const bf16x8 (&kf)[4], const bf16x8 (&qf)[4], float sl_alpha, float fb, int lo_rel, int hi_rel, bool extra) {
    qk_raw(s, kf, qf); mask_bias(s, sl_alpha, fb, lo_rel, hi_rel, extra);
}
__device__ __forceinline__ float max16(const f32x16& s) {
    float a = fmaxf(fmaxf(s[0], s[1]), fmaxf(s[2], s[3])), b = fmaxf(fmaxf(s[4], s[5]), fmaxf(s[6], s[7])), c = fmaxf(fmaxf(s[8], s[9]), fmaxf(s[10], s[11])), d = fmaxf(fmaxf(s[12], s[13]), fmaxf(s[14], s[15]));
    return fmaxf(fmaxf(a, b), fmaxf(c, d));
}
__device__ __forceinline__ void pack_p(bf16x8 (&pf)[2], const f32x16& p) {
#pragma unroll
    for (int ks = 0; ks < 2; ++ks) { v4u w; w.x = cvt_pk(p[8 * ks + 0], p[8 * ks + 1]); w.y = cvt_pk(p[8 * ks + 2], p[8 * ks + 3]); w.z = cvt_pk(p[8 * ks + 4], p[8 * ks + 5]); w.w = cvt_pk(p[8 * ks + 6], p[8 * ks + 7]); pf[ks] = __builtin_bit_cast(bf16x8, w); }
}

template <int NQB>
__device__ __forceinline__ void attn_unit(Frame& F, const ASeq& A, int qrow0, int g, int tl0, LAS unsigned char* wl) {
    int lane_ = F.lane; asm volatile("" : "+v"(lane_));
    const int lane = lane_ & 63, h = lane >> 5, c = lane & 31, head = c & 3;
    LAS unsigned char* kl = wl + AL_K; LAS unsigned char* vl = wl + AL_V; LAS float* imp = (LAS float*)(wl + AL_IMP); LAS unsigned* selm = (LAS unsigned*)(wl + AL_SELM);
    unsigned* stash0 = (unsigned*)(F.ws + WS_STASH) + (size_t)F.gw * 2048 + lane;
    const int vq = (lane & 15) >> 2, vfq = (vq >> 1) & 1;
    const int vbase_off = (4 * h + vq) * 128 + (2 * ((lane >> 4) & 1) + ((lane & 3) >> 1)) * 16 + (lane & 1) * 8;
    const int voff0 = vbase_off + vfq * 64, voff1 = vbase_off + (1 - vfq) * 64;
    const bf16* Qb = (const bf16*)(F.ws + WS_QB); bf16* Ob = (bf16*)(F.ws + WS_OB); const float* gates = (const float*)(F.ws + WS_GATES);
    bf16x8 qf[NQB][4]; int qpos[NQB];
#pragma unroll
    for (int qb = 0; qb < NQB; ++qb) {
        const int tok = qb * 8 + (c >> 2); const size_t r = (size_t)qrow0 + tok;
        const bf16* qp = Qb + r * DM + (4 * g + head) * 64 + 8 * h;
#pragma unroll
        for (int ks = 0; ks < 4; ++ks) qf[qb][ks] = *(const bf16x8*)(qp + 16 * ks);
        qpos[qb] = A.qpos0 + tl0 + tok;
    }
    const float sl = exp2f(-0.5f * (float)(4 * g + head + 1)) * LOG2E;
    const int qmin = A.qpos0 + tl0, qmax = qmin + 8 * NQB - 1;
    AState<NQB> st;

#pragma unroll
    for (int i = 0; i < 8; ++i) *(LAS f32x4*)(imp + (i * 64 + lane) * 4) = (f32x4){0.f, 0.f, 0.f, 0.f};

    int lim[NQB];
#pragma unroll
    for (int qb = 0; qb < NQB; ++qb) { int nv = qpos[qb] >= 31 ? (qpos[qb] - 31) / 16 + 1 : 0; nv = nv < A.nc ? nv : A.nc; lim[qb] = nv - 1; }
    int nvmax = qmax >= 31 ? (qmax - 31) / 16 + 1 : 0; nvmax = nvmax < A.nc ? nvmax : A.nc;
    const int ntc = (nvmax + 31) >> 5;
#pragma unroll
    for (int qb = 0; qb < NQB; ++qb) { st.m[qb] = -1.0e30f; st.l[qb] = 0.f; }
    if (ntc > 0) issue_k(kl, A.kc, 64, 0, A.nc, lane);
    for (int tile = 0; tile < ntc; ++tile) {
        bf16x8 kf[4];
        asm volatile("s_waitcnt vmcnt(0)" ::: "memory"); read_kf(kf, kl, lane); LDS_WAIT(); asm volatile("" ::: "memory");
        if (tile + 1 < ntc) issue_k(kl, A.kc, 64, (tile + 1) * 32, A.nc, lane);
        const int nb = tile * 32 + 4 * h;
#pragma unroll
        for (int qb = 0; qb < NQB; ++qb) {
            f32x16 s; scores<NQB>(s, kf, qf[qb], sl * 16.f, sl * (16.f * (float)nb + 15.5f - (float)qpos[qb]), 0, lim[qb] - nb, true);
            float tm = xhalf_max(max16(s));
            const float mn = fmaxf(st.m[qb], tm); float sum = 0.f;
#pragma unroll
            for (int i = 0; i < 16; ++i) sum += ex2(s[i] - mn);
            st.l[qb] = st.l[qb] * ex2(st.m[qb] - mn) + sum; st.m[qb] = mn;
        }
    }
    float invl[NQB];
#pragma unroll
    for (int qb = 0; qb < NQB; ++qb) { const float lt = xhalf_sum(st.l[qb]); invl[qb] = (lim[qb] >= 0 && lt > 0.f) ? 1.f / lt : 0.f; }
#pragma unroll
    for (int db = 0; db < 2; ++db)
#pragma unroll
        for (int qb = 0; qb < NQB; ++qb)
#pragma unroll
            for (int i = 0; i < 16; ++i) st.o[db][qb][i] = 0.f;
    if (ntc > 0) { issue_k(kl, A.kc, 64, 0, A.nc, lane); issue_v(vl, A.vc, 64, 0, A.nc, lane); }
    for (int tile = 0; tile < ntc; ++tile) {
        const bool more = tile + 1 < ntc;
        bf16x8 kf[4];
        asm volatile("s_waitcnt vmcnt(4)" ::: "memory"); read_kf(kf, kl, lane); LDS_WAIT(); asm volatile("" ::: "memory");
        if (more) issue_k(kl, A.kc, 64, (tile + 1) * 32, A.nc, lane);
        const int nb = tile * 32 + 4 * h;
        bf16x8 pf[NQB][2];
#pragma unroll
        for (int qb = 0; qb < NQB; ++qb) {
            f32x16 s; scores<NQB>(s, kf, qf[qb], sl * 16.f, sl * (16.f * (float)nb + 15.5f - (float)qpos[qb]), 0, lim[qb] - nb, true);
            f32x16 p;
#pragma unroll
            for (int i = 0; i < 16; ++i) p[i] = ex2(s[i] - st.m[qb]) * invl[qb];
#pragma unroll
            for (int q = 0; q < 4; ++q) { const float v = quad_sum((p[4 * q] + p[4 * q + 1]) + (p[4 * q + 2] + p[4 * q + 3]));
                if (head == 0) imp[(qb * 8 + (c >> 2)) * 128 + 8 * tile + 2 * q + h] = v; }
            pack_p(pf[qb], p);
        }
        if (more) asm volatile("s_waitcnt vmcnt(4) lgkmcnt(0)" ::: "memory"); else asm volatile("s_waitcnt vmcnt(0) lgkmcnt(0)" ::: "memory");
#pragma unroll
        for (int db = 0; db < 2; ++db)
#pragma unroll
            for (int ks = 0; ks < 2; ++ks) { const bf16x8 vf = vfrag(vl + (db ? voff1 : voff0), ks);
#pragma unroll
                for (int qb = 0; qb < NQB; ++qb) st.o[db][qb] = __builtin_amdgcn_mfma_f32_32x32x16_bf16(vf, pf[qb][ks], st.o[db][qb], 0, 0, 0); }
        LDS_WAIT(); asm volatile("" ::: "memory");
        if (more) issue_v(vl, A.vc, 64, (tile + 1) * 32, A.nc, lane);
    }
    asm volatile("s_waitcnt vmcnt(0) lgkmcnt(0)" ::: "memory");

    unsigned taken = 0u;
    {
        const int tok = lane >> 2, part = lane & 3; const bool live = tok < 8 * NQB;
        const int cur = (A.qpos0 + tl0 + tok) >> 6;
        float v[32];
#pragma unroll
        for (int j4 = 0; j4 < 8; ++j4) { const f32x4 t = *(LAS const f32x4*)(imp + (live ? tok : 0) * 128 + 32 * part + 4 * j4); v[4 * j4] = t[0]; v[4 * j4 + 1] = t[1]; v[4 * j4 + 2] = t[2]; v[4 * j4 + 3] = t[3]; }
        const int rel = cur - 32 * part, nsrel = A.ns - 32 * part;
#pragma unroll
        for (int j = 0; j < 32; ++j) { const bool forced = (j == rel) || (j == rel - 1) || (j == 0 && part == 0);
            v[j] = (j < nsrel) ? ((j <= rel) ? v[j] + (forced ? 1.0e4f : 0.f) : -1.0e30f) : NEGS; }
        for (int k = 0; k < 16; ++k) {
            float bv = -__builtin_inff(); int bj = 0;
#pragma unroll
            for (int j = 0; j < 32; ++j) { const float cnd = ((taken >> j) & 1u) ? NEGS : v[j]; if (cnd > bv) { bv = cnd; bj = j; } }
            int bi = 32 * part + bj;
            { const float ov = dpp_f<0xB1>(bv); const int oi = __builtin_amdgcn_update_dpp(0, bi, 0xB1, 0xf, 0xf, true); if (ov > bv || (ov == bv && oi < bi)) { bv = ov; bi = oi; } }
            { const float ov = dpp_f<0x4E>(bv); const int oi = __builtin_amdgcn_update_dpp(0, bi, 0x4E, 0xf, 0xf, true); if (ov > bv || (ov == bv && oi < bi)) { bv = ov; bi = oi; } }
            if ((bi >> 5) == part) taken |= 1u << (bi & 31);
        }
        if (!live) taken = 0u;
        selm[lane] = taken;
    }
    LDS_WAIT(); asm volatile("" ::: "memory");
    { unsigned* stash = stash0; asm volatile("" : "+v"(stash));
#pragma unroll
    for (int db = 0; db < 2; ++db)
#pragma unroll
        for (int qb = 0; qb < NQB; ++qb)
#pragma unroll
            for (int k = 0; k < 8; ++k) { const float g0 = gates[((size_t)qrow0 + qb * 8 + (c >> 2)) * 48 + (4 * g + head) * 3];
                stash[((db * NQB + qb) * 8 + k) * 64] = cvt_pk(st.o[db][qb][2 * k] * g0, st.o[db][qb][2 * k + 1] * g0); } }
    unsigned un[4], unq[NQB][4];
    { unsigned u = taken; u |= __shfl_xor(u, 4); u |= __shfl_xor(u, 8); u |= __shfl_xor(u, 16);
#pragma unroll
      for (int qb = 0; qb < NQB; ++qb)
#pragma unroll
          for (int p = 0; p < 4; ++p) unq[qb][p] = __builtin_amdgcn_readlane(u, 32 * qb + p);
#pragma unroll
      for (int p = 0; p < 4; ++p) { un[p] = unq[0][p]; if (NQB > 1) un[p] |= unq[NQB - 1][p]; } }
    LDS_WAIT(); asm volatile("" ::: "memory");

    f32x16 sbase;
#pragma unroll
    for (int i = 0; i < 16; ++i) sbase[i] = sl * (float)OFFI(i);
#pragma unroll
    for (int br = 0; br < 2; ++br) {
#pragma unroll
        for (int qb = 0; qb < NQB; ++qb) { st.m[qb] = -1.0e30f; st.l[qb] = 0.f; }
#pragma unroll
        for (int db = 0; db < 2; ++db)
#pragma unroll
            for (int qb = 0; qb < NQB; ++qb)
#pragma unroll
                for (int i = 0; i < 16; ++i) st.o[db][qb][i] = 0.f;
        const bf16* kb_ = br == 0 ? A.ks : A.kw; const int pitch = br == 0 ? A.spitch : A.wpitch, nrows = br == 0 ? A.srows : A.wrows, pos0 = br == 0 ? 0 : A.wpos0;
        const int curblk = qmin >> 6;
        unsigned ub[4];
#pragma unroll
        for (int p = 0; p < 4; ++p) { const int hi = curblk - 32 * p; ub[p] = hi < 0 ? 0u : (hi >= 31 ? un[p] : (un[p] & ((2u << hi) - 1u))); }
        int wrow_min = 0, wrow_cur = -1, ublk = 0, upart = 3, hcnt = 0; unsigned ubits = ub[3];
        if (br == 1) { int lo = qmin - 511 - pos0; lo = lo > 0 ? lo : 0; wrow_min = lo & ~31; wrow_cur = (qmax - pos0) & ~31; }
#define NEXT_TILE(ROW, BLK, OK) do { OK = false; \
            if (br == 0) { for (;;) { \
                if (hcnt == 0) { while (ubits == 0u && upart > 0) { --upart; ubits = upart == 2 ? ub[2] : (upart == 1 ? ub[1] : ub[0]); } \
                    if (ubits == 0u) break; \
                    const int j_ = 31 - __builtin_clz(ubits); ubits &= ~(1u << j_); ublk = 32 * upart + j_; hcnt = 2; } \
                --hcnt; const int r_ = ublk * 64 + 32 * hcnt; if (r_ > qmax) continue; \
                ROW = r_; BLK = ublk; OK = true; break; } } \
            else if (wrow_cur >= wrow_min) { ROW = wrow_cur; BLK = 0; wrow_cur -= 32; OK = true; } } while (0)
        int crow = 0, cblk = 0; bool cok; NEXT_TILE(crow, cblk, cok);
        int pb = 0;
        if (cok) { issue_k(kl, kb_, pitch, crow, nrows, lane); issue_v(vl, kb_ + 256, pitch, crow, nrows, lane); }
        while (cok) {
            int nrow = 0, nblk = 0; bool nok; NEXT_TILE(nrow, nblk, nok);
            bf16x8 kf[4];
            asm volatile("s_waitcnt vmcnt(4)" ::: "memory"); read_kf(kf, kl, lane); LDS_WAIT(); asm volatile("" ::: "memory");
            if (nok) { issue_k(kl, kb_, pitch, nrow, nrows, lane); issue_v(pb ? vl : wl + AL_V1, kb_ + 256, pitch, nrow, nrows, lane); }
            bool sb[NQB], act[NQB];
#pragma unroll
            for (int qb = 0; qb < NQB; ++qb) { sb[qb] = true; act[qb] = true;
                if (br == 0) { const unsigned w = selm[(qb * 8 + (c >> 2)) * 4 + (cblk >> 5)]; sb[qb] = (w >> (cblk & 31)) & 1u;
                    const int pp = cblk >> 5; const unsigned uw = pp == 0 ? unq[qb][0] : (pp == 1 ? unq[qb][1] : (pp == 2 ? unq[qb][2] : unq[qb][3])); act[qb] = (uw >> (cblk & 31)) & 1u; } }
            const int nb = pos0 + crow + 4 * h;
            const bool interior = (pos0 + crow + 31 <= qmin) && (br == 0 || qmax - (pos0 + crow) < 512);
            bf16x8 pf[NQB][2];
#pragma unroll
            for (int qb = 0; qb < NQB; ++qb) if (act[qb]) {
                const bool un_ = st.m[qb] < -1.0e29f; const float mref = un_ ? 0.f : st.m[qb];
                const float fb = sl * (float)(nb - qpos[qb]);
                const float c0 = ((interior && !sb[qb]) ? NEGS : fb) - mref;
                f32x16 s;
#pragma unroll
                for (int i = 0; i < 16; ++i) s[i] = sbase[i] + c0;
#pragma unroll
                for (int ks = 0; ks < 4; ++ks) s = __builtin_amdgcn_mfma_f32_32x32x16_bf16(kf[ks], qf[qb][ks], s, 0, 0, 0);
                if (!interior) { const int lo_rel = (br == 1) ? (qpos[qb] - 511 - nb) : -64, hi_rel = qpos[qb] - nb;
#pragma unroll
                    for (int i = 0; i < 16; ++i) { const bool ok = sb[qb] && (OFFI(i) <= hi_rel) && (OFFI(i) >= lo_rel); s[i] = ok ? s[i] : NEGS; } }
                float tm = xhalf_max(max16(s));
                const bool dead = tm < -1.0e37f;
                const float shift = dead ? 0.f : (un_ ? tm : (tm > 8.f ? tm : 0.f));
                if (__any(shift != 0.f)) {
                    const float al = un_ ? 1.f : ex2(-shift);
#pragma unroll
                    for (int i = 0; i < 16; ++i) s[i] -= shift;
                    st.l[qb] *= al;
#pragma unroll
                    for (int db = 0; db < 2; ++db)
#pragma unroll
                        for (int i = 0; i < 16; ++i) st.o[db][qb][i] *= al;
                }
                if (!dead) st.m[qb] = mref + shift;
                float sum = 0.f;
#pragma unroll
                for (int i = 0; i < 16; ++i) { s[i] = ex2(s[i]); sum += s[i]; }
                st.l[qb] += sum;
                pack_p(pf[qb], s);
                __builtin_amdgcn_sched_barrier(0);
            }
            if (nok) asm volatile("s_waitcnt vmcnt(8) lgkmcnt(0)" ::: "memory"); else asm volatile("s_waitcnt vmcnt(0) lgkmcnt(0)" ::: "memory");
#pragma unroll
            for (int db = 0; db < 2; ++db)
#pragma unroll
                for (int ks = 0; ks < 2; ++ks) { const bf16x8 vf = vfrag((pb ? wl + AL_V1 : vl) + (db ? voff1 : voff0), ks);
#pragma unroll
                    for (int qb = 0; qb < NQB; ++qb) if (act[qb]) st.o[db][qb] = __builtin_amdgcn_mfma_f32_32x32x16_bf16(vf, pf[qb][ks], st.o[db][qb], 0, 0, 0); }
            LDS_WAIT(); asm volatile("" ::: "memory");
            crow = nrow; cblk = nblk; cok = nok; pb ^= 1;
        }
#undef NEXT_TILE
        unsigned* stash = stash0; asm volatile("s_waitcnt vmcnt(0)" : "+v"(stash) :: "memory");
#pragma unroll
        for (int qb = 0; qb < NQB; ++qb) {
            const int tok = qb * 8 + (c >> 2);
            const float gbr = gates[((size_t)qrow0 + tok) * 48 + (4 * g + head) * 3 + 1 + br];
            const float lt = xhalf_sum(st.l[qb]); const float sc = lt > 0.f ? gbr / lt : 0.f;
            bf16* orow = Ob + ((size_t)qrow0 + tok) * DM + (4 * g + head) * 64;
#pragma unroll
            for (int db = 0; db < 2; ++db)
#pragma unroll
                for (int k = 0; k < 8; k += 2) {
                    const unsigned w0 = stash[((db * NQB + qb) * 8 + k) * 64], w1 = stash[((db * NQB + qb) * 8 + k + 1) * 64];
                    const float e0 = __uint_as_float(w0 << 16) + st.o[db][qb][2 * k] * sc, e1 = __uint_as_float(w0 & 0xffff0000u) + st.o[db][qb][2 * k + 1] * sc;
                    const float e2 = __uint_as_float(w1 << 16) + st.o[db][qb][2 * k + 2] * sc, e3 = __uint_as_float(w1 & 0xffff0000u) + st.o[db][qb][2 * k + 3] * sc;
                    if (br == 0) { stash[((db * NQB + qb) * 8 + k) * 64] = cvt_pk(e0, e1); stash[((db * NQB + qb) * 8 + k + 1) * 64] = cvt_pk(e2, e3); }
                    else { v2u w; w.x = cvt_pk(e0, e1); w.y = cvt_pk(e2, e3); *(v2u*)(orow + 32 * db + 8 * (k >> 1) + 4 * h) = w; }
                }
        }
        LDS_WAIT(); asm volatile("" ::: "memory");
    }
}

constexpr int CW_AQ = 8192;
__device__ __forceinline__ void attn_phase_v2(Frame& F, int qslot = 0) {
    LAS unsigned char* wl = F.lds + F.wave * WAVE_LDS;
    unsigned* qh = (unsigned*)(F.ws + WS_CTL) + CW_AQ + 64 * qslot;
    constexpr int NUP = NB * NG * (SEQ / 16), NUS = DB * NG;
    for (;;) {
        unsigned u = 0; if (F.lane == 0) u = atomicAdd(qh, 1u); u = __builtin_amdgcn_readfirstlane(u);
        if (u >= (unsigned)(NUP + NUS)) break;
        ASeq A;
        if (u >= (unsigned)NUS) {
            const unsigned v_ = u - NUS; const int tt = (SEQ / 16 - 1) - (int)(v_ >> 3), b = (v_ >> 2) & 1, g = v_ & 3;
            A.kc = (const bf16*)(F.ws + WS_KCP) + (size_t)(b * NG + g) * 512 * 64; A.vc = (const bf16*)(F.ws + WS_VCP) + (size_t)(b * NG + g) * 512 * 64; A.nc = NCP;
            A.ks = (const bf16*)(F.ws + WS_KVB) + (size_t)b * SEQ * 1024 + 512 + g * 64; A.spitch = 1024; A.srows = SEQ;
            A.kw = (const bf16*)(F.ws + WS_WINB) + (size_t)b * SEQ * 512 + g * 64; A.wpitch = 512; A.wrows = SEQ; A.wpos0 = 0; A.qpos0 = 0; A.ns = NSP;
            attn_unit<2>(F, A, b * SEQ + tt * 16, g, tt * 16, wl);
        } else {
            const int v = (int)u, s = v >> 2, g = v & 3;
            A.kc = (const bf16*)(F.ws + WS_KCS) + (size_t)(s * NG + g) * 128 * 64; A.vc = (const bf16*)(F.ws + WS_VCS) + (size_t)(s * NG + g) * 128 * 64; A.nc = NCS;
            A.ks = (const bf16*)(F.ws + WS_SELS) + (size_t)s * (PAST + DS) * 512 + g * 64; A.spitch = 512; A.srows = PAST + DS;
            A.kw = (const bf16*)(F.ws + WS_WINS) + (size_t)s * 520 * 512 + g * 64; A.wpitch = 512; A.wrows = 520; A.wpos0 = PAST - 512; A.qpos0 = PAST; A.ns = NSS;
            attn_unit<1>(F, A, MP + s * DS, g, 0, wl);
        }
    }
}
constexpr int S5L = 32;
__device__ __forceinline__ void cmul(float& r, float& i, float ar, float ai) { const float t = r * ar - i * ai; i = r * ai + i * ar; r = t; }

__device__ __forceinline__ void s5_tables_part(Frame& F, int g, int q, LAS float* sl) {
    LAS float* Bbr = sl; LAS float* Bbi = sl + 1024; LAS float* Cr = sl + 2048; LAS float* Ci = sl + 3072; LAS float* Ar = sl + 4096; LAS float* Ai = sl + 4160; LAS float* Qr = sl + 4224; LAS float* Qi = sl + 4288;
    const int tid = F.tid;
    bf16* KT = (bf16*)(F.ws + WS_S5K) + (size_t)g * 32 * 256; bf16* WE = (bf16*)(F.ws + WS_S5W) + (size_t)g * 128 * 512; bf16* VI = (bf16*)(F.ws + WS_S5V) + (size_t)g * 512 * 128;
    float* AL = (float*)(F.ws + WS_S5A) + (size_t)g * 128; float* A8 = (float*)(F.ws + WS_S5A) + 64 * 128 + (size_t)g * 128;
    const float* gn = F.in[I_NMIX] + DM;
    __syncthreads();
    if (tid < 64) {
        const int p = tid;
        const float are = F.in[I_ARE][g * 64 + p], aim = F.in[I_AIM][g * 64 + p], dt = expf(F.in[I_LDT][g]);
        const float er = expf(are * dt); float sn, cs; sincosf(aim * dt, &sn, &cs);
        const float abr = er * cs, abi = er * sn;
        const float nr = abr - 1.f, ni = abi, den = are * are + aim * aim;
        const float fr_ = (nr * are + ni * aim) / den, fi_ = (ni * are - nr * aim) / den;
        Ar[p] = abr; Ai[p] = abi;
#pragma unroll
        for (int c = 0; c < 16; ++c) { const float br = F.in[I_BRE][(g * 64 + p) * 16 + c], bi = F.in[I_BIM][(g * 64 + p) * 16 + c], gg = gn[g * 16 + c];
            Bbr[p * 16 + c] = (fr_ * br - fi_ * bi) * gg; Bbi[p * 16 + c] = (fr_ * bi + fi_ * br) * gg; }
        float r = abr, i = abi; cmul(r, i, r, i); cmul(r, i, r, i); cmul(r, i, r, i);
        float qr = 1.f, qi = 0.f;
        for (int k = 0; k < q; ++k) cmul(qr, qi, r, i);
        Qr[p] = qr; Qi[p] = qi;
        if (q == 0) { A8[p] = r; A8[64 + p] = i; cmul(r, i, r, i); cmul(r, i, r, i); AL[p] = r; AL[64 + p] = i; }
    }
    for (int e = tid; e < 1024; e += 512) { Cr[e] = F.in[I_CRE][g * 1024 + e]; Ci[e] = F.in[I_CIM][g * 1024 + e]; }
    __syncthreads();
    if (tid < 256) {
        const int c = tid >> 4, cp = tid & 15;
        float acc[8];
#pragma unroll
        for (int t = 0; t < 8; ++t) acc[t] = 0.f;
        for (int p = 0; p < 64; ++p) {
            const float cr = Cr[c * 64 + p], ci = Ci[c * 64 + p], br = Bbr[p * 16 + cp], bi = Bbi[p * 16 + cp], ar = Ar[p], ai = Ai[p];
            float mr = cr * br - ci * bi, mi = cr * bi + ci * br; cmul(mr, mi, Qr[p], Qi[p]);
#pragma unroll
            for (int t = 0; t < 8; ++t) { acc[t] += mr; cmul(mr, mi, ar, ai); }
        }
        if (q == 0 && c == cp) acc[0] += F.in[I_SD][g * 16 + c] * gn[g * 16 + c];
#pragma unroll
        for (int t = 0; t < 8; ++t) KT[(8 * q + t) * 256 + tid] = (bf16)f2bf(acc[t]);
    }
    {
        const int p = tid & 63, j = tid >> 6, sidx = 31 - 8 * q - j; const float ar = Ar[p], ai = Ai[p];
        float pr = Qr[p], pi = Qi[p];
        for (int k = 0; k < j; ++k) cmul(pr, pi, ar, ai);
        float wre[16], wim[16];
#pragma unroll
        for (int cp = 0; cp < 16; ++cp) { const float br = Bbr[p * 16 + cp], bi = Bbi[p * 16 + cp]; wre[cp] = pr * br - pi * bi; wim[cp] = pr * bi + pi * br; }
        v4u o;
        o.x = pk2(wre[0], wre[1]); o.y = pk2(wre[2], wre[3]); o.z = pk2(wre[4], wre[5]); o.w = pk2(wre[6], wre[7]); *(v4u*)(WE + (size_t)p * 512 + 16 * sidx) = o;
        o.x = pk2(wre[8], wre[9]); o.y = pk2(wre[10], wre[11]); o.z = pk2(wre[12], wre[13]); o.w = pk2(wre[14], wre[15]); *(v4u*)(WE + (size_t)p * 512 + 16 * sidx + 8) = o;
        o.x = pk2(wim[0], wim[1]); o.y = pk2(wim[2], wim[3]); o.z = pk2(wim[4], wim[5]); o.w = pk2(wim[6], wim[7]); *(v4u*)(WE + (size_t)(64 + p) * 512 + 16 * sidx) = o;
        o.x = pk2(wim[8], wim[9]); o.y = pk2(wim[10], wim[11]); o.z = pk2(wim[12], wim[13]); o.w = pk2(wim[14], wim[15]); *(v4u*)(WE + (size_t)(64 + p) * 512 + 16 * sidx + 8) = o;
    }
    {
        const int p = tid & 63, cq = tid >> 6; const float ar = Ar[p], ai = Ai[p];
        float pr = Qr[p], pi = Qi[p]; cmul(pr, pi, ar, ai);
        for (int j = 0; j < 8; ++j) { const int t = 8 * q + j;
#pragma unroll
            for (int k = 0; k < 2; ++k) { const int c = 2 * cq + k; const float cr = Cr[c * 64 + p], ci = Ci[c * 64 + p];
                VI[(size_t)(16 * t + c) * 128 + p] = (bf16)f2bf(cr * pr - ci * pi); VI[(size_t)(16 * t + c) * 128 + 64 + p] = (bf16)f2bf(-(cr * pi + ci * pr)); }
            cmul(pr, pi, ar, ai);
        }
    }
    __syncthreads();
}
__device__ __forceinline__ void s5_tables(Frame& F) { for (int u = blockIdx.x; u < 256; u += gridDim.x) s5_tables_part(F, u >> 2, u & 3, (LAS float*)F.lds); }

__device__ __forceinline__ bf16x8 s5_ufrag(const bf16* XG, const float* ss, int row, int col) {
    const v4u w = *(const v4u*)(XG + ((size_t)(col >> 4) * M + row) * 16 + (col & 15)); const float rs = rsqrtf(ss[row] * (1.f / DM) + EPS);
    v4u o; o.x = cvt_pk(__uint_as_float(w.x << 16) * rs, __uint_as_float(w.x & 0xffff0000u) * rs); o.y = cvt_pk(__uint_as_float(w.y << 16) * rs, __uint_as_float(w.y & 0xffff0000u) * rs);
    o.z = cvt_pk(__uint_as_float(w.z << 16) * rs, __uint_as_float(w.z & 0xffff0000u) * rs); o.w = cvt_pk(__uint_as_float(w.w << 16) * rs, __uint_as_float(w.w & 0xffff0000u) * rs);
    return __builtin_bit_cast(bf16x8, o);
}
__device__ __forceinline__ bf16x8 ldfrag(const bf16* p) { return *(const bf16x8*)p; }
__device__ __forceinline__ void s5_store_z(bf16* Z, const f32x16& y, size_t row_t0, int g, int h) {
#pragma unroll
    for (int q = 0; q < 4; ++q) { v2u w; w.x = cvt_pk(gelu_tanh_div(y[4 * q]), gelu_tanh_div(y[4 * q + 1])); w.y = cvt_pk(gelu_tanh_div(y[4 * q + 2]), gelu_tanh_div(y[4 * q + 3]));
        *(v2u*)(Z + (row_t0 + (q >> 1)) * DM + g * 16 + 8 * (q & 1) + 4 * h) = w; }
}

constexpr int S5_EP = 65;
constexpr int S5_HP = 136;
constexpr int S5_XP = 1040;
constexpr int S5_LE = 0, S5_LH = 128 * S5_EP * 4, S5_LX = S5_LH + 64 * S5_HP * 2, S5_LK = S5_LX + 64 * S5_XP, S5_LEND = S5_LK + 16384;
static_assert(S5_LEND <= MISC_OFF, "S5 LDS map");
__device__ __forceinline__ void s5_prompt_unit(Frame& F, int b, int g, const bf16* XG, const float* ss) {
    LAS float* E = (LAS float*)(F.lds + S5_LE); LAS bf16* Hp = (LAS bf16*)(F.lds + S5_LH); LAS unsigned char* xs = F.lds + S5_LX; LAS unsigned char* kt = F.lds + S5_LK;
    const int w = F.wave;
    const bf16* KT = (const bf16*)(F.ws + WS_S5K) + (size_t)g * 32 * 256; const bf16* WE = (const bf16*)(F.ws + WS_S5W) + (size_t)g * 128 * 512; const bf16* VI = (const bf16*)(F.ws + WS_S5V) + (size_t)g * 512 * 128;
    const float* AL = (const float*)(F.ws + WS_S5A) + (size_t)g * 128;
    bf16* Z = (bf16*)(F.ws + WS_Z);
    float hr = 0.f, hi = 0.f, alr = 0.f, ali = 0.f;
    if (w == 0) { alr = AL[F.lane]; ali = AL[64 + F.lane]; }
    const int cb = w >> 2, rq = w & 3;
    __syncthreads();
    { const int tid = F.tid; const v4u* src = (const v4u*)KT; LAS v4u* dst = (LAS v4u*)kt; dst[tid] = src[tid]; dst[tid + 512] = src[tid + 512]; }
    v4u xv[8]; float rv[8];
    { const int tid = F.tid; const bf16* xsrc = XG + ((size_t)g * M + (size_t)b * SEQ) * 16;
#pragma unroll
      for (int k = 0; k < 8; ++k) { const int e = tid + 512 * k; xv[k] = *(const v4u*)(xsrc + (size_t)e * 8); rv[k] = ss[b * SEQ + (e >> 1)]; } }
    for (int seg = 0; seg < 4; ++seg) {
        int lane_ = F.lane; asm volatile("" : "+v"(lane_));
        const int lane = lane_ & 63, tid = w * 64 + lane, h = lane >> 5, c31 = lane & 31;
        const int srow0 = b * SEQ + seg * 2048;
        bf16x8 wfr[32];
        { const bf16* wp = WE + (size_t)(32 * rq + c31) * 512 + 8 * h;
#pragma unroll
          for (int s = 0; s < 32; ++s) wfr[s] = ldfrag(wp + 16 * s); }
        {
#pragma unroll
            for (int k = 0; k < 8; ++k) { const int e = tid + 512 * k, tok = e >> 1; const float rs = rsqrtf(rv[k] * (1.f / DM) + EPS); const v4u w4 = xv[k];
                v4u o; o.x = cvt_pk(__uint_as_float(w4.x << 16) * rs, __uint_as_float(w4.x & 0xffff0000u) * rs); o.y = cvt_pk(__uint_as_float(w4.y << 16) * rs, __uint_as_float(w4.y & 0xffff0000u) * rs);
                o.z = cvt_pk(__uint_as_float(w4.z << 16) * rs, __uint_as_float(w4.z & 0xffff0000u) * rs); o.w = cvt_pk(__uint_as_float(w4.w << 16) * rs, __uint_as_float(w4.w & 0xffff0000u) * rs);
                *(LAS v4u*)(xs + (tok >> 5) * S5_XP + (tok & 31) * 32 + (e & 1) * 16) = o; }
        }
        __syncthreads();
        LAS const unsigned char* xl = xs + (32 * cb + c31) * S5_XP + 16 * h;
        const int row0 = srow0 + (32 * cb + c31) * S5L;
        {
            f32x16 acc;
#pragma unroll
            for (int i = 0; i < 16; ++i) acc[i] = 0.f;
#pragma unroll
            for (int s = 0; s < 32; ++s) acc = __builtin_amdgcn_mfma_f32_32x32x16_bf16(wfr[s], *(LAS const bf16x8*)(xl + 32 * s), acc, 0, 0, 0);
#pragma unroll
            for (int i = 0; i < 16; ++i) E[(32 * rq + (i & 3) + 8 * (i >> 2) + 4 * h) * S5_EP + 32 * cb + c31] = acc[i];
        }
        __syncthreads();
        if (w == 0) {
            for (int j0 = 0; j0 < 64; j0 += 8) {
                float er[8], ei[8];
#pragma unroll
                for (int j = 0; j < 8; ++j) { er[j] = E[lane * S5_EP + j0 + j]; ei[j] = E[(64 + lane) * S5_EP + j0 + j]; }
#pragma unroll
                for (int j = 0; j < 8; ++j) {
                    Hp[(j0 + j) * S5_HP + lane] = (bf16)f2bf(hr); Hp[(j0 + j) * S5_HP + 64 + lane] = (bf16)f2bf(hi);
                    cmul(hr, hi, alr, ali); hr += er[j]; hi += ei[j];
                }
            }
        }
        __syncthreads();
        if (seg < 3) {
            const bf16* xsrc = XG + ((size_t)g * M + srow0 + 2048) * 16;
#pragma unroll
            for (int k = 0; k < 8; ++k) { const int e = tid + 512 * k; xv[k] = *(const v4u*)(xsrc + (size_t)e * 8); rv[k] = ss[srow0 + 2048 + (e >> 1)]; }
        }
        {
            f32x16 acc[4];
#pragma unroll
            for (int i4 = 0; i4 < 4; ++i4)
#pragma unroll
                for (int i = 0; i < 16; ++i) acc[i4][i] = 0.f;
            const int tin = c31 >> 4, cc = c31 & 15;
            bf16x8 vi[4][4];
#pragma unroll
            for (int ks = 0; ks < 4; ++ks)
#pragma unroll
                for (int i4 = 0; i4 < 4; ++i4) vi[ks][i4] = ldfrag(VI + (size_t)(32 * (rq + 4 * i4) + c31) * 128 + 16 * ks + 8 * h);
#pragma unroll 4
            for (int s = 0; s < 32; ++s) {
                const bf16x8 uf = *(LAS const bf16x8*)(xl + 32 * s);
#pragma unroll
                for (int i4 = 0; i4 < 4; ++i4) { const int tau = 2 * (rq + 4 * i4) + tin - s;
                    if (s <= 2 * (rq + 4 * i4) + 1) {
                        bf16x8 a = *(LAS const bf16x8*)(kt + (tau < 0 ? 0 : tau) * 512 + cc * 32 + 16 * h);
                        if (tau < 0) a = (bf16x8){0, 0, 0, 0, 0, 0, 0, 0};
                        acc[i4] = __builtin_amdgcn_mfma_f32_32x32x16_bf16(a, uf, acc[i4], 0, 0, 0); } }
            }
#pragma unroll
            for (int ks = 0; ks < 4; ++ks) {
                const bf16x8 hf = *(LAS const bf16x8*)(Hp + (32 * cb + c31) * S5_HP + 16 * ks + 8 * h);
#pragma unroll
                for (int i4 = 0; i4 < 4; ++i4) acc[i4] = __builtin_amdgcn_mfma_f32_32x32x16_bf16(vi[ks][i4], hf, acc[i4], 0, 0, 0);
            }
#pragma unroll
            for (int ks = 0; ks < 4; ++ks)
#pragma unroll
                for (int i4 = 0; i4 < 4; ++i4) vi[ks][i4] = ldfrag(VI + (size_t)(32 * (rq + 4 * i4) + c31) * 128 + 16 * (ks + 4) + 8 * h);
#pragma unroll
            for (int ks = 0; ks < 4; ++ks) {
                const bf16x8 hf = *(LAS const bf16x8*)(Hp + (32 * cb + c31) * S5_HP + 16 * (ks + 4) + 8 * h);
#pragma unroll
                for (int i4 = 0; i4 < 4; ++i4) acc[i4] = __builtin_amdgcn_mfma_f32_32x32x16_bf16(vi[ks][i4], hf, acc[i4], 0, 0, 0);
            }
#pragma unroll
            for (int i4 = 0; i4 < 4; ++i4) s5_store_z(Z, acc[i4], (size_t)row0 + 2 * (rq + 4 * i4), g, h);
        }
        __syncthreads();
    }
    if (w == 0) { F.out[O_SREP + ((size_t)b * 64 + g) * 64 + F.lane] = hr; F.out[O_SIMP + ((size_t)b * 64 + g) * 64 + F.lane] = hi; }
}

__device__ __forceinline__ void s5_sample_unit(Frame& F, int g, int cb, const bf16* XB, const float* ss) {
    const int lane = F.lane, h = lane >> 5, c31 = lane & 31, seq = 32 * cb + c31;
    const bf16* KT = (const bf16*)(F.ws + WS_S5K) + (size_t)g * 32 * 256; const bf16* WE = (const bf16*)(F.ws + WS_S5W) + (size_t)g * 128 * 512; const bf16* VI = (const bf16*)(F.ws + WS_S5V) + (size_t)g * 512 * 128;
    const float* A8 = (const float*)(F.ws + WS_S5A) + 64 * 128 + (size_t)g * 128;
    bf16* Z = (bf16*)(F.ws + WS_Z);
    const int row0 = MP + seq * DS;
    bf16x8 uf[8];
#pragma unroll
    for (int s = 0; s < 8; ++s) uf[s] = s5_ufrag(XB, ss, row0 + s, g * 16 + 8 * h);
    const float* h0r = F.in[I_SRE] + ((size_t)seq * 64 + g) * 64; const float* h0i = F.in[I_SIM] + ((size_t)seq * 64 + g) * 64;
    {
        f32x16 acc[4];
#pragma unroll
        for (int rb = 0; rb < 4; ++rb)
#pragma unroll
            for (int i = 0; i < 16; ++i) acc[rb][i] = 0.f;
        const int tin = c31 >> 4, cc = c31 & 15;
#pragma unroll
        for (int s = 0; s < 8; ++s)
#pragma unroll
            for (int rb = 0; rb < 4; ++rb) if (s <= 2 * rb + 1) { const int tau = 2 * rb + tin - s;
                bf16x8 a = ldfrag(KT + (size_t)(tau < 0 ? 0 : tau) * 256 + cc * 16 + 8 * h); if (tau < 0) a = (bf16x8){0, 0, 0, 0, 0, 0, 0, 0};
                acc[rb] = __builtin_amdgcn_mfma_f32_32x32x16_bf16(a, uf[s], acc[rb], 0, 0, 0); }
#pragma unroll
        for (int ks = 0; ks < 8; ++ks) {
            const float* hp = (ks < 4 ? h0r : h0i) + 16 * (ks & 3) + 8 * h;
            const f32x4 x0 = ld4(hp), x1 = ld4(hp + 4);
            v4u o; o.x = cvt_pk(x0[0], x0[1]); o.y = cvt_pk(x0[2], x0[3]); o.z = cvt_pk(x1[0], x1[1]); o.w = cvt_pk(x1[2], x1[3]);
            const bf16x8 hf = __builtin_bit_cast(bf16x8, o);
#pragma unroll
            for (int rb = 0; rb < 4; ++rb) acc[rb] = __builtin_amdgcn_mfma_f32_32x32x16_bf16(ldfrag(VI + (size_t)(32 * rb + c31) * 128 + 16 * ks + 8 * h), hf, acc[rb], 0, 0, 0);
        }
#pragma unroll
        for (int rb = 0; rb < 4; ++rb) s5_store_z(Z, acc[rb], (size_t)row0 + 2 * rb, g, h);
    }
    {
        f32x16 acc[4];
#pragma unroll
        for (int rb = 0; rb < 4; ++rb)
#pragma unroll
            for (int i = 0; i < 16; ++i) acc[rb][i] = 0.f;
#pragma unroll
        for (int s = 0; s < 8; ++s)
#pragma unroll
            for (int rb = 0; rb < 4; ++rb) acc[rb] = __builtin_amdgcn_mfma_f32_32x32x16_bf16(ldfrag(WE + (size_t)(32 * rb + c31) * 512 + 16 * (24 + s) + 8 * h), uf[s], acc[rb], 0, 0, 0);
        float* ore = F.out + O_SRES + ((size_t)seq * 64 + g) * 64; float* oim = F.out + O_SIMS + ((size_t)seq * 64 + g) * 64;
#pragma unroll
        for (int rb = 0; rb < 2; ++rb)
#pragma unroll
            for (int i = 0; i < 16; ++i) { const int p = 32 * rb + (i & 3) + 8 * (i >> 2) + 4 * h;
                const float xr = h0r[p], xi = h0i[p], ar = A8[p], ai = A8[64 + p];
                ore[p] = acc[rb][i] + (ar * xr - ai * xi); oim[p] = acc[rb + 2][i] + (ar * xi + ai * xr); }
    }
}

__device__ __forceinline__ void s5_phase_v2(Frame& F) {
    const bf16* XB = (const bf16*)(F.ws + WS_XG); const float* ss = F.SS(3);
    const int G = gridDim.x, bid = blockIdx.x;
    const int npw = (G >= 256) ? 128 : G;
    if (bid < npw) { for (int u = bid; u < NB * 64; u += npw) s5_prompt_unit(F, u >> 6, u & 63, XB, ss); }
    const int ws0 = (G >= 256) ? 128 : 0, nsw = (G - ws0) * NWAVES;
    if (bid >= ws0) { for (int u = (bid - ws0) * NWAVES + F.wave; u < 64 * 4; u += nsw) s5_sample_unit(F, u >> 2, u & 3, XB, ss); }
}
#ifndef MK_ONE_LAUNCH
#define MK_ONE_LAUNCH 0
#endif
constexpr int N_PHASES = 17;
#define GP(EPI) pg8::gemm_phase<EPI, pg8::StaticOrder, true, true>
#define REFRESH() do { F.lane = mk_lane(); F.tid = F.wave * 64 + F.lane; } while (0)

__global__ void __launch_bounds__(NWAVES * 64, 2) nsa_s5_fwd(Args args) {
    extern __shared__ __attribute__((aligned(16))) unsigned char lds[];
    Frame F;
    F.lds = (LAS unsigned char*)lds;
    F.wave = __builtin_amdgcn_readfirstlane((int)(threadIdx.x >> 6)); F.lane = mk_lane(); F.tid = F.wave * 64 + F.lane;
    F.gw = blockIdx.x * NWAVES + F.wave; F.NGW = gridDim.x * NWAVES;
    F.ws = args.ws; F.out = args.out; F.in = args.in; F.pt = args.page_table;
    volatile LAS unsigned* MISC = (volatile LAS unsigned*)(F.lds + MISC_OFF);
    if (F.tid < 64) MISC[F.tid] = 0u;
    __syncthreads();
#if MK_ONE_LAUNCH
    XcdBarrier bar = xcd_barrier_post((unsigned*)(F.ws + WS_CTL) + CW_BAR, MISC + 8, (unsigned)F.wave);
#define GRID_BAR() xcd_barrier(bar)
#else
#define GRID_BAR() do {} while (0)
#endif
    const int lo = args.ph_lo, hi = args.ph_hi;
#ifndef PHMASK
#define PHMASK 0x1ffff
#endif
#define IN(k) ((((PHMASK) >> (k)) & 1) && lo <= (k) && (k) < hi)
#define SEAM(k) do { if (IN(k) && IN((k) + 1)) GRID_BAR(); } while (0)
    unsigned char* ws = F.ws;
    LAS unsigned char* ring = F.lds;
    const int G = gridDim.x, cid = blockIdx.x;

    const bool split1 = (G == 256); const int j1 = cid >> 3; const bool streamer = split1 && (j1 & 1) == 0;
    const int G1 = split1 ? 128 : G, c1 = split1 ? ((j1 >> 1) * 8 + (cid & 7)) : cid;
    if (IN(0)) { REFRESH(); p0_prologue(F); if (!split1) p0_stream(F, F.gw, F.NGW, 0, DB * PAST, true); SEAM(0); }

    if (IN(1)) {
        if (streamer) { REFRESH(); p0_stream(F, c1 * NWAVES + F.wave, 128 * NWAVES, 0, DB * PAST / 16 * 15, true); }
        else {
        { pg8::Gemm g{(const bf16*)(ws + WS_XBA), (const bf16*)(ws + WS_WIN_T), M, NINP, DM}; pg8::StaticOrder S; S.init(M, NINP, G1, c1);
          EpiAttnIn E{ws, F.out};
          GP(EpiAttnIn)(ring, g, S, E, F.wave); }
        { int kp = PLE; asm volatile("" : "+s"(kp));
          { pg8::Gemm g{(const bf16*)(ws + WS_PB0), (const bf16*)(ws + WS_WP_T0), MP, DM, kp}; pg8::StaticOrder S; S.init(MP, DM, G1, c1);
            EpiPlain E{(bf16*)(ws + WS_PP0), DM}; GP(EpiPlain)(ring, g, S, E, F.wave); }
          REFRESH(); sample_plain_sub(F, (const bf16*)(ws + WS_PB0), PLE, (const bf16*)(ws + WS_WP_T0), kp, (bf16*)(ws + WS_PP0), c1, G1); }
          if (split1) { REFRESH(); p0_stream(F, c1 * NWAVES + F.wave, 128 * NWAVES, DB * PAST / 16 * 15, DB * PAST, false); }
        }
        SEAM(1);
    }
    if (IN(2)) {
        REFRESH(); sample_cmp_pages(F);
        REFRESH(); prompt_cmp(F);
        SEAM(2);
    }
    if (IN(3)) { REFRESH(); cmp_finalize(F); s5_tables(F); SEAM(3); }
    if (IN(4)) { REFRESH(); attn_phase_v2(F); SEAM(4); }
    if (IN(5)) {
        pg8::Gemm g{(const bf16*)(ws + WS_OB), (const bf16*)(ws + WS_WOUT_T), MP, DM, DM}; pg8::StaticOrder S; S.init(MP, DM, G, cid);
        EpiResid E{(const bf16*)(ws + WS_XBA), (bf16*)(ws + WS_XBB), F.SS(1)};
        GP(EpiResid)(ring, g, S, E, F.wave);
        REFRESH(); sample_resid(F, (const bf16*)(ws + WS_OB), DM, (const bf16*)(ws + WS_WOUT_T), DM, (const bf16*)(ws + WS_XBA), (bf16*)(ws + WS_XBB), F.SS(1));
        SEAM(5);
    }
#define LAYER_BODY(layer) do { \
        const int pb = layer ? 12 : 6; \
        bf16* xb_up = (bf16*)(ws + (layer ? WS_XBA : WS_XBB)); \
        bf16* xb_dn = (bf16*)(ws + (layer ? WS_XBB : WS_XBA)); \
        if (layer == 1) { \
            if (IN(10)) { REFRESH(); s5_phase_v2(F); \
                if (G >= 256 && cid >= 128) {     \
                    int kp = PLE; asm volatile("" : "+s"(kp)); \
                    pg8::Gemm g{(const bf16*)(ws + WS_PB1), (const bf16*)(ws + WS_WP_T1), MP, DM, kp}; pg8::StaticOrder S; S.init(MP, DM, 128, cid - 128); \
                    EpiPlain E{(bf16*)(ws + WS_PP1), DM}; GP(EpiPlain)(ring, g, S, E, F.wave); \
                    REFRESH(); sample_plain_sub(F, (const bf16*)(ws + WS_PB1), PLE, (const bf16*)(ws + WS_WP_T1), kp, (bf16*)(ws + WS_PP1), cid - 128, 128); \
                } else if (G < 256) { \
                    int kp = PLE; asm volatile("" : "+s"(kp)); \
                    pg8::Gemm g{(const bf16*)(ws + WS_PB1), (const bf16*)(ws + WS_WP_T1), MP, DM, kp}; pg8::StaticOrder S; S.init(MP, DM, G, cid); \
                    EpiPlain E{(bf16*)(ws + WS_PP1), DM}; GP(EpiPlain)(ring, g, S, E, F.wave); \
                    REFRESH(); sample_plain_sub(F, (const bf16*)(ws + WS_PB1), PLE, (const bf16*)(ws + WS_WP_T1), kp, (bf16*)(ws + WS_PP1), cid, G); \
                } \
                SEAM(10); } \
            if (IN(11)) { \
                pg8::Gemm g{(const bf16*)(ws + WS_Z), (const bf16*)(ws + WS_WGLU_T), MP, 2 * DM, DM}; pg8::StaticOrder S; S.init(MP, 2 * DM, G, cid); \
                EpiGlu E{xb_dn, xb_up, F.SS(4)}; \
                GP(EpiGlu)(ring, g, S, E, F.wave); \
                REFRESH(); sample_glu(F, (const bf16*)(ws + WS_Z), (const bf16*)(ws + WS_WGLU_T), xb_dn, xb_up, F.SS(4)); \
                SEAM(11); \
            } \
        } \
        if (IN(pb)) { \
            pg8::Gemm g{xb_up, (const bf16*)(ws + (layer ? WS_WUP_T1 : WS_WUP_T0)), M, 2 * FF, DM}; pg8::StaticOrder S; S.init(M, 2 * FF, G, cid); \
            EpiUpFused E{ws, F.out, F.in[I_CONVW] + (size_t)layer * 3 * FF, F.in[I_CONVB] + (size_t)layer * FF, F.in[I_SCONV] + (size_t)layer * DB * 2 * FF, layer, F.lds}; \
            GP(EpiUpFused)(ring, g, S, E, F.wave); \
            SEAM(pb); \
        } \
        if (IN(pb + 2)) { \
            pg8::Gemm g{(const bf16*)(ws + WS_ACT), (const bf16*)(ws + (layer ? WS_WDN_T1 : WS_WDN_T0)), MP, DM, FF}; pg8::StaticOrder S; S.init(MP, DM, G, cid); \
            { REFRESH(); pg8::Unit uu; for (int i = 0; S.next(i, uu); ++i) { if (uu.pm < MP / 256 && (uu.pm & 31) != 0) up_fix(ws, F.in[I_CONVW] + (size_t)layer * 3 * FF, F.in[I_CONVB] + (size_t)layer * FF, uu.pm, F.tid); } \
              VM_WAIT(); __syncthreads(); } \
            EpiResid E{xb_up, xb_dn, F.SS(layer ? 5 : 2)}; \
            GP(EpiResid)(ring, g, S, E, F.wave); \
            REFRESH(); sample_resid(F, (const bf16*)(ws + WS_ACT), FF, (const bf16*)(ws + (layer ? WS_WDN_T1 : WS_WDN_T0)), FF, xb_up, xb_dn, F.SS(layer ? 5 : 2)); \
            SEAM(pb + 2); \
        } \
        if (IN(pb + 3)) { \
            pg8::Gemm g{xb_dn, (const bf16*)(ws + (layer ? WS_WG_T1 : WS_WG_T0)), MP, DM, DM}; pg8::StaticOrder S; S.init(MP, DM, G, cid); \
            EpiGate E{F.SS(layer ? 5 : 2), (const bf16*)(ws + (layer ? WS_PP1 : WS_PP0)), xb_dn, xb_up, F.SS(layer ? 6 : 3), layer ? (bf16*)nullptr : (bf16*)(ws + WS_XG)}; \
            GP(EpiGate)(ring, g, S, E, F.wave); \
            REFRESH(); sample_gate(F, xb_dn, (const bf16*)(ws + (layer ? WS_WG_T1 : WS_WG_T0)), F.SS(layer ? 5 : 2), (const bf16*)(ws + (layer ? WS_PP1 : WS_PP0)), xb_dn, xb_up, layer ? (bf16*)nullptr : (bf16*)(ws + WS_XG), F.SS(layer ? 6 : 3)); \
            SEAM(pb + 3); \
        } \
    } while (0)
    LAYER_BODY(0);
    LAYER_BODY(1);
#undef LAYER_BODY
    if (IN(16)) { REFRESH(); final_norm(F); }
#undef IN
#undef SEAM
}

extern "C" void kernel_launch(void* const* d_in, const int* in_sizes, int n_in, void* d_out, int out_size, void* d_ws, size_t ws_size, hipStream_t stream) {
    static int grid = 0;
    if (grid == 0) {
        if (n_in != 34 || out_size != (int)O_END || ws_size < WS_END) { fprintf(stderr, "kernel_launch: unexpected sizes n_in %d out %d ws %zu\n", n_in, out_size, ws_size); grid = -1; return; }
        int dev = 0, cus = 0, per_cu = 0;
        if (hipGetDevice(&dev) != hipSuccess || hipDeviceGetAttribute(&cus, hipDeviceAttributeMultiprocessorCount, dev) != hipSuccess) { grid = -1; return; }
        if (hipFuncSetAttribute((const void*)nsa_s5_fwd, hipFuncAttributeMaxDynamicSharedMemorySize, LDS_BYTES) != hipSuccess) { fprintf(stderr, "kernel_launch: hipFuncSetAttribute failed\n"); grid = -1; return; }
        if (hipOccupancyMaxActiveBlocksPerMultiprocessor(&per_cu, (const void*)nsa_s5_fwd, NWAVES * 64, LDS_BYTES) != hipSuccess || per_cu < 1)
            fprintf(stderr, "kernel_launch: occupancy query reports %d blocks per CU\n", per_cu);
        (void)hipGetLastError();
        grid = cus;
    }
    if (grid < 0) return;
    (void)hipMemsetAsync((char*)d_ws + WS_CTL, 0, CTL_ZERO_BYTES, stream);
    Args a{};
    for (int i = 0; i < 34; ++i) a.in[i] = (const float*)d_in[i];
    a.page_table = (const int*)d_in[I_PT]; a.out = (float*)d_out; a.ws = (unsigned char*)d_ws;
#if MK_ONE_LAUNCH
    a.ph_lo = 0; a.ph_hi = N_PHASES;
    hipLaunchKernelGGL(nsa_s5_fwd, dim3(grid), dim3(NWAVES * 64), LDS_BYTES, stream, a);
#else
    for (int p = 0; p < N_PHASES; ++p) { a.ph_lo = p; a.ph_hi = p + 1; hipLaunchKernelGGL(nsa_s5_fwd, dim3(grid), dim3(NWAVES * 64), LDS_BYTES, stream, a); }
#endif
}
```

```cpp
#include <hip/hip_runtime.h>
#include <cstdio>
#include <cstdint>

#define GAS __attribute__((address_space(1)))
#define LAS __attribute__((address_space(3)))
typedef unsigned short bf16;
typedef unsigned v4u __attribute__((ext_vector_type(4)));
typedef unsigned v2u __attribute__((ext_vector_type(2)));
typedef float f32x4 __attribute__((ext_vector_type(4)));
typedef float f32x2 __attribute__((ext_vector_type(2)));
typedef short bf16x8 __attribute__((ext_vector_type(8)));
typedef float f32x16 __attribute__((ext_vector_type(16)));

constexpr int DM = 1024, SEQ = 8192, NB = 2, MP = NB * SEQ  , DB = 128, DS = 8, MS = DB * DS  , M = MP + MS  ;
constexpr int PAST = 2048, PAGE = 128, NPAGES = PAST / PAGE  ;
constexpr int NH = 16, HD = 64, NG = 4;
constexpr int NIN = 2608, NINP = 2816;
constexpr int FF = 2816, PLE = 256;
constexpr int NCP = 511, NCS = 127;
constexpr int NSP = 128, NSS = 33;
constexpr float EPS = 1e-6f;
constexpr int CMP_ROWS_P = 2 * NB * 512 * NG;
constexpr int CMP_ROWS_S = 2 * DB * 128 * NG;
constexpr int CMP_ROWS = CMP_ROWS_P + CMP_ROWS_S;

constexpr size_t MiB = 1u << 20;
constexpr size_t WS_CTL = 0, CTL_ZERO_BYTES = 2 * MiB;
constexpr size_t WS_WIN_T = 2 * MiB, WS_WOUT_T = 8 * MiB, WS_WUP_T0 = 10 * MiB, WS_WUP_T1 = 21 * MiB, WS_WDN_T0 = 32 * MiB, WS_WDN_T1 = 38 * MiB;
constexpr size_t WS_WP_T0 = 44 * MiB, WS_WP_T1 = 45 * MiB, WS_WG_T0 = 47 * MiB, WS_WG_T1 = 49 * MiB, WS_WGLU_T = 51 * MiB, WS_W1R_T = 55 * MiB, WS_CVEC = 55 * MiB + 768 * 1024, WS_S5TAB = 56 * MiB;
constexpr size_t WS_XBA = 64 * MiB, WS_XBB = 98 * MiB, WS_XR = 132 * MiB, WS_QB = 200 * MiB, WS_OB = 234 * MiB, WS_KVB = 268 * MiB, WS_WINB = 302 * MiB, WS_GATES = 319 * MiB;
constexpr size_t WS_KCP = 323 * MiB, WS_VCP = 323 * MiB + 512 * 1024, WS_KCS = 324 * MiB, WS_VCS = 332 * MiB, WS_CMPA = 340 * MiB, WS_PBUF = 612 * MiB;
constexpr size_t WS_HG = 680 * MiB, WS_ACT = 867 * MiB, WS_PB0 = 961 * MiB, WS_PB1 = 970 * MiB, WS_PP0 = 979 * MiB, WS_PP1 = 1013 * MiB, WS_Z = 1047 * MiB, WS_SELS = 1081 * MiB, WS_WINS = 1340 * MiB, WS_S5K = 1407 * MiB, WS_S5W = 1408 * MiB, WS_S5V = 1416 * MiB, WS_S5A = 1424 * MiB, WS_HALOA = 1425 * MiB, WS_HALOB = 1429 * MiB, WS_S5E = 1431 * MiB, WS_S5H = 1448 * MiB, WS_STASH = 1457 * MiB, WS_XG = 1474 * MiB, WS_END = 1509 * MiB;
constexpr int CW_TMO = 0, CW_BAR = 4096, CW_SS = 65536;
static_assert((CW_SS + 7 * M) * 4 <= (int)CTL_ZERO_BYTES, "ctl words inside the memset region");

constexpr int NWAVES = 8;
constexpr int RING_BYTES = 131072;
constexpr int WAVE_LDS = 18432;
constexpr int MISC_OFF = NWAVES * WAVE_LDS;
constexpr int LDS_BYTES = MISC_OFF + 256;

#define RLX_AGENT __ATOMIC_RELAXED, __HIP_MEMORY_SCOPE_AGENT
#define LDS_WAIT() asm volatile("s_waitcnt lgkmcnt(0)" ::: "memory")
#define VM_WAIT() asm volatile("s_waitcnt vmcnt(0)" ::: "memory")

__device__ __forceinline__ float bf2f(bf16 v) { return __uint_as_float(((unsigned)v) << 16); }
__device__ __forceinline__ unsigned f2bf(float f) { unsigned u = __builtin_bit_cast(unsigned, f); return (u + 0x7fffu + ((u >> 16) & 1u)) >> 16; }
__device__ __forceinline__ unsigned cvt_pk(float lo, float hi) { unsigned r; asm("v_cvt_pk_bf16_f32 %0, %1, %2" : "=v"(r) : "v"(lo), "v"(hi)); return r; }
__device__ __forceinline__ unsigned pk2(float lo, float hi) { return cvt_pk(lo, hi); }
__device__ __forceinline__ v4u pk8(f32x4 a, f32x4 b) { v4u w; w.x = pk2(a[0], a[1]); w.y = pk2(a[2], a[3]); w.z = pk2(b[0], b[1]); w.w = pk2(b[2], b[3]); return w; }
__device__ __forceinline__ float wave_sum(float v) {
#pragma unroll
    for (int o = 1; o < 64; o <<= 1) v += __shfl_xor(v, o);
    return v;
}
__device__ __forceinline__ float wave_max(float v) {
#pragma unroll
    for (int o = 1; o < 64; o <<= 1) v = fmaxf(v, __shfl_xor(v, o));
    return v;
}
__device__ __forceinline__ float sigmoidf_(float x) { return __builtin_amdgcn_rcpf(1.f + __builtin_amdgcn_exp2f(-1.4426950408889634f * x)); }
__device__ __forceinline__ float gelu_tanh(float x) { constexpr float K1 = -2.f * 0.7978845608028654f * 1.4426950408889634f, K2 = K1 * 0.044715f;
    const float t = x * __builtin_fmaf(x * x, K2, K1); return x * __builtin_amdgcn_rcpf(1.f + __builtin_amdgcn_exp2f(t)); }
__device__ __forceinline__ float gelu_tanh_div(float x) { const float y = 0.7978845608028654f * (x + 0.044715f * x * x * x); return x / (1.f + __expf(-2.f * y)); }
__device__ __forceinline__ f32x4 ld4(const float* p) { return *(const f32x4*)p; }
__device__ __forceinline__ void st4(float* p, f32x4 v) { *(f32x4*)p = v; }
constexpr size_t O_YP = 0, O_YS = O_YP + (size_t)MP * DM, O_KVP = O_YS + (size_t)MS * DM, O_KVS = O_KVP + (size_t)MP * 1024, O_WINP = O_KVS + (size_t)MS * 1024,
                 O_WINS = O_WINP + (size_t)NB * 512 * 512, O_SREP = O_WINS + (size_t)DB * 512 * 512, O_SIMP = O_SREP + NB * 64 * 64, O_SRES = O_SIMP + NB * 64 * 64,
                 O_SIMS = O_SRES + (size_t)DB * 64 * 64, O_CONVP = O_SIMS + (size_t)DB * 64 * 64, O_CONVS = O_CONVP + 2 * NB * 2 * FF, O_END = O_CONVS + (size_t)2 * DB * 2 * FF;
static_assert(O_END == 72259584, "output size");
__device__ __forceinline__ int mk_lane() { int l; asm volatile("v_mbcnt_lo_u32_b32 %0, -1, 0\n\tv_mbcnt_hi_u32_b32 %0, -1, %0" : "=v"(l)); return l & 63; }
__device__ __forceinline__ void unpk8(v4u w, f32x4& a, f32x4& b) { a[0] = __uint_as_float(w.x << 16); a[1] = __uint_as_float(w.x & 0xffff0000u); a[2] = __uint_as_float(w.y << 16); a[3] = __uint_as_float(w.y & 0xffff0000u);
    b[0] = __uint_as_float(w.z << 16); b[1] = __uint_as_float(w.z & 0xffff0000u); b[2] = __uint_as_float(w.w << 16); b[3] = __uint_as_float(w.w & 0xffff0000u); }
__device__ __forceinline__ v4u pk8c(f32x4 a, f32x4 b) { v4u w; w.x = cvt_pk(a[0], a[1]); w.y = cvt_pk(a[2], a[3]); w.z = cvt_pk(b[0], b[1]); w.w = cvt_pk(b[2], b[3]); return w; }
#define MK_ONE_LAUNCH 1
namespace pg8 {
#define PG8_LAS __attribute__((address_space(3)))
typedef unsigned short bf16_t;
typedef short bf16x8 __attribute__((ext_vector_type(8)));
typedef float f32x4 __attribute__((ext_vector_type(4)));
typedef unsigned u32x4 __attribute__((ext_vector_type(4)));
constexpr int BM = 256, BK = 64, HALF = 128, HTB = HALF * BK * 2  , STAGE_BYTES = 8 * HTB, NXCD = 8, WGM = 8;

__host__ __device__ __forceinline__ int lds_byte(int r, int c) { const int st = (r >> 4) * 2 + (c >> 5), rr = r & 15, cc = c & 31, ob = rr * 64 + cc * 2; return st * 1024 + (ob ^ (((ob >> 9) & 1) << 5)); }
__host__ __device__ __forceinline__ void stage_rc(int b, int& R, int& C) { const int st = b / 1024, sb = b % 1024, swz = sb ^ (((sb >> 9) & 1) << 5); R = (st >> 1) * 16 + swz / 64; C = (st & 1) * 32 + (swz % 64) / 2; }
__host__ __device__ __forceinline__ int perm32(int rho) { const int n = rho >> 4, i = rho & 15; return 8 * (i >> 2) + 4 * n + (i & 3); }

struct Unit { int pm, pn; };
struct Gemm { const bf16_t* A; const bf16_t* Bt; int M, N, K; };

struct StaticOrder {
    int nM, nN, nwg, G, c;
    __host__ __device__ void init(int M, int N, int G_, int c_) { nM = M / BM; nN = N / BM; nwg = nM * nN; G = G_; c = c_; }
    __host__ __device__ __forceinline__ bool next(int i, Unit& u) const {
        const long L = (long)i * G + c; if (L >= nwg) return false;
        int wgid = (int)L; { const int q = nwg / NXCD, r = nwg % NXCD, xcd = wgid % NXCD, off = wgid / NXCD; wgid = (xcd < r ? xcd * (q + 1) : r * (q + 1) + (xcd - r) * q) + off; }
        const int nig = WGM * nN, gid = wgid / nig, fm = gid * WGM, gsz = (nM - fm) < WGM ? (nM - fm) : WGM;
        u.pm = fm + ((wgid % nig) % gsz); u.pn = (wgid % nig) / gsz; return true;
    }
    __device__ __forceinline__ void a_ready(const Unit&) const {}
    __device__ __forceinline__ void done(const Unit&) const {}
};

__device__ __forceinline__ unsigned cvt_pk_bf16(float lo, float hi) { unsigned r; asm volatile("v_cvt_pk_bf16_f32 %0, %1, %2" : "=v"(r) : "v"(lo), "v"(hi)); return r; }
template <class Epi, class Sched, bool ALIGN_EPI = false, bool SP2 = false>
__device__ __forceinline__ void gemm_phase(PG8_LAS unsigned char* lds, const Gemm g, const Sched& S, const Epi& E, const int wid) {
    const int lane = mk_lane(), tid = wid * 64 + lane, wr = wid >> 2, wc = wid & 3, fr = lane & 15, fq = lane >> 4;
    const int K = g.K, nt = K / BK;
    unsigned voffA[2], voffB[2];
#pragma unroll
    for (int i = 0; i < 2; ++i) { int R, C; stage_rc(tid * 16 + i * 8192, R, C); const int Rb = Epi::PERM ? ((R & ~31) + perm32(R & 31)) : R;
        voffA[i] = (unsigned)(R * K + C) * 2u; voffB[i] = (unsigned)(Rb * K + C) * 2u; }
    const size_t kstep = (size_t)(BK * 2);
    const size_t hstep = (size_t)HALF * K * 2;
    const size_t tstep = 2 * hstep;
    const unsigned ldsw = (unsigned)wid * 1024u;
    const int aoff = lds_byte(wr * 64 + fr, fq * 8), boff = lds_byte(wc * 32 + fr, fq * 8);
#define PG8_SA(b, h) (((b) * 2 + (h)) * HTB)
#define PG8_SB(b, h) ((4 + (b) * 2 + (h)) * HTB)
#define PG8_STAGE(bufoff, gbase, voff) do { _Pragma("unroll") for (int _i = 0; _i < 2; ++_i) \
        __builtin_amdgcn_global_load_lds((const unsigned*)((const char*)(gbase) + (voff)[_i]), (PG8_LAS unsigned*)(lds + (bufoff) + ldsw + _i * 8192), 16, 0, 0); } while (0)
#define PG8_LDA(dst, b, h) do { _Pragma("unroll") for (int m = 0; m < 4; ++m) _Pragma("unroll") for (int k = 0; k < 2; ++k) dst[m][k] = *(const PG8_LAS bf16x8*)(lds + PG8_SA(b, h) + aoff + m * 2048 + k * 1024); } while (0)
#define PG8_LDB(dst, b, h) do { _Pragma("unroll") for (int n = 0; n < 2; ++n) _Pragma("unroll") for (int k = 0; k < 2; ++k) dst[n][k] = *(const PG8_LAS bf16x8*)(lds + PG8_SB(b, h) + boff + n * 2048 + k * 1024); } while (0)
#define PG8_MMA(ai, bj, At, Bt) do { __builtin_amdgcn_s_setprio(1); _Pragma("unroll") for (int m = 0; m < 4; ++m) _Pragma("unroll") for (int n = 0; n < 2; ++n) _Pragma("unroll") for (int k = 0; k < 2; ++k) \
        acc[ai][bj][m][n] = __builtin_amdgcn_mfma_f32_16x16x32_bf16(Bt[n][k], At[m][k], acc[ai][bj][m][n], 0, 0, 0); __builtin_amdgcn_s_setprio(0); } while (0)
#define PG8_WAIT_V(n) asm volatile("s_waitcnt vmcnt(" #n ")" ::: "memory")
#define PG8_WAIT_L(n) asm volatile("s_waitcnt lgkmcnt(" #n ")" ::: "memory")
#define PG8_BAR __builtin_amdgcn_s_barrier()
#define PG8_SCHED __builtin_amdgcn_sched_barrier(0)
    Unit cur, nxt; int ui = 0;
    if (!S.next(0, cur)) return;
    f32x4 acc[2][2][4][2];
#pragma unroll
    for (int a = 0; a < 2; ++a)
#pragma unroll
        for (int b = 0; b < 2; ++b)
#pragma unroll
            for (int m = 0; m < 4; ++m)
#pragma unroll
                for (int n = 0; n < 2; ++n) acc[a][b][m][n] = (f32x4){0.f, 0.f, 0.f, 0.f};
    bf16x8 At[4][2], B0[2][2], B1[2][2];
    const char* cA = (const char*)g.A + (size_t)cur.pm * tstep; const char* cB = (const char*)g.Bt + (size_t)cur.pn * tstep;
    S.a_ready(cur);
    if constexpr (SP2) {
        PG8_STAGE(PG8_SB(0, 0), cB, voffB); PG8_STAGE(PG8_SB(0, 1), cB + hstep, voffB); PG8_STAGE(PG8_SA(0, 0), cA, voffA); PG8_STAGE(PG8_SA(0, 1), cA + hstep, voffA);
        if (wr == 1) PG8_BAR;
        PG8_WAIT_V(2); PG8_BAR;
        PG8_STAGE(PG8_SB(1, 0), cB + kstep, voffB); PG8_STAGE(PG8_SA(1, 0), cA + kstep, voffA); PG8_STAGE(PG8_SB(1, 1), cB + hstep + kstep, voffB);
        PG8_WAIT_V(6); PG8_BAR;
    } else {
        PG8_STAGE(PG8_SB(0, 0), cB, voffB); PG8_STAGE(PG8_SA(0, 0), cA, voffA); PG8_STAGE(PG8_SB(0, 1), cB + hstep, voffB); PG8_STAGE(PG8_SA(0, 1), cA + hstep, voffA);
        if (wr == 1) PG8_BAR;
        PG8_WAIT_V(4); PG8_BAR;
        PG8_STAGE(PG8_SB(1, 0), cB + kstep, voffB); PG8_STAGE(PG8_SA(1, 0), cA + kstep, voffA); PG8_STAGE(PG8_SB(1, 1), cB + hstep + kstep, voffB);
        PG8_WAIT_V(6); PG8_BAR;
    }
    for (;;) {
        const bool has_next = S.next(ui + 1, nxt);
        const char* nA = has_next ? (const char*)g.A + (size_t)nxt.pm * tstep : cA; const char* nB = has_next ? (const char*)g.Bt + (size_t)nxt.pn * tstep : cB;
        for (int t = 0; t < nt; t += 2) {
            const bool last = (t == nt - 2);
            const char* a1 = cA + (size_t)(t + 1) * kstep;
            const char* a2 = last ? nA : cA + (size_t)(t + 2) * kstep; const char* b2 = last ? nB : cB + (size_t)(t + 2) * kstep;
            const char* a3 = a2 + kstep; const char* b3 = b2 + kstep;
            if (last && has_next) S.a_ready(nxt);
            if constexpr (SP2) {
            PG8_LDB(B0, 0, 0); PG8_LDB(B1, 0, 1); PG8_SCHED; PG8_LDA(At, 0, 0); PG8_STAGE(PG8_SA(1, 1), a1 + hstep, voffA);
            PG8_WAIT_V(8); PG8_WAIT_L(0); PG8_BAR; PG8_MMA(0, 0, At, B0); PG8_MMA(0, 1, At, B1); PG8_BAR; PG8_SCHED;
            PG8_LDA(At, 0, 1); PG8_STAGE(PG8_SB(0, 0), b2, voffB); PG8_STAGE(PG8_SB(0, 1), b2 + hstep, voffB); PG8_STAGE(PG8_SA(0, 0), a2, voffA);
            PG8_WAIT_V(8); PG8_WAIT_L(0); PG8_BAR; PG8_MMA(1, 0, At, B0); PG8_MMA(1, 1, At, B1); PG8_BAR; PG8_SCHED;
            PG8_LDB(B0, 1, 0); PG8_LDB(B1, 1, 1); PG8_SCHED; PG8_LDA(At, 1, 0); PG8_STAGE(PG8_SA(0, 1), a2 + hstep, voffA);
            PG8_WAIT_V(8); PG8_WAIT_L(0); PG8_BAR; PG8_MMA(0, 0, At, B0); PG8_MMA(0, 1, At, B1); PG8_BAR; PG8_SCHED;
            PG8_LDA(At, 1, 1); PG8_STAGE(PG8_SB(1, 0), b3, voffB); PG8_STAGE(PG8_SB(1, 1), b3 + hstep, voffB); PG8_STAGE(PG8_SA(1, 0), a3, voffA);
            PG8_WAIT_V(8); PG8_WAIT_L(0); PG8_BAR; PG8_MMA(1, 0, At, B0); PG8_MMA(1, 1, At, B1); PG8_BAR; PG8_SCHED;
            } else {
            PG8_LDB(B0, 0, 0); PG8_SCHED; PG8_LDA(At, 0, 0); PG8_STAGE(PG8_SA(1, 1), a1 + hstep, voffA);
            PG8_WAIT_L(8); PG8_BAR; PG8_WAIT_L(0); PG8_MMA(0, 0, At, B0); PG8_BAR; PG8_SCHED;
            PG8_LDB(B1, 0, 1); PG8_STAGE(PG8_SB(0, 0), b2, voffB);
            PG8_BAR; PG8_WAIT_L(0); PG8_MMA(0, 1, At, B1); PG8_BAR;
            PG8_LDA(At, 0, 1); PG8_STAGE(PG8_SA(0, 0), a2, voffA);
            PG8_BAR; PG8_WAIT_L(0); PG8_MMA(1, 0, At, B0); PG8_BAR; PG8_SCHED;
            PG8_STAGE(PG8_SB(0, 1), b2 + hstep, voffB);
            PG8_WAIT_V(6); PG8_BAR; PG8_MMA(1, 1, At, B1); PG8_BAR;
            PG8_LDB(B0, 1, 0); PG8_SCHED; PG8_LDA(At, 1, 0); PG8_STAGE(PG8_SA(0, 1), a2 + hstep, voffA);
            PG8_WAIT_L(8); PG8_BAR; PG8_WAIT_L(0); PG8_MMA(0, 0, At, B0); PG8_BAR; PG8_SCHED;
            PG8_LDB(B1, 1, 1); PG8_STAGE(PG8_SB(1, 0), b3, voffB);
            PG8_BAR; PG8_WAIT_L(0); PG8_MMA(0, 1, At, B1); PG8_BAR;
            PG8_LDA(At, 1, 1); PG8_STAGE(PG8_SA(1, 0), a3, voffA);
            PG8_BAR; PG8_WAIT_L(0); PG8_MMA(1, 0, At, B0); PG8_BAR; PG8_SCHED;
            PG8_STAGE(PG8_SB(1, 1), b3 + hstep, voffB);
            PG8_WAIT_V(6); PG8_BAR; PG8_MMA(1, 1, At, B1); PG8_BAR;
            }
        }
        if constexpr (ALIGN_EPI) { if (wr == 0) PG8_BAR; }
        if constexpr (!Epi::AFTER_DRAIN) { E(acc, cur, wr, wc, fr, fq); S.done(cur); }
        if (!has_next) break;
#pragma unroll
        for (int a = 0; a < 2; ++a)
#pragma unroll
            for (int b = 0; b < 2; ++b)
#pragma unroll
                for (int m = 0; m < 4; ++m)
#pragma unroll
                    for (int n = 0; n < 2; ++n) acc[a][b][m][n] = (f32x4){0.f, 0.f, 0.f, 0.f};
        cur = nxt; cA = nA; cB = nB; ++ui;
        if constexpr (ALIGN_EPI) { if (wr == 1) PG8_BAR; }
    }
    PG8_WAIT_V(0);
    if constexpr (!ALIGN_EPI) { if (wr == 0) PG8_BAR; }
    PG8_BAR;
    if constexpr (Epi::AFTER_DRAIN) { E.fused(acc, cur, wr, wc, fr, fq, lds, wid, lane); S.done(cur); }
#undef PG8_SA
#undef PG8_SB
#undef PG8_STAGE
#undef PG8_LDA
#undef PG8_LDB
#undef PG8_MMA
#undef PG8_WAIT_V
#undef PG8_WAIT_L
#undef PG8_BAR
#undef PG8_SCHED
}
}

#define XB_TMO      128
#define XB_XCNT(j)  (256  + 64 * (j))
#define XB_XSUB(j)  (1280 + 64 * (j))
#define XB_XGEN(j)  (2304 + 64 * (j))
#define XB_TOP      3328
#define XB_TOPGEN   3392
#define XCD_BAR_WORDS 3456
#define XB_SPIN_CAP (1u << 18)

__device__ __forceinline__ unsigned xb_ld(unsigned* p)              { return __hip_atomic_load(p, __ATOMIC_RELAXED, __HIP_MEMORY_SCOPE_AGENT); }
__device__ __forceinline__ unsigned xb_add(unsigned* p, unsigned v) { return __hip_atomic_fetch_add(p, v, __ATOMIC_RELAXED, __HIP_MEMORY_SCOPE_AGENT); }
__device__ __forceinline__ unsigned xb_xcc_id() { return (unsigned)__builtin_amdgcn_s_getreg((3 << 11) | 20) & 0xFu; }
#define XB_SPIN(cond, bar) do { unsigned _sp = 0; while (cond) { __builtin_amdgcn_s_sleep(1); \
    if ((++_sp & 255u) == 0u) { if (xb_ld(&(bar)[XB_TMO])) break; if (_sp > XB_SPIN_CAP) { atomicAdd(&(bar)[XB_TMO], 1u); break; } } } } while (0)

struct XcdBarrier {
    unsigned* bar; unsigned x; unsigned wid;
    volatile LAS unsigned* st;
};

__device__ __forceinline__ XcdBarrier xcd_barrier_post(unsigned* bar, volatile LAS unsigned* st, unsigned wid) {
    XcdBarrier b; b.bar = bar; b.x = xb_xcc_id(); b.st = st; b.wid = wid;
    if (wid == 0u && mk_lane() == 0) (void)xb_add(&bar[XB_XCNT(b.x)], 1u);
    return b;
}
__device__ __forceinline__ void xcd_barrier_complete(unsigned* bar, unsigned x, unsigned& nloc, unsigned& nx) {
    const unsigned G = gridDim.x * gridDim.y * gridDim.z;
    unsigned sum, cnt, mine, sp = 0u;
    for (;;) {
        sum = 0u; cnt = 0u; mine = 0u;
#pragma unroll
        for (unsigned j = 0; j < 16; ++j) { const unsigned c = xb_ld(&bar[XB_XCNT(j)]); sum += c; cnt += (c > 0u) ? 1u : 0u; mine = (j == x) ? c : mine; }
        if (sum == G) break;
        __builtin_amdgcn_s_sleep(1);
        if ((++sp & 255u) == 0u) { if (xb_ld(&bar[XB_TMO])) break; if (sp > XB_SPIN_CAP) { atomicAdd(&bar[XB_TMO], 1u); break; } }
    }
    nloc = mine > 0u ? mine : 1u; nx = cnt > 0u ? cnt : 1u;
}

__device__ __forceinline__ void xcd_barrier(const XcdBarrier& b) {
    asm volatile("s_waitcnt vmcnt(0)" ::: "memory");
    __syncthreads();
    if (b.wid == 0u && mk_lane() == 0) {
        unsigned* bar = b.bar;
        __builtin_amdgcn_s_waitcnt(0);
        unsigned nloc = b.st[0], nx = b.st[1];
        if (nloc == 0u) { xcd_barrier_complete(bar, b.x, nloc, nx); b.st[0] = nloc; b.st[1] = nx; }
        const unsigned old = xb_add(&bar[XB_XSUB(b.x)], 1u);
        const unsigned gen = old / nloc;
        if (old + 1u == (gen + 1u) * nloc) {
            __builtin_amdgcn_fence(__ATOMIC_RELEASE, "agent");
            asm volatile("s_waitcnt vmcnt(0)" ::: "memory");
            const unsigned og = xb_add(&bar[XB_TOP], 1u);
            const unsigned tg = og / nx;
            if (og + 1u == (tg + 1u) * nx) xb_add(&bar[XB_TOPGEN], 1u);
            else XB_SPIN(xb_ld(&bar[XB_TOPGEN]) == tg, bar);
            __builtin_amdgcn_fence(__ATOMIC_ACQUIRE, "agent");
            xb_add(&bar[XB_XGEN(b.x)], 1u);
            asm volatile("s_waitcnt vmcnt(0)" ::: "memory");
        } else {
            XB_SPIN(xb_ld(&bar[XB_XGEN(b.x)]) == gen, bar);
            __builtin_amdgcn_fence(__ATOMIC_ACQUIRE, "agent");
            asm volatile("s_waitcnt vmcnt(0)" ::: "memory");
        }
    }
    __syncthreads();
}

constexpr float LOG2E = 1.4426950408889634f;
constexpr float QSCALE = 0.125f * LOG2E;
typedef const f32x4 (&AccRef)[2][2][4][2];
using pg8::Unit;

struct EpiAttnIn {
    static constexpr bool PERM = true, AFTER_DRAIN = false;
    unsigned char* ws; float* out;
    __device__ __forceinline__ void operator()(AccRef acc, const Unit& u, int wr, int wc, int fr, int fq) const {
        const int pn = u.pn;
        const float* ss = (const float*)(ws + WS_CTL) + CW_SS;
        const int rbase = u.pm * 256 + wr * 64 + fr, cw = wc * 32 + 8 * fq;
#define EAI_LOOP(...) _Pragma("unroll") for (int ai = 0; ai < 2; ++ai) _Pragma("unroll") for (int m = 0; m < 4; ++m) { const int r = rbase + ai * 128 + m * 16; const float rstd = rsqrtf(ss[r] * (1.f / DM) + EPS); \
            _Pragma("unroll") for (int bj = 0; bj < 2; ++bj) { const f32x4 v0 = acc[ai][bj][m][0] * rstd, v1 = acc[ai][bj][m][1] * rstd; __VA_ARGS__ } asm volatile("" ::: "memory"); }
        if (pn < 4) {
            bf16* Qb = (bf16*)(ws + WS_QB) + pn * 256 + cw;
            EAI_LOOP({ *(v4u*)(Qb + (size_t)r * DM + bj * 128) = pk8(v0 * QSCALE, v1 * QSCALE); })
        } else if (pn < 8) {
            const int cc0 = (pn - 4) * 256 + cw;
            bf16* KVb = (bf16*)(ws + WS_KVB) + cc0; bf16* cmpa = (bf16*)(ws + WS_CMPA);
            float* okv = (rbase < MP) ? out + O_KVP + cc0 : out + O_KVS - (size_t)MP * 1024 + cc0;
            EAI_LOOP({ float* o = okv + (size_t)r * 1024 + bj * 128; st4(o, v0); st4(o + 4, v1);
                const v4u w = pk8(v0, v1); *(v4u*)(KVb + (size_t)r * 1024 + bj * 128) = w;
                if (pn < 6 && r < MP) { const int cc = cc0 + bj * 128; const int c = pn - 4, g = (cc & 255) >> 6, d = cc & 63, b = r >> 13, t = r & 8191, mb = t >> 4, l = t & 15;
                    *(v4u*)(cmpa + ((((size_t)(c * NB + b) * 512 + mb) * NG + g) * 16 + l) * 64 + d) = w; }
                if (pn >= 6 && r >= MP) { const int rs = r - MP; *(v4u*)((bf16*)(ws + WS_SELS) + ((size_t)(rs >> 3) * (PAST + DS) + PAST + (rs & 7)) * 512 + (cc0 - 512) + bj * 128) = w; } })
        } else if (pn < 10) {
            const int cc0 = (pn - 8) * 256 + cw;
            bf16* WINb = (bf16*)(ws + WS_WINB) + cc0;
            EAI_LOOP({ const int cc = cc0 + bj * 128; const v4u w = pk8(v0, v1); *(v4u*)(WINb + (size_t)r * 512 + bj * 128) = w;
                if (r >= MP) { const int rs = r - MP; *(v4u*)((bf16*)(ws + WS_WINS) + ((size_t)(rs >> 3) * 520 + 512 + (rs & 7)) * 512 + cc) = w; }
                if (r < MP) { const int t = r & 8191; if (t >= SEQ - 512) { float* o = out + O_WINP + ((size_t)(r >> 13) * 512 + (t - (SEQ - 512))) * 512 + cc; st4(o, v0); st4(o + 4, v1); } }
                else { const int rs = r - MP, s = rs >> 3, t = rs & 7; float* o = out + O_WINS + ((size_t)s * 512 + 504 + t) * 512 + cc; st4(o, v0); st4(o + 4, v1); } })
        } else {
            float* gates = (float*)(ws + WS_GATES);
            EAI_LOOP({ const int cc = bj * 128 + cw; if (cc < 48) { float* o = gates + (size_t)r * 48 + cc;
                f32x4 a, b2; a[0] = sigmoidf_(v0[0]); a[1] = sigmoidf_(v0[1]); a[2] = sigmoidf_(v0[2]); a[3] = sigmoidf_(v0[3]);
                b2[0] = sigmoidf_(v1[0]); b2[1] = sigmoidf_(v1[1]); b2[2] = sigmoidf_(v1[2]); b2[3] = sigmoidf_(v1[3]); st4(o, a); st4(o + 4, b2); } })
        }
#undef EAI_LOOP
    }
};

struct EpiPlain {
    static constexpr bool PERM = true, AFTER_DRAIN = false;
    bf16* O; int ldc;
    __device__ __forceinline__ void operator()(AccRef acc, const Unit& u, int wr, int wc, int fr, int fq) const {
#pragma unroll
        for (int ai = 0; ai < 2; ++ai)
#pragma unroll
            for (int m = 0; m < 4; ++m) {
                const int r = u.pm * 256 + ai * 128 + wr * 64 + m * 16 + fr;
#pragma unroll
                for (int bj = 0; bj < 2; ++bj) { const int c0 = u.pn * 256 + bj * 128 + wc * 32 + 8 * fq; *(v4u*)(O + (size_t)r * ldc + c0) = pk8(acc[ai][bj][m][0], acc[ai][bj][m][1]); }
            }
    }
};

__device__ __forceinline__ void ss_accum(float* ssout, int r, float s, int fq) {
    s += __shfl_xor(s, 16); s += __shfl_xor(s, 32);
    if (fq == 0) atomicAdd(ssout + r, s);
}

struct EpiResid {
    static constexpr bool PERM = true, AFTER_DRAIN = false;
    const bf16* XI; bf16* XO; float* ssout;
    __device__ __forceinline__ void operator()(AccRef acc, const Unit& u, int wr, int wc, int fr, int fq) const {
#pragma unroll
        for (int ai = 0; ai < 2; ++ai)
#pragma unroll
            for (int m = 0; m < 4; ++m) {
                const int r = u.pm * 256 + ai * 128 + wr * 64 + m * 16 + fr;
                float s = 0.f;
#pragma unroll
                for (int bj = 0; bj < 2; ++bj) {
                    const int c0 = u.pn * 256 + bj * 128 + wc * 32 + 8 * fq;
                    f32x4 v0, v1; unpk8(*(const v4u*)(XI + (size_t)r * DM + c0), v0, v1); v0 += acc[ai][bj][m][0]; v1 += acc[ai][bj][m][1];
                    *(v4u*)(XO + (size_t)r * DM + c0) = pk8c(v0, v1);
                    s += (v0[0] * v0[0] + v0[1] * v0[1]) + (v0[2] * v0[2] + v0[3] * v0[3]) + (v1[0] * v1[0] + v1[1] * v1[1]) + (v1[2] * v1[2] + v1[3] * v1[3]);
                }
                ss_accum(ssout, r, s, fq);
            }
    }
};

template <int CTRL> __device__ __forceinline__ float dppf(float v) { return __uint_as_float((unsigned)__builtin_amdgcn_update_dpp(0, (int)__float_as_uint(v), CTRL, 0xf, 0xf, false)); }
template <int CTRL> __device__ __forceinline__ f32x4 dpp4(f32x4 v) { f32x4 r; r[0] = dppf<CTRL>(v[0]); r[1] = dppf<CTRL>(v[1]); r[2] = dppf<CTRL>(v[2]); r[3] = dppf<CTRL>(v[3]); return r; }
__device__ __forceinline__ f32x4 sel4(bool c, f32x4 a, f32x4 b) { f32x4 r; r[0] = c ? a[0] : b[0]; r[1] = c ? a[1] : b[1]; r[2] = c ? a[2] : b[2]; r[3] = c ? a[3] : b[3]; return r; }
__device__ __forceinline__ f32x4 gelu4(f32x4 v) { f32x4 r; r[0] = gelu_tanh(v[0]); r[1] = gelu_tanh(v[1]); r[2] = gelu_tanh(v[2]); r[3] = gelu_tanh(v[3]); return r; }
constexpr int XCH_OFF = RING_BYTES;
struct EpiUpFused {
    static constexpr bool PERM = true, AFTER_DRAIN = false;
    unsigned char* ws; float* out; const float* cw; const float* cb; const float* sconv; int layer; LAS unsigned char* lds;
    __device__ __forceinline__ void operator()(AccRef acc, const Unit& u, int wr, int wc, int fr, int fq) const {
        const float* ss = (const float*)(ws + WS_CTL) + CW_SS + (size_t)(layer ? 4 : 1) * M;
        bf16* ACT = (bf16*)(ws + WS_ACT); float* haloA = (float*)(ws + WS_HALOA); float* haloB = (float*)(ws + WS_HALOB);
        LAS float* xch = (LAS float*)(lds + XCH_OFF);
        const int j0 = u.pn * 128 + wc * 32 + 8 * fq;
        const f32x4 w0a = ld4(cw + j0), w0b = ld4(cw + j0 + 4), w1a = ld4(cw + FF + j0), w1b = ld4(cw + FF + j0 + 4), w2a = ld4(cw + 2 * FF + j0), w2b = ld4(cw + 2 * FF + j0 + 4), bba = ld4(cb + j0), bbb = ld4(cb + j0 + 4);
        const int rs0 = u.pm * 256 + wr * 64 + fr;
        const bool sample = u.pm >= MP / 256;
        if (fr >= 14) {
#pragma unroll
            for (int ai = 0; ai < 2; ++ai) { const int r = rs0 + ai * 128 + 48; const float rstd = rsqrtf(ss[r] * (1.f / DM) + EPS);
                LAS float* d = xch + ((((ai * 2 + wr) * 4 + wc) * 2 + (fr - 14)) * 32) + 8 * fq;
                *(LAS f32x4*)d = acc[ai][0][3][0] * rstd; *(LAS f32x4*)(d + 4) = acc[ai][0][3][1] * rstd; }
        }
        asm volatile("s_waitcnt lgkmcnt(0)" ::: "memory"); __builtin_amdgcn_s_barrier(); asm volatile("" ::: "memory");
#pragma unroll
        for (int ai = 0; ai < 2; ++ai) {
            f32x4 hpa = {0.f, 0.f, 0.f, 0.f}, hpb = {0.f, 0.f, 0.f, 0.f};
            const bool first = (ai == 0 && wr == 0);
            if (!first && fr >= 14) { const int sa = wr ? ai : ai - 1, sw = wr ? 0 : 1;
                const LAS float* s = xch + ((((sa * 2 + sw) * 4 + wc) * 2 + (fr - 14)) * 32) + 8 * fq; hpa = *(const LAS f32x4*)s; hpb = *(const LAS f32x4*)(s + 4); }
            const bool defer = first && !sample && (u.pm & 31) != 0;
#pragma unroll
            for (int m = 0; m < 4; ++m) {
                const int r = rs0 + ai * 128 + m * 16; const float rstd = rsqrtf(ss[r] * (1.f / DM) + EPS);
                const f32x4 ha = acc[ai][0][m][0] * rstd, hb = acc[ai][0][m][1] * rstd, ga = acc[ai][1][m][0] * rstd, gb = acc[ai][1][m][1] * rstd;
                f32x4 p1a, p1b, p2a, p2b;
                if (!sample) {
                    p1a = sel4(fr == 0, dpp4<0x121>(hpa), dpp4<0x121>(ha)); p1b = sel4(fr == 0, dpp4<0x121>(hpb), dpp4<0x121>(hb));
                    p2a = sel4(fr < 2, dpp4<0x122>(hpa), dpp4<0x122>(ha)); p2b = sel4(fr < 2, dpp4<0x122>(hpb), dpp4<0x122>(hb));
                } else {
                    const int t = fr & 7; const float* sc = sconv + (size_t)((r - MP) >> 3) * 2 * FF + j0;
                    f32x4 s0a = {0.f, 0.f, 0.f, 0.f}, s0b = s0a, s1a = s0a, s1b = s0a;
                    if (t < 2) { s1a = ld4(sc + FF); s1b = ld4(sc + FF + 4); if (t == 0) { s0a = ld4(sc); s0b = ld4(sc + 4); } }
                    p1a = sel4(t >= 1, dpp4<0x121>(ha), s1a); p1b = sel4(t >= 1, dpp4<0x121>(hb), s1b);
                    p2a = sel4(t >= 2, dpp4<0x122>(ha), sel4(t == 1, s1a, s0a)); p2b = sel4(t >= 2, dpp4<0x122>(hb), sel4(t == 1, s1b, s0b));
                }
                if (defer && m == 0 && fr < 2) {
                    float* d = haloA + ((size_t)(u.pm * 2 + fr) * 2) * FF + j0; st4(d, ha); st4(d + 4, hb); st4(d + FF, ga); st4(d + FF + 4, gb);
                } else {
                    const f32x4 oa = gelu4(bba + w0a * p2a + w1a * p1a + w2a * ha) * ga, ob = gelu4(bbb + w0b * p2b + w1b * p1b + w2b * hb) * gb;
                    *(v4u*)(ACT + (size_t)r * FF + j0) = pk8(oa, ob);
                }
                if (!sample) { const int t = r & 8191; if (t >= SEQ - 2) { float* o = out + O_CONVP + ((size_t)(layer * NB + (r >> 13)) * 2 + (t - (SEQ - 2))) * FF + j0; st4(o, ha); st4(o + 4, hb); }
                    if (ai == 1 && wr == 1 && m == 3 && fr >= 14) { float* d = haloB + (size_t)(u.pm * 2 + (fr - 14)) * FF + j0; st4(d, ha); st4(d + 4, hb); } }
                else { const int rs = r - MP, t = rs & 7; if (t >= 6) { float* o = out + O_CONVS + ((size_t)(layer * DB + (rs >> 3)) * 2 + (t - 6)) * FF + j0; st4(o, ha); st4(o + 4, hb); } }
                hpa = ha; hpb = hb;
            }
        }
    }
};
__device__ __forceinline__ void up_fix(unsigned char* ws, const float* cw, const float* cb, int pm, int tid) {
    const float* haloA = (const float*)(ws + WS_HALOA) + (size_t)pm * 4 * FF; const float* haloB = (const float*)(ws + WS_HALOB) + (size_t)(pm - 1) * 2 * FF; bf16* ACT = (bf16*)(ws + WS_ACT) + (size_t)pm * 256 * FF;
    for (int j = tid; j < FF; j += NWAVES * 64) {
        const float hm2 = haloB[j], hm1 = haloB[FF + j], h0 = haloA[j], g0 = haloA[FF + j], h1 = haloA[2 * FF + j], g1 = haloA[3 * FF + j];
        const float w0 = cw[j], w1 = cw[FF + j], w2 = cw[2 * FF + j], bb = cb[j];
        ACT[j] = (bf16)f2bf(gelu_tanh(bb + w0 * hm2 + w1 * hm1 + w2 * h0) * g0);
        ACT[FF + j] = (bf16)f2bf(gelu_tanh(bb + w0 * hm1 + w1 * h0 + w2 * h1) * g1);
    }
}

struct EpiGate {
    static constexpr bool PERM = true, AFTER_DRAIN = false;
    const float* ss; const bf16* PP; const bf16* XI; bf16* XO; float* ssout; bf16* XG;
    __device__ __forceinline__ void operator()(AccRef acc, const Unit& u, int wr, int wc, int fr, int fq) const {
#pragma unroll
        for (int ai = 0; ai < 2; ++ai)
#pragma unroll
            for (int m = 0; m < 4; ++m) {
                const int r = u.pm * 256 + ai * 128 + wr * 64 + m * 16 + fr;
                const float rstd = rsqrtf(ss[r] * (1.f / DM) + EPS);
                float s = 0.f;
#pragma unroll
                for (int bj = 0; bj < 2; ++bj) {
                    const int c0 = u.pn * 256 + bj * 128 + wc * 32 + 8 * fq;
                    f32x4 p0, p1, v0, v1; unpk8(*(const v4u*)(PP + (size_t)r * DM + c0), p0, p1); unpk8(*(const v4u*)(XI + (size_t)r * DM + c0), v0, v1);
                    const f32x4 a0 = acc[ai][bj][m][0] * rstd, a1 = acc[ai][bj][m][1] * rstd;
#pragma unroll
                    for (int e = 0; e < 4; ++e) { v0[e] += p0[e] * sigmoidf_(a0[e]); v1[e] += p1[e] * sigmoidf_(a1[e]); }
                    const v4u wv = pk8c(v0, v1);
                    *(v4u*)(XO + (size_t)r * DM + c0) = wv;
                    if (XG) *(v4u*)(XG + ((size_t)(c0 >> 4) * M + r) * 16 + (c0 & 15)) = wv;
                    s += (v0[0] * v0[0] + v0[1] * v0[1]) + (v0[2] * v0[2] + v0[3] * v0[3]) + (v1[0] * v1[0] + v1[1] * v1[1]) + (v1[2] * v1[2] + v1[3] * v1[3]);
                }
                ss_accum(ssout, r, s, fq);
            }
    }
};

struct EpiGlu {
    static constexpr bool PERM = true, AFTER_DRAIN = false;
    const bf16* XI; bf16* XO; float* ssout;
    __device__ __forceinline__ void operator()(AccRef acc, const Unit& u, int wr, int wc, int fr, int fq) const {
#pragma unroll
        for (int ai = 0; ai < 2; ++ai)
#pragma unroll
            for (int m = 0; m < 4; ++m) {
                const int r = u.pm * 256 + ai * 128 + wr * 64 + m * 16 + fr;
                const int c0 = u.pn * 128 + wc * 32 + 8 * fq;
                f32x4 v0, v1; unpk8(*(const v4u*)(XI + (size_t)r * DM + c0), v0, v1);
                const f32x4 a0 = acc[ai][0][m][0], a1 = acc[ai][0][m][1], b0 = acc[ai][1][m][0], b1 = acc[ai][1][m][1];
#pragma unroll
                for (int e = 0; e < 4; ++e) { v0[e] += a0[e] * sigmoidf_(b0[e]); v1[e] += a1[e] * sigmoidf_(b1[e]); }
                *(v4u*)(XO + (size_t)r * DM + c0) = pk8c(v0, v1);
                const float s = (v0[0] * v0[0] + v0[1] * v0[1]) + (v0[2] * v0[2] + v0[3] * v0[3]) + (v1[0] * v1[0] + v1[1] * v1[1]) + (v1[2] * v1[2] + v1[3] * v1[3]);
                ss_accum(ssout, r, s, fq);
            }
    }
};

struct EpiCmp {
    static constexpr bool PERM = true, AFTER_DRAIN = false;
    float* PBUF;
    __device__ __forceinline__ void operator()(AccRef acc, const Unit& u, int wr, int wc, int fr, int fq) const {
        const int row0 = u.pm * 256;
        const int c = row0 / (CMP_ROWS_S / 2);
#pragma unroll
        for (int ai = 0; ai < 2; ++ai)
#pragma unroll
            for (int m = 0; m < 4; ++m) {
                const int r = row0 + ai * 128 + wr * 64 + m * 16 + fr;
                float* o = PBUF + (size_t)r * 128 + wc * 32 + 8 * fq;
                const f32x4 v0 = c ? acc[ai][1][m][0] : acc[ai][0][m][0], v1 = c ? acc[ai][1][m][1] : acc[ai][0][m][1];
                st4(o, v0); st4(o + 4, v1);
            }
    }
};
struct Args {
    const float* in[34]; const int* page_table; float* out; unsigned char* ws; int ph_lo, ph_hi;
};
static_assert(sizeof(Args) == 34 * 8 + 8 + 8 + 8 + 8, "Args has no padding");
enum { I_XP = 0, I_XS, I_CKV, I_CWIN, I_SRE, I_SIM, I_SCONV, I_PT, I_PP, I_PS, I_NMIX, I_NFFN, I_NPLE, I_NFIN, I_WIN, I_WOUT, I_CPE, I_CW1, I_CW2,
       I_ARE, I_AIM, I_LDT, I_BRE, I_BIM, I_CRE, I_CIM, I_SD, I_WGLU, I_WUP, I_CONVW, I_CONVB, I_WDN, I_WPP, I_WPG };

struct Frame {
    LAS unsigned char* lds;
    int tid, lane, wave, gw, NGW;
    unsigned char* ws; float* out; const float* const* in; const int* pt;
    __device__ __forceinline__ float* SS(int k) const { return (float*)(ws + WS_CTL) + CW_SS + (size_t)k * M; }
};

template <int MODE>
__device__ __forceinline__ void transpose_item(const float* W, int K, int N, int nblk, bf16* WT, const float* gain, LAS float* scr, int item, int lane) {
    const int kb = item / nblk, nb = item % nblk, k0 = 32 * kb, n0 = 128 * nb;
    const int nn = n0 + 4 * (lane & 31);
#pragma unroll 8
    for (int i = 0; i < 16; ++i) { const int kk = 2 * i + (lane >> 5); f32x4 v = {0.f, 0.f, 0.f, 0.f};
        if (nn + 3 < N) v = ld4(W + (size_t)(k0 + kk) * N + nn);
        else { if (nn < N) v[0] = W[(size_t)(k0 + kk) * N + nn]; if (nn + 1 < N) v[1] = W[(size_t)(k0 + kk) * N + nn + 1]; if (nn + 2 < N) v[2] = W[(size_t)(k0 + kk) * N + nn + 2]; }
        if (gain) v = v * gain[k0 + kk];
        *(LAS f32x4*)(scr + kk * 132 + 4 * (lane & 31)) = v; }
    LDS_WAIT(); asm volatile("" ::: "memory");
    const int c4 = lane >> 4;
#pragma unroll
    for (int j = 0; j < 8; ++j) { const int n = (lane & 15) + 16 * j; const LAS float* s = scr + (8 * c4) * 132 + n;
        v4u o; o.x = pk2(s[0 * 132], s[1 * 132]); o.y = pk2(s[2 * 132], s[3 * 132]); o.z = pk2(s[4 * 132], s[5 * 132]); o.w = pk2(s[6 * 132], s[7 * 132]);
        int ns = n0 + n, dr = ns;
        if (MODE == 1) { const int half = ns >> 10, jj = ns & 1023; dr = (jj >> 7) * 256 + half * 128 + (jj & 127); }
        if (MODE == 2) { const int half = ns >= FF ? 1 : 0, jj = ns - half * FF; dr = (jj >> 7) * 256 + half * 128 + (jj & 127); }
        *(v4u*)(WT + (size_t)dr * K + k0 + 8 * c4) = o; }
    LDS_WAIT(); asm volatile("" ::: "memory");
}

template <int PART>
__device__ __forceinline__ void p0_weights(Frame& F, int gw, int NGW) {
    LAS float* scr = (LAS float*)(F.lds + F.wave * WAVE_LDS);
    const int lane = F.lane; unsigned char* ws = F.ws;
    constexpr int I_IN = 32 * 22, I_OUT = 32 * 8, I_UP = 32 * 44, I_DN = 88 * 8, I_P = 8 * 8, I_G = 32 * 8, I_GLU = 32 * 16;
    if (PART == 0) {
        constexpr int NITEMS = I_IN + I_OUT + I_UP + I_DN + 2 * I_P + I_G;
        for (int it = gw; it < NITEMS; it += NGW) {
            int r = it;
            if (r < I_IN) { transpose_item<0>(F.in[I_WIN], DM, NIN, 22, (bf16*)(ws + WS_WIN_T), F.in[I_NMIX], scr, r, lane); continue; } r -= I_IN;
            if (r < I_OUT) { transpose_item<0>(F.in[I_WOUT], DM, DM, 8, (bf16*)(ws + WS_WOUT_T), nullptr, scr, r, lane); continue; } r -= I_OUT;
            if (r < I_UP) { transpose_item<2>(F.in[I_WUP], DM, 2 * FF, 44, (bf16*)(ws + WS_WUP_T0), F.in[I_NFFN], scr, r, lane); continue; } r -= I_UP;
            if (r < I_DN) { transpose_item<0>(F.in[I_WDN], FF, DM, 8, (bf16*)(ws + WS_WDN_T0), nullptr, scr, r, lane); continue; } r -= I_DN;
            if (r < I_P) { transpose_item<0>(F.in[I_WPP], PLE, DM, 8, (bf16*)(ws + WS_WP_T0), nullptr, scr, r, lane); continue; } r -= I_P;
            if (r < I_P) { transpose_item<0>(F.in[I_WPP] + (size_t)PLE * DM, PLE, DM, 8, (bf16*)(ws + WS_WP_T1), nullptr, scr, r, lane); continue; } r -= I_P;
            transpose_item<0>(F.in[I_WPG], DM, DM, 8, (bf16*)(ws + WS_WG_T0), F.in[I_NPLE], scr, r, lane);
        }
    } else {
        constexpr int NITEMS = I_UP + I_DN + I_G + I_GLU;
        for (int it = gw; it < NITEMS; it += NGW) {
            int r = it;
            if (r < I_UP) { transpose_item<2>(F.in[I_WUP] + (size_t)DM * 2 * FF, DM, 2 * FF, 44, (bf16*)(ws + WS_WUP_T1), F.in[I_NFFN] + DM, scr, r, lane); continue; } r -= I_UP;
            if (r < I_DN) { transpose_item<0>(F.in[I_WDN] + (size_t)FF * DM, FF, DM, 8, (bf16*)(ws + WS_WDN_T1), nullptr, scr, r, lane); continue; } r -= I_DN;
            if (r < I_G) { transpose_item<0>(F.in[I_WPG] + (size_t)DM * DM, DM, DM, 8, (bf16*)(ws + WS_WG_T1), F.in[I_NPLE] + DM, scr, r, lane); continue; } r -= I_G;
            transpose_item<1>(F.in[I_WGLU], DM, 2 * DM, 16, (bf16*)(ws + WS_WGLU_T), nullptr, scr, r, lane);
        }
    }
}

__device__ __forceinline__ void p0_prologue(Frame& F) {
    LAS float* scr = (LAS float*)(F.lds + F.wave * WAVE_LDS);
    const int gw = F.gw, NGW = F.NGW, lane = F.lane;
    unsigned char* ws = F.ws;
    p0_weights<0>(F, gw, NGW);
    {
        bf16* W1rT = (bf16*)(ws + WS_W1R_T); const float* w1 = F.in[I_CW1];
        for (int it = gw; it < 256 * 16; it += NGW) {
            const int np = it >> 4, lp = it & 15, c = np >> 7, a = (np >> 6) & 1, e = np & 63;
            W1rT[(size_t)np * 1024 + lp * 64 + lane] = (bf16)f2bf(w1[(((size_t)c * 32 + 16 * a + lp) * 64 + lane) * 64 + e]);
        }
        float* cvec = (float*)(ws + WS_CVEC); const float* pe = F.in[I_CPE];
        for (int it = gw; it < 128; it += NGW) {
            const int c = it >> 6, e = it & 63; float s = 0.f;
            for (int i = lane; i < 2048; i += 64) s += pe[c * 2048 + i] * w1[((size_t)c * 2048 + i) * 64 + e];
            s = wave_sum(s); if (lane == 0) cvec[it] = s;
        }
    }
    {
        bf16* XB = (bf16*)(ws + WS_XBA); float* ss = F.SS(0);
        for (int r = gw; r < M; r += NGW) {
            const float* xr = (r < MP) ? F.in[I_XP] + (size_t)r * DM : F.in[I_XS] + (size_t)(r - MP) * DM;
            float s = 0.f;
#pragma unroll
            for (int j = 0; j < 4; ++j) { const f32x4 v = ld4(xr + 4 * lane + 256 * j); s += (v[0] * v[0] + v[1] * v[1]) + (v[2] * v[2] + v[3] * v[3]);
                v2u w; w.x = pk2(v[0], v[1]); w.y = pk2(v[2], v[3]); *(v2u*)(XB + (size_t)r * DM + 4 * lane + 256 * j) = w; }
            s = wave_sum(s); if (lane == 0) ss[r] = s;
        }
    }
    for (int it = gw; it < 2 * M; it += NGW) {
        const int i = it / M, r = it % M;
        const float* pr = (r < MP) ? F.in[I_PP] + ((size_t)i * MP + r) * PLE : F.in[I_PS] + ((size_t)i * MS + (r - MP)) * PLE;
        bf16* o = (bf16*)(ws + (i ? WS_PB1 : WS_PB0)) + (size_t)r * PLE;
        const f32x4 v = ld4(pr + 4 * lane); v2u w; w.x = pk2(v[0], v[1]); w.y = pk2(v[2], v[3]); *(v2u*)(o + 4 * lane) = w;
    }
}

__device__ __forceinline__ void p0_stream(Frame& F, int gw, int NGW, int e_lo, int e_hi, bool do_f) {
    const int lane = F.lane;
    unsigned char* ws = F.ws;
    {
        bf16* sels = (bf16*)(ws + WS_SELS); const float* ckv = F.in[I_CKV];
        for (int it = e_lo + gw * 8; it < e_hi; it += NGW * 8) {
            const int s = it >> 11, tok0 = it & 2047;
            const int page = F.pt[s * NPAGES + (tok0 >> 7)];
            const float* src = ckv + ((size_t)page * PAGE + (tok0 & 127)) * 1024 + 512 + 4 * lane;
            f32x4 v[8][2];
#pragma unroll
            for (int j = 0; j < 8; ++j) { v[j][0] = __builtin_nontemporal_load((const f32x4*)(src + j * 1024)); v[j][1] = __builtin_nontemporal_load((const f32x4*)(src + j * 1024 + 256)); }
            bf16* so = sels + ((size_t)s * (PAST + DS) + tok0) * 512 + 4 * lane;
#pragma unroll
            for (int j = 0; j < 8; ++j)
#pragma unroll
                for (int c = 0; c < 2; ++c) { v2u w; w.x = pk2(v[j][c][0], v[j][c][1]); w.y = pk2(v[j][c][2], v[j][c][3]); *(v2u*)(so + j * 512 + c * 256) = w; }
        }
    }
    if (do_f) {
        const float* cw = F.in[I_CWIN]; float* o = F.out + O_WINS; bf16* wins = (bf16*)(ws + WS_WINS);
        for (int it = gw * 4; it < DB * 512; it += NGW * 4) {
            const int s = it >> 9, i0 = it & 511;
            const float* src = cw + ((size_t)s * 512 + i0) * 512 + 4 * lane;
            f32x4 a[4], b[4];
#pragma unroll
            for (int j = 0; j < 4; ++j) { a[j] = __builtin_nontemporal_load((const f32x4*)(src + j * 512)); b[j] = __builtin_nontemporal_load((const f32x4*)(src + j * 512 + 256)); }
#pragma unroll
            for (int j = 0; j < 4; ++j) { const int i = i0 + j;
                v2u w; w.x = pk2(a[j][0], a[j][1]); w.y = pk2(a[j][2], a[j][3]); *(v2u*)(wins + ((size_t)s * 520 + i) * 512 + 4 * lane) = w;
                w.x = pk2(b[j][0], b[j][1]); w.y = pk2(b[j][2], b[j][3]); *(v2u*)(wins + ((size_t)s * 520 + i) * 512 + 256 + 4 * lane) = w;
                if (i >= 8) { float* dst = o + ((size_t)s * 512 + (i - 8)) * 512 + 4 * lane; __builtin_nontemporal_store(a[j], (f32x4*)dst); __builtin_nontemporal_store(b[j], (f32x4*)(dst + 256)); } }
        }
    }
}

__device__ __forceinline__ void cmp_finalize(Frame& F) {
    const float* PB = (const float*)(F.ws + WS_PBUF); const float* cvec = (const float*)(F.ws + WS_CVEC); const float* w2 = F.in[I_CW2];
    const int lane = F.lane, r = lane & 31, h = lane >> 5;
    constexpr int LP = NB * NCP * NG  , LS = DB * NCS * NG  , BP = (LP + 31) / 32, BS = (LS + 31) / 32, NBT = 2 * BP + 2 * BS;
    bf16x8 wf[2][4]; int wc_ = -1;
    for (int bt = F.gw; bt < NBT; bt += F.NGW) {
        int c, lb, len; bool prompt;
        if (bt < 2 * BP) { prompt = true; c = bt / BP; lb = bt % BP; len = LP; } else { const int q = bt - 2 * BP; prompt = false; c = q / BS; lb = q % BS; len = LS; }
        int idx = lb * 32 + r; const bool valid = idx < len; idx = valid ? idx : len - 1;
        const int g = idx & 3; int q = idx >> 2; size_t row0; bf16* dst;
        if (prompt) { const int n = q % NCP, sq = q / NCP; row0 = (((size_t)(c * NB + sq) * 512 + n) * NG + g); dst = (bf16*)(F.ws + (c ? WS_VCP : WS_KCP)) + ((size_t)(sq * NG + g) * 512 + n) * 64; }
        else { const int n = q % NCS, sq = q / NCS; row0 = CMP_ROWS_P + (((size_t)(c * DB + sq) * 128 + n) * NG + g); dst = (bf16*)(F.ws + (c ? WS_VCS : WS_KCS)) + ((size_t)(sq * NG + g) * 128 + n) * 64; }
        const float* p0 = PB + row0 * 128 + 8 * h; const float* p1 = PB + (row0 + NG) * 128 + 64 + 8 * h;
        f32x4 a[4][2], b[4][2];
#pragma unroll
        for (int ks = 0; ks < 4; ++ks) { a[ks][0] = ld4(p0 + 16 * ks); a[ks][1] = ld4(p0 + 16 * ks + 4); b[ks][0] = ld4(p1 + 16 * ks); b[ks][1] = ld4(p1 + 16 * ks + 4); }
        if (c != wc_) { wc_ = c;
#pragma unroll
            for (int fb = 0; fb < 2; ++fb)
#pragma unroll
                for (int ks = 0; ks < 4; ++ks) { const float* wp = w2 + ((size_t)c * 64 + 16 * ks + 8 * h) * 64 + 32 * fb + r;
                    v4u o; o.x = cvt_pk(wp[0], wp[64]); o.y = cvt_pk(wp[128], wp[192]); o.z = cvt_pk(wp[256], wp[320]); o.w = cvt_pk(wp[384], wp[448]); wf[fb][ks] = __builtin_bit_cast(bf16x8, o); } }
        f32x16 acc[2];
#pragma unroll
        for (int fb = 0; fb < 2; ++fb)
#pragma unroll
            for (int i = 0; i < 16; ++i) acc[fb][i] = 0.f;
#pragma unroll
        for (int ks = 0; ks < 4; ++ks) { const float* cv = cvec + c * 64 + 16 * ks + 8 * h; const f32x4 c0 = ld4(cv), c1 = ld4(cv + 4);
            const f32x4 x0 = a[ks][0] + b[ks][0] + c0, x1 = a[ks][1] + b[ks][1] + c1;
            v4u o; o.x = cvt_pk(gelu_tanh(x0[0]), gelu_tanh(x0[1])); o.y = cvt_pk(gelu_tanh(x0[2]), gelu_tanh(x0[3])); o.z = cvt_pk(gelu_tanh(x1[0]), gelu_tanh(x1[1])); o.w = cvt_pk(gelu_tanh(x1[2]), gelu_tanh(x1[3]));
            const bf16x8 hf = __builtin_bit_cast(bf16x8, o);
#pragma unroll
            for (int fb = 0; fb < 2; ++fb) acc[fb] = __builtin_amdgcn_mfma_f32_32x32x16_bf16(wf[fb][ks], hf, acc[fb], 0, 0, 0); }
        if (valid) {
#pragma unroll
            for (int fb = 0; fb < 2; ++fb)
#pragma unroll
                for (int q4 = 0; q4 < 4; ++q4) { v2u w; w.x = cvt_pk(acc[fb][4 * q4], acc[fb][4 * q4 + 1]); w.y = cvt_pk(acc[fb][4 * q4 + 2], acc[fb][4 * q4 + 3]);
                    *(v2u*)(dst + 32 * fb + 8 * q4 + 4 * h) = w; }
        }
    }
}

__device__ __forceinline__ void final_norm(Frame& F) {
    const bf16* X = (const bf16*)(F.ws + WS_XBA); const float* ss = F.SS(6); const float* gn = F.in[I_NFIN];
    for (int r = F.gw; r < M; r += F.NGW) {
        const float rstd = rsqrtf(ss[r] * (1.f / DM) + EPS);
        float* o = (r < MP) ? F.out + O_YP + (size_t)r * DM : F.out + O_YS + (size_t)(r - MP) * DM;
#pragma unroll
        for (int j = 0; j < 2; ++j) { const int c = 8 * F.lane + 512 * j; f32x4 v0, v1; unpk8(*(const v4u*)(X + (size_t)r * DM + c), v0, v1);
            __builtin_nontemporal_store(v0 * rstd * ld4(gn + c), (f32x4*)(o + c)); __builtin_nontemporal_store(v1 * rstd * ld4(gn + c + 4), (f32x4*)(o + c + 4)); }
    }
}
constexpr int SG_PITCH = 68;
struct SgPre { v4u a, b; float f; };
template <bool DUAL, class Pre, class Fn>
__device__ __forceinline__ void sgemm_tile(LAS unsigned char* lds, const bf16* A, int lda, const bf16* B0, const bf16* B1, int K, int wave, int lane, const Pre& pre, const Fn& fn) {
    LAS float* part = (LAS float*)lds;
    const int nsl = DUAL ? 4 : 8, sl = DUAL ? (wave & 3) : wave; const bf16* Bt = (DUAL && wave >= 4) ? B1 : B0;
    const int ksl = K / nsl, k0 = sl * ksl, steps = ksl / 16;
    const int r = lane & 31, h = lane >> 5;
    f32x16 acc[2][2];
#pragma unroll
    for (int a = 0; a < 2; ++a)
#pragma unroll
        for (int b = 0; b < 2; ++b)
#pragma unroll
            for (int i = 0; i < 16; ++i) acc[a][b][i] = 0.f;
    const bf16* ap = A + (size_t)r * lda + k0 + 8 * h; const bf16* bp = Bt + (size_t)r * K + k0 + 8 * h;
    for (int s0 = 0; s0 < steps; s0 += 8) {
        bf16x8 fa0[8], fa1[8], fb0[8], fb1[8];
#pragma unroll
        for (int j = 0; j < 8; ++j) { const int st = (s0 + j < steps) ? s0 + j : steps - 1;
            fa0[j] = *(const bf16x8*)(ap + 16 * st); fa1[j] = *(const bf16x8*)(ap + (size_t)32 * lda + 16 * st); fb0[j] = *(const bf16x8*)(bp + 16 * st); fb1[j] = *(const bf16x8*)(bp + (size_t)32 * K + 16 * st); }
        __builtin_amdgcn_sched_barrier(0);
#pragma unroll
        for (int j = 0; j < 8; ++j) if (s0 + j < steps) {
            acc[0][0] = __builtin_amdgcn_mfma_f32_32x32x16_bf16(fa0[j], fb0[j], acc[0][0], 0, 0, 0); acc[0][1] = __builtin_amdgcn_mfma_f32_32x32x16_bf16(fa0[j], fb1[j], acc[0][1], 0, 0, 0);
            acc[1][0] = __builtin_amdgcn_mfma_f32_32x32x16_bf16(fa1[j], fb0[j], acc[1][0], 0, 0, 0); acc[1][1] = __builtin_amdgcn_mfma_f32_32x32x16_bf16(fa1[j], fb1[j], acc[1][1], 0, 0, 0); }
    }
    const int t = wave * 64 + lane, row = t >> 3, c8 = (t & 7) * 8;
    const SgPre pv = pre(row, c8);
    LAS float* pw = part + wave * 64 * SG_PITCH;
#pragma unroll
    for (int a = 0; a < 2; ++a)
#pragma unroll
        for (int b = 0; b < 2; ++b)
#pragma unroll
            for (int i = 0; i < 16; ++i) pw[(32 * a + (i & 3) + 8 * (i >> 2) + 4 * h) * SG_PITCH + 32 * b + r] = acc[a][b][i];
    asm volatile("s_waitcnt lgkmcnt(0)" ::: "memory"); __syncthreads();
    f32x4 v0 = {0.f, 0.f, 0.f, 0.f}, v1 = v0, w0 = v0, w1 = v0;
#pragma unroll
    for (int p = 0; p < nsl; ++p) { const LAS float* q = part + (p * 64 + row) * SG_PITCH + c8; v0 += *(const LAS f32x4*)q; v1 += *(const LAS f32x4*)(q + 4); }
    if (DUAL) {
#pragma unroll
        for (int p = 4; p < 8; ++p) { const LAS float* q = part + (p * 64 + row) * SG_PITCH + c8; w0 += *(const LAS f32x4*)q; w1 += *(const LAS f32x4*)(q + 4); }
    }
    fn(row, c8, v0, v1, w0, w1, pv);
    asm volatile("s_waitcnt lgkmcnt(0)" ::: "memory"); __syncthreads();
}
__device__ __forceinline__ void ss_accum8(float* ssout, int r, float s, int lane) {
    s += __shfl_xor(s, 1); s += __shfl_xor(s, 2); s += __shfl_xor(s, 4);
    if ((lane & 7) == 0) atomicAdd(ssout + r, s);
}
__device__ __forceinline__ float sumsq8(f32x4 a, f32x4 b) { return (a[0] * a[0] + a[1] * a[1]) + (a[2] * a[2] + a[3] * a[3]) + (b[0] * b[0] + b[1] * b[1]) + (b[2] * b[2] + b[3] * b[3]); }

__device__ __forceinline__ void sample_resid(Frame& F, const bf16* A, int lda, const bf16* Bt, int K, const bf16* XI, bf16* XO, float* ssout) {
    for (int u = blockIdx.x; u < 256; u += gridDim.x) { const int rb = u >> 4, cbk = u & 15; const int lane = F.lane;
        sgemm_tile<false>(F.lds, A + (size_t)(MP + 64 * rb) * lda, lda, Bt + (size_t)(64 * cbk) * K, nullptr, K, F.wave, lane,
            [&](int row, int c8) { SgPre p; p.a = *(const v4u*)(XI + (size_t)(MP + 64 * rb + row) * DM + 64 * cbk + c8); p.b = p.a; p.f = 0.f; return p; },
            [&](int row, int c8, f32x4 v0, f32x4 v1, f32x4, f32x4, const SgPre& pv) { const int r = MP + 64 * rb + row, c0 = 64 * cbk + c8;
                f32x4 x0, x1; unpk8(pv.a, x0, x1); v0 += x0; v1 += x1;
                *(v4u*)(XO + (size_t)r * DM + c0) = pk8c(v0, v1);
                ss_accum8(ssout, r, sumsq8(v0, v1), lane); }); }
}
__device__ __forceinline__ void sample_gate(Frame& F, const bf16* A, const bf16* Bt, const float* ss, const bf16* PP, const bf16* XI, bf16* XO, bf16* XG, float* ssout) {
    for (int u = blockIdx.x; u < 256; u += gridDim.x) { const int rb = u >> 4, cbk = u & 15; const int lane = F.lane;
        sgemm_tile<false>(F.lds, A + (size_t)(MP + 64 * rb) * DM, DM, Bt + (size_t)(64 * cbk) * DM, nullptr, DM, F.wave, lane,
            [&](int row, int c8) { const int r = MP + 64 * rb + row, c0 = 64 * cbk + c8; SgPre p; p.a = *(const v4u*)(PP + (size_t)r * DM + c0); p.b = *(const v4u*)(XI + (size_t)r * DM + c0); p.f = ss[r]; return p; },
            [&](int row, int c8, f32x4 a0, f32x4 a1, f32x4, f32x4, const SgPre& pv) { const int r = MP + 64 * rb + row, c0 = 64 * cbk + c8;
                const float rstd = rsqrtf(pv.f * (1.f / DM) + EPS);
                f32x4 p0, p1, v0, v1; unpk8(pv.a, p0, p1); unpk8(pv.b, v0, v1);
                a0 = a0 * rstd; a1 = a1 * rstd;
#pragma unroll
                for (int e = 0; e < 4; ++e) { v0[e] += p0[e] * sigmoidf_(a0[e]); v1[e] += p1[e] * sigmoidf_(a1[e]); }
                const v4u wv = pk8c(v0, v1); *(v4u*)(XO + (size_t)r * DM + c0) = wv;
                if (XG) *(v4u*)(XG + ((size_t)(c0 >> 4) * M + r) * 16 + (c0 & 15)) = wv;
                ss_accum8(ssout, r, sumsq8(v0, v1), lane); }); }
}
__device__ __forceinline__ void sample_glu(Frame& F, const bf16* A, const bf16* WgluT, const bf16* XI, bf16* XO, float* ssout) {
    for (int u = blockIdx.x; u < 256; u += gridDim.x) { const int rb = u >> 4, cbk = u & 15; const int lane = F.lane; const int j0 = 64 * cbk;
        const bf16* B0 = WgluT + (size_t)((j0 >> 7) * 256 + (j0 & 127)) * DM;
        sgemm_tile<true>(F.lds, A + (size_t)(MP + 64 * rb) * DM, DM, B0, B0 + (size_t)128 * DM, DM, F.wave, lane,
            [&](int row, int c8) { SgPre p; p.a = *(const v4u*)(XI + (size_t)(MP + 64 * rb + row) * DM + j0 + c8); p.b = p.a; p.f = 0.f; return p; },
            [&](int row, int c8, f32x4 a0, f32x4 a1, f32x4 b0, f32x4 b1, const SgPre& pv) { const int r = MP + 64 * rb + row, c0 = j0 + c8;
                f32x4 v0, v1; unpk8(pv.a, v0, v1);
#pragma unroll
                for (int e = 0; e < 4; ++e) { v0[e] += a0[e] * sigmoidf_(b0[e]); v1[e] += a1[e] * sigmoidf_(b1[e]); }
                *(v4u*)(XO + (size_t)r * DM + c0) = pk8c(v0, v1);
                ss_accum8(ssout, r, sumsq8(v0, v1), lane); }); }
}

__device__ __forceinline__ void sample_plain(Frame& F, const bf16* A, int lda, const bf16* Bt, int K, bf16* O) {
    for (int u = blockIdx.x; u < 256; u += gridDim.x) { const int rb = u >> 4, cbk = u & 15;
        sgemm_tile<false>(F.lds, A + (size_t)(MP + 64 * rb) * lda, lda, Bt + (size_t)(64 * cbk) * K, nullptr, K, F.wave, F.lane,
            [&](int, int) { SgPre p; p.a = (v4u){0u, 0u, 0u, 0u}; p.b = p.a; p.f = 0.f; return p; },
            [&](int row, int c8, f32x4 v0, f32x4 v1, f32x4, f32x4, const SgPre&) { *(v4u*)(O + (size_t)(MP + 64 * rb + row) * DM + 64 * cbk + c8) = pk8c(v0, v1); }); }
}
__device__ __forceinline__ void sample_plain_sub(Frame& F, const bf16* A, int lda, const bf16* Bt, int K, bf16* O, int r, int n) {
    for (int u = r; u < 256; u += n) { const int rb = u >> 4, cbk = u & 15;
        sgemm_tile<false>(F.lds, A + (size_t)(MP + 64 * rb) * lda, lda, Bt + (size_t)(64 * cbk) * K, nullptr, K, F.wave, F.lane,
            [&](int, int) { SgPre p; p.a = (v4u){0u, 0u, 0u, 0u}; p.b = p.a; p.f = 0.f; return p; },
            [&](int row, int c8, f32x4 v0, f32x4 v1, f32x4, f32x4, const SgPre&) { *(v4u*)(O + (size_t)(MP + 64 * rb + row) * DM + 64 * cbk + c8) = pk8c(v0, v1); }); }
}
__device__ __forceinline__ void prompt_cmp(Frame& F) {
    const bf16* A = (const bf16*)(F.ws + WS_CMPA); const bf16* W = (const bf16*)(F.ws + WS_W1R_T); float* PB = (float*)(F.ws + WS_PBUF);
    for (int u = blockIdx.x; u < 256; u += gridDim.x) { const int rb = u >> 1, c2 = u & 1, c = (64 * rb) / (CMP_ROWS_P / 2);
        sgemm_tile<false>(F.lds, A + (size_t)(64 * rb) * 1024, 1024, W + (size_t)(128 * c + 64 * c2) * 1024, nullptr, 1024, F.wave, F.lane,
            [&](int, int) { SgPre p; p.a = (v4u){0u, 0u, 0u, 0u}; p.b = p.a; p.f = 0.f; return p; },
            [&](int row, int c8, f32x4 v0, f32x4 v1, f32x4, f32x4, const SgPre&) { float* o = PB + (size_t)(64 * rb + row) * 128 + 64 * c2 + c8; st4(o, v0); st4(o + 4, v1); }); }
}

constexpr int SC_PITCH = 2064, SC_BUF = 32 * SC_PITCH;
__device__ __forceinline__ void sample_cmp_pages(Frame& F) {
    LAS unsigned char* al = F.lds;
    const int lane = F.lane, w = F.wave, j16 = lane & 15, kq = lane >> 4;
    const int c = blockIdx.x & 1, u0 = blockIdx.x >> 1, ustep = gridDim.x >> 1;
    const float* ckv = F.in[I_CKV] + c * 256 + 4 * lane; float* PB = (float*)(F.ws + WS_PBUF);
    bf16x8 bq[32];
    { const bf16* bp = (const bf16*)(F.ws + WS_W1R_T) + (size_t)(c * 128 + 16 * w + j16) * 1024 + 8 * kq;
#pragma unroll
      for (int ks = 0; ks < 32; ++ks) bq[ks] = *(const bf16x8*)(bp + 32 * ks); }
    LAS unsigned char* aw = al + (lane >> 4) * SC_PITCH + 2 * (w * 64 + (lane & 15) * 4);
    LAS const unsigned char* ap = al + j16 * SC_PITCH + 16 * kq;
    f32x4 v[16];
    int u = u0;
    if (u < DB * NPAGES) { const float* src = ckv + ((size_t)F.pt[u] * PAGE + w) * 1024;
#pragma unroll
        for (int i = 0; i < 16; ++i) v[i] = __builtin_nontemporal_load((const f32x4*)(src + (size_t)i * 8192));
#pragma unroll
        for (int i = 0; i < 16; ++i) { v2u wv; wv.x = cvt_pk(v[i][0], v[i][1]); wv.y = cvt_pk(v[i][2], v[i][3]); *(LAS v2u*)(aw + (i >> 1) * 4 * SC_PITCH + (i & 1) * 1024) = wv; } }
    LDS_WAIT(); __syncthreads();
    for (int p = 0; u < DB * NPAGES; u += ustep, p ^= 1) {
        const int un = u + ustep; const bool more = un < DB * NPAGES;
        if (more) { const float* src = ckv + ((size_t)F.pt[un] * PAGE + w) * 1024;
#pragma unroll
            for (int i = 0; i < 16; ++i) v[i] = __builtin_nontemporal_load((const f32x4*)(src + (size_t)i * 8192)); }
        f32x4 acc0 = {0.f, 0.f, 0.f, 0.f}, acc1 = acc0;
        LAS const unsigned char* a = ap + p * SC_BUF;
#pragma unroll
        for (int ks = 0; ks < 32; ++ks) { const bf16x8 a0 = *(LAS const bf16x8*)(a + 64 * ks), a1 = *(LAS const bf16x8*)(a + 16 * SC_PITCH + 64 * ks);
            acc0 = __builtin_amdgcn_mfma_f32_16x16x32_bf16(a0, bq[ks], acc0, 0, 0, 0); acc1 = __builtin_amdgcn_mfma_f32_16x16x32_bf16(a1, bq[ks], acc1, 0, 0, 0); }
        const int s = u >> 4, pg = u & 15;
        float* po = PB + ((size_t)CMP_ROWS_P + (size_t)(c * DB + s) * 512 + 32 * pg + 4 * kq) * 128 + 16 * w + j16;
#pragma unroll
        for (int e = 0; e < 4; ++e) { po[e * 128] = acc0[e]; po[(16 + e) * 128] = acc1[e]; }
        if (more) { LAS unsigned char* d = aw + (p ^ 1) * SC_BUF;
#pragma unroll
            for (int i = 0; i < 16; ++i) { v2u wv; wv.x = cvt_pk(v[i][0], v[i][1]); wv.y = cvt_pk(v[i][2], v[i][3]); *(LAS v2u*)(d + (i >> 1) * 4 * SC_PITCH + (i & 1) * 1024) = wv; } }
        LDS_WAIT(); __syncthreads();
    }
}

typedef short s16x4 __attribute__((ext_vector_type(4)));
constexpr float NEGS = -3.0e38f;
constexpr int VBUF = 4096;
constexpr int AL_K = 0, AL_V = VBUF, AL_IMP = 2 * VBUF, AL_V1 = 2 * VBUF  , AL_SELM = 2 * VBUF + 8192, AL_END = AL_SELM + 256;
static_assert(AL_END <= WAVE_LDS, "attention LDS map");

struct ASeq {
    const bf16* kc; const bf16* vc; int nc;
    const bf16* ks; int spitch; int srows;
    const bf16* kw; int wpitch; int wrows; int wpos0;
    int qpos0; int ns;
};

__device__ __forceinline__ float ex2(float x) { return __builtin_amdgcn_exp2f(x); }
typedef unsigned v2uu __attribute__((ext_vector_type(2)));
__device__ __forceinline__ float xhalf_max(float v) { const unsigned b = __float_as_uint(v); const v2uu r = __builtin_amdgcn_permlane32_swap(b, b, false, false); float o; asm("v_max_f32 %0, %1, %2" : "=v"(o) : "v"(r[0]), "v"(r[1])); return o; }
__device__ __forceinline__ float xhalf_sum(float v) { const unsigned b = __float_as_uint(v); const v2uu r = __builtin_amdgcn_permlane32_swap(b, b, false, false); return __uint_as_float(r[0]) + __uint_as_float(r[1]); }
template <int CTRL> __device__ __forceinline__ float dpp_f(float v) { return __uint_as_float((unsigned)__builtin_amdgcn_update_dpp(0, (int)__float_as_uint(v), CTRL, 0xf, 0xf, true)); }
__device__ __forceinline__ float quad_sum(float v) { v += dpp_f<0xB1>(v); v += dpp_f<0x4E>(v); return v; }

__device__ __forceinline__ void issue_k(LAS unsigned char* kbuf, const bf16* kbase, int pitch, int row0, int nrows, int lane) {
#pragma unroll
    for (int i = 0; i < 4; ++i) { int row = row0 + 8 * i + (lane >> 3); row = row < nrows ? row : nrows - 1;
        const int ch = (lane & 7) ^ ((lane >> 3) & 7);
        __builtin_amdgcn_global_load_lds((const unsigned*)(kbase + (size_t)row * pitch + 8 * ch), (LAS unsigned*)(kbuf + i * 1024), 16, 0, 0); }
}
__device__ __forceinline__ void read_kf(bf16x8 (&kf)[4], LAS const unsigned char* kbuf, int lane) {
    const int key = lane & 31, h = lane >> 5;
#pragma unroll
    for (int ks = 0; ks < 4; ++ks) kf[ks] = *(LAS const bf16x8*)(kbuf + key * 128 + (((2 * ks + h) ^ (key & 7)) << 4));
}
__device__ __forceinline__ void issue_v(LAS unsigned char* vbuf, const bf16* vbase, int pitch, int row0, int nrows, int lane) {
#pragma unroll
    for (int i = 0; i < 4; ++i) { int row = row0 + 8 * i + (lane >> 3); row = row < nrows ? row : nrows - 1;
        const int ch = (lane & 7) ^ (((lane >> 4) & 1) << 2);
        __builtin_amdgcn_global_load_lds((const unsigned*)(vbase + (size_t)row * pitch + 8 * ch), (LAS unsigned*)(vbuf + i * 1024), 16, 0, 0); }
}
__device__ __forceinline__ s16x4 vtr(LAS const unsigned char* p) { return __builtin_bit_cast(s16x4, __builtin_amdgcn_ds_read_tr16_b64_v4i16((LAS s16x4*)p)); }
__device__ __forceinline__ bf16x8 vfrag(LAS const unsigned char* va, int ks) {
    const s16x4 lo = vtr(va + ks * 2048), hi = vtr(va + ks * 2048 + 1024);
    bf16x8 r; r[0] = lo[0]; r[1] = lo[1]; r[2] = lo[2]; r[3] = lo[3]; r[4] = hi[0]; r[5] = hi[1]; r[6] = hi[2]; r[7] = hi[3]; return r;
}

template <int NQB> struct AState { float m[NQB], l[NQB]; f32x16 o[2][NQB]; };

#define OFFI(i) (((i) & 3) + 8 * ((i) >> 2))
__device__ __forceinline__ void qk_raw(f32x16& acc, const bf16x8 (&kf)[4], const bf16x8 (&qf)[4]) {
#pragma unroll
    for (int i = 0; i < 16; ++i) acc[i] = 0.f;
#pragma unroll
    for (int ks = 0; ks < 4; ++ks) acc = __builtin_amdgcn_mfma_f32_32x32x16_bf16(kf[ks], qf[ks], acc, 0, 0, 0);
}
__device__ __forceinline__ void mask_bias(f32x16& s, float sl_alpha, float fb, int lo_rel, int hi_rel, bool extra) {
#pragma unroll
    for (int i = 0; i < 16; ++i) { const bool ok = extra && (OFFI(i) <= hi_rel) && (OFFI(i) >= lo_rel); s[i] = ok ? __builtin_fmaf(sl_alpha, (float)OFFI(i), s[i] + fb) : NEGS; }
}
template <int NQB>
__device__ __forceinline__ void scores(f32x16& s, const bf16x8 (&kf)[4], const bf16x8 (&qf)[4], float sl_alpha, float fb, int lo_rel, int hi_rel, bool extra) {
    qk_raw(s, kf, qf); mask_bias(s, sl_alpha, fb, lo_rel, hi_rel, extra);
}
__device__ __forceinline__ float max16(const f32x16& s) {
    float a = fmaxf(fmaxf(s[0], s[1]), fmaxf(s[2], s[3])), b = fmaxf(fmaxf(s[4], s[5]), fmaxf(s[6], s[7])), c = fmaxf(fmaxf(s[8], s[9]), fmaxf(s[10], s[11])), d = fmaxf(fmaxf(s[12], s[13]), fmaxf(s[14], s[15]));
    return fmaxf(fmaxf(a, b), fmaxf(c, d));
}
__device__ __forceinline__ void pack_p(bf16x8 (&pf)[2], const f32x16& p) {
#pragma unroll
    for (int ks = 0; ks < 2; ++ks) { v4u w; w.x = cvt_pk(p[8 * ks + 0], p[8 * ks + 1]); w.y = cvt_pk(p[8 * ks + 2], p[8 * ks + 3]); w.z = cvt_pk(p[8 * ks + 4], p[8 * ks + 5]); w.w = cvt_pk(p[8 * ks + 6], p[8 * ks + 7]); pf[ks] = __builtin_bit_cast(bf16x8, w); }
}

template <int NQB>
__device__ __forceinline__ void attn_unit(Frame& F, const ASeq& A, int qrow0, int g, int tl0, LAS unsigned char* wl) {
    int lane_ = F.lane; asm volatile("" : "+v"(lane_));
    const int lane = lane_ & 63, h = lane >> 5, c = lane & 31, head = c & 3;
    LAS unsigned char* kl = wl + AL_K; LAS unsigned char* vl = wl + AL_V; LAS float* imp = (LAS float*)(wl + AL_IMP); LAS unsigned* selm = (LAS unsigned*)(wl + AL_SELM);
    unsigned* stash0 = (unsigned*)(F.ws + WS_STASH) + (size_t)F.gw * 2048 + lane;
    const int vq = (lane & 15) >> 2, vfq = (vq >> 1) & 1;
    const int vbase_off = (4 * h + vq) * 128 + (2 * ((lane >> 4) & 1) + ((lane & 3) >> 1)) * 16 + (lane & 1) * 8;
    const int voff0 = vbase_off + vfq * 64, voff1 = vbase_off + (1 - vfq) * 64;
    const bf16* Qb = (const bf16*)(F.ws + WS_QB); bf16* Ob = (bf16*)(F.ws + WS_OB); const float* gates = (const float*)(F.ws + WS_GATES);
    bf16x8 qf[NQB][4]; int qpos[NQB];
#pragma unroll
    for (int qb = 0; qb < NQB; ++qb) {
        const int tok = qb * 8 + (c >> 2); const size_t r = (size_t)qrow0 + tok;
        const bf16* qp = Qb + r * DM + (4 * g + head) * 64 + 8 * h;
#pragma unroll
        for (int ks = 0; ks < 4; ++ks) qf[qb][ks] = *(const bf16x8*)(qp + 16 * ks);
        qpos[qb] = A.qpos0 + tl0 + tok;
    }
    const float sl = exp2f(-0.5f * (float)(4 * g + head + 1)) * LOG2E;
    const int qmin = A.qpos0 + tl0, qmax = qmin + 8 * NQB - 1;
    AState<NQB> st;

#pragma unroll
    for (int i = 0; i < 8; ++i) *(LAS f32x4*)(imp + (i * 64 + lane) * 4) = (f32x4){0.f, 0.f, 0.f, 0.f};

    int lim[NQB];
#pragma unroll
    for (int qb = 0; qb < NQB; ++qb) { int nv = qpos[qb] >= 31 ? (qpos[qb] - 31) / 16 + 1 : 0; nv = nv < A.nc ? nv : A.nc; lim[qb] = nv - 1; }
    int nvmax = qmax >= 31 ? (qmax - 31) / 16 + 1 : 0; nvmax = nvmax < A.nc ? nvmax : A.nc;
    const int ntc = (nvmax + 31) >> 5;
#pragma unroll
    for (int qb = 0; qb < NQB; ++qb) { st.m[qb] = -1.0e30f; st.l[qb] = 0.f; }
    if (ntc > 0) issue_k(kl, A.kc, 64, 0, A.nc, lane);
    for (int tile = 0; tile < ntc; ++tile) {
        bf16x8 kf[4];
        asm volatile("s_waitcnt vmcnt(0)" ::: "memory"); read_kf(kf, kl, lane); LDS_WAIT(); asm volatile("" ::: "memory");
        if (tile + 1 < ntc) issue_k(kl, A.kc, 64, (tile + 1) * 32, A.nc, lane);
        const int nb = tile * 32 + 4 * h;
#pragma unroll
        for (int qb = 0; qb < NQB; ++qb) {
            f32x16 s; scores<NQB>(s, kf, qf[qb], sl * 16.f, sl * (16.f * (float)nb + 15.5f - (float)qpos[qb]), 0, lim[qb] - nb, true);
            float tm = xhalf_max(max16(s));
            const float mn = fmaxf(st.m[qb], tm); float sum = 0.f;
#pragma unroll
            for (int i = 0; i < 16; ++i) sum += ex2(s[i] - mn);
            st.l[qb] = st.l[qb] * ex2(st.m[qb] - mn) + sum; st.m[qb] = mn;
        }
    }
    float invl[NQB];
#pragma unroll
    for (int qb = 0; qb < NQB; ++qb) { const float lt = xhalf_sum(st.l[qb]); invl[qb] = (lim[qb] >= 0 && lt > 0.f) ? 1.f / lt : 0.f; }
#pragma unroll
    for (int db = 0; db < 2; ++db)
#pragma unroll
        for (int qb = 0; qb < NQB; ++qb)
#pragma unroll
            for (int i = 0; i < 16; ++i) st.o[db][qb][i] = 0.f;
    if (ntc > 0) { issue_k(kl, A.kc, 64, 0, A.nc, lane); issue_v(vl, A.vc, 64, 0, A.nc, lane); }
    for (int tile = 0; tile < ntc; ++tile) {
        const bool more = tile + 1 < ntc;
        bf16x8 kf[4];
        asm volatile("s_waitcnt vmcnt(4)" ::: "memory"); read_kf(kf, kl, lane); LDS_WAIT(); asm volatile("" ::: "memory");
        if (more) issue_k(kl, A.kc, 64, (tile + 1) * 32, A.nc, lane);
        const int nb = tile * 32 + 4 * h;
        bf16x8 pf[NQB][2];
#pragma unroll
        for (int qb = 0; qb < NQB; ++qb) {
            f32x16 s; scores<NQB>(s, kf, qf[qb], sl * 16.f, sl * (16.f * (float)nb + 15.5f - (float)qpos[qb]), 0, lim[qb] - nb, true);
            f32x16 p;
#pragma unroll
            for (int i = 0; i < 16; ++i) p[i] = ex2(s[i] - st.m[qb]) * invl[qb];
#pragma unroll
            for (int q = 0; q < 4; ++q) { const float v = quad_sum((p[4 * q] + p[4 * q + 1]) + (p[4 * q + 2] + p[4 * q + 3]));
                if (head == 0) imp[(qb * 8 + (c >> 2)) * 128 + 8 * tile + 2 * q + h] = v; }
            pack_p(pf[qb], p);
        }
        if (more) asm volatile("s_waitcnt vmcnt(4) lgkmcnt(0)" ::: "memory"); else asm volatile("s_waitcnt vmcnt(0) lgkmcnt(0)" ::: "memory");
#pragma unroll
        for (int db = 0; db < 2; ++db)
#pragma unroll
            for (int ks = 0; ks < 2; ++ks) { const bf16x8 vf = vfrag(vl + (db ? voff1 : voff0), ks);
#pragma unroll
                for (int qb = 0; qb < NQB; ++qb) st.o[db][qb] = __builtin_amdgcn_mfma_f32_32x32x16_bf16(vf, pf[qb][ks], st.o[db][qb], 0, 0, 0); }
        LDS_WAIT(); asm volatile("" ::: "memory");
        if (more) issue_v(vl, A.vc, 64, (tile + 1) * 32, A.nc, lane);
    }
    asm volatile("s_waitcnt vmcnt(0) lgkmcnt(0)" ::: "memory");

    unsigned taken = 0u;
    {
        const int tok = lane >> 2, part = lane & 3; const bool live = tok < 8 * NQB;
        const int cur = (A.qpos0 + tl0 + tok) >> 6;
        float v[32];
#pragma unroll
        for (int j4 = 0; j4 < 8; ++j4) { const f32x4 t = *(LAS const f32x4*)(imp + (live ? tok : 0) * 128 + 32 * part + 4 * j4); v[4 * j4] = t[0]; v[4 * j4 + 1] = t[1]; v[4 * j4 + 2] = t[2]; v[4 * j4 + 3] = t[3]; }
        const int rel = cur - 32 * part, nsrel = A.ns - 32 * part;
#pragma unroll
        for (int j = 0; j < 32; ++j) { const bool forced = (j == rel) || (j == rel - 1) || (j == 0 && part == 0);
            v[j] = (j < nsrel) ? ((j <= rel) ? v[j] + (forced ? 1.0e4f : 0.f) : -1.0e30f) : NEGS; }
        for (int k = 0; k < 16; ++k) {
            float bv = -__builtin_inff(); int bj = 0;
#pragma unroll
            for (int j = 0; j < 32; ++j) { const float cnd = ((taken >> j) & 1u) ? NEGS : v[j]; if (cnd > bv) { bv = cnd; bj = j; } }
            int bi = 32 * part + bj;
            { const float ov = dpp_f<0xB1>(bv); const int oi = __builtin_amdgcn_update_dpp(0, bi, 0xB1, 0xf, 0xf, true); if (ov > bv || (ov == bv && oi < bi)) { bv = ov; bi = oi; } }
            { const float ov = dpp_f<0x4E>(bv); const int oi = __builtin_amdgcn_update_dpp(0, bi, 0x4E, 0xf, 0xf, true); if (ov > bv || (ov == bv && oi < bi)) { bv = ov; bi = oi; } }
            if ((bi >> 5) == part) taken |= 1u << (bi & 31);
        }
        if (!live) taken = 0u;
        selm[lane] = taken;
    }
    LDS_WAIT(); asm volatile("" ::: "memory");
    { unsigned* stash = stash0; asm volatile("" : "+v"(stash));
#pragma unroll
    for (int db = 0; db < 2; ++db)
#pragma unroll
        for (int qb = 0; qb < NQB; ++qb)
#pragma unroll
            for (int k = 0; k < 8; ++k) { const float g0 = gates[((size_t)qrow0 + qb * 8 + (c >> 2)) * 48 + (4 * g + head) * 3];
                stash[((db * NQB + qb) * 8 + k) * 64] = cvt_pk(st.o[db][qb][2 * k] * g0, st.o[db][qb][2 * k + 1] * g0); } }
    unsigned un[4], unq[NQB][4];
    { unsigned u = taken; u |= __shfl_xor(u, 4); u |= __shfl_xor(u, 8); u |= __shfl_xor(u, 16);
#pragma unroll
      for (int qb = 0; qb < NQB; ++qb)
#pragma unroll
          for (int p = 0; p < 4; ++p) unq[qb][p] = __builtin_amdgcn_readlane(u, 32 * qb + p);
#pragma unroll
      for (int p = 0; p < 4; ++p) { un[p] = unq[0][p]; if (NQB > 1) un[p] |= unq[NQB - 1][p]; } }
    LDS_WAIT(); asm volatile("" ::: "memory");

    f32x16 sbase;
#pragma unroll
    for (int i = 0; i < 16; ++i) sbase[i] = sl * (float)OFFI(i);
#pragma unroll
    for (int br = 0; br < 2; ++br) {
#pragma unroll
        for (int qb = 0; qb < NQB; ++qb) { st.m[qb] = -1.0e30f; st.l[qb] = 0.f; }
#pragma unroll
        for (int db = 0; db < 2; ++db)
#pragma unroll
            for (int qb = 0; qb < NQB; ++qb)
#pragma unroll
                for (int i = 0; i < 16; ++i) st.o[db][qb][i] = 0.f;
        const bf16* kb_ = br == 0 ? A.ks : A.kw; const int pitch = br == 0 ? A.spitch : A.wpitch, nrows = br == 0 ? A.srows : A.wrows, pos0 = br == 0 ? 0 : A.wpos0;
        const int curblk = qmin >> 6;
        unsigned ub[4];
#pragma unroll
        for (int p = 0; p < 4; ++p) { const int hi = curblk - 32 * p; ub[p] = hi < 0 ? 0u : (hi >= 31 ? un[p] : (un[p] & ((2u << hi) - 1u))); }
        int wrow_min = 0, wrow_cur = -1, ublk = 0, upart = 3, hcnt = 0; unsigned ubits = ub[3];
        if (br == 1) { int lo = qmin - 511 - pos0; lo = lo > 0 ? lo : 0; wrow_min = lo & ~31; wrow_cur = (qmax - pos0) & ~31; }
#define NEXT_TILE(ROW, BLK, OK) do { OK = false; \
            if (br == 0) { for (;;) { \
                if (hcnt == 0) { while (ubits == 0u && upart > 0) { --upart; ubits = upart == 2 ? ub[2] : (upart == 1 ? ub[1] : ub[0]); } \
                    if (ubits == 0u) break; \
                    const int j_ = 31 - __builtin_clz(ubits); ubits &= ~(1u << j_); ublk = 32 * upart + j_; hcnt = 2; } \
                --hcnt; const int r_ = ublk * 64 + 32 * hcnt; if (r_ > qmax) continue; \
                ROW = r_; BLK = ublk; OK = true; break; } } \
            else if (wrow_cur >= wrow_min) { ROW = wrow_cur; BLK = 0; wrow_cur -= 32; OK = true; } } while (0)
        int crow = 0, cblk = 0; bool cok; NEXT_TILE(crow, cblk, cok);
        int pb = 0;
        if (cok) { issue_k(kl, kb_, pitch, crow, nrows, lane); issue_v(vl, kb_ + 256, pitch, crow, nrows, lane); }
        while (cok) {
            int nrow = 0, nblk = 0; bool nok; NEXT_TILE(nrow, nblk, nok);
            bf16x8 kf[4];
            asm volatile("s_waitcnt vmcnt(4)" ::: "memory"); read_kf(kf, kl, lane); LDS_WAIT(); asm volatile("" ::: "memory");
            if (nok) { issue_k(kl, kb_, pitch, nrow, nrows, lane); issue_v(pb ? vl : wl + AL_V1, kb_ + 256, pitch, nrow, nrows, lane); }
            bool sb[NQB], act[NQB];
#pragma unroll
            for (int qb = 0; qb < NQB; ++qb) { sb[qb] = true; act[qb] = true;
                if (br == 0) { const unsigned w = selm[(qb * 8 + (c >> 2)) * 4 + (cblk >> 5)]; sb[qb] = (w >> (cblk & 31)) & 1u;
                    const int pp = cblk >> 5; const unsigned uw = pp == 0 ? unq[qb][0] : (pp == 1 ? unq[qb][1] : (pp == 2 ? unq[qb][2] : unq[qb][3])); act[qb] = (uw >> (cblk & 31)) & 1u; } }
            const int nb = pos0 + crow + 4 * h;
            const bool interior = (pos0 + crow + 31 <= qmin) && (br == 0 || qmax - (pos0 + crow) < 512);
            bf16x8 pf[NQB][2];
#pragma unroll
            for (int qb = 0; qb < NQB; ++qb) if (act[qb]) {
                const bool un_ = st.m[qb] < -1.0e29f; const float mref = un_ ? 0.f : st.m[qb];
                const float fb = sl * (float)(nb - qpos[qb]);
                const float c0 = ((interior && !sb[qb]) ? NEGS : fb) - mref;
                f32x16 s;
#pragma unroll
                for (int i = 0; i < 16; ++i) s[i] = sbase[i] + c0;
#pragma unroll
                for (int ks = 0; ks < 4; ++ks) s = __builtin_amdgcn_mfma_f32_32x32x16_bf16(kf[ks], qf[qb][ks], s, 0, 0, 0);
                if (!interior) { const int lo_rel = (br == 1) ? (qpos[qb] - 511 - nb) : -64, hi_rel = qpos[qb] - nb;
#pragma unroll
                    for (int i = 0; i < 16; ++i) { const bool ok = sb[qb] && (OFFI(i) <= hi_rel) && (OFFI(i) >= lo_rel); s[i] = ok ? s[i] : NEGS; } }
                float tm = xhalf_max(max16(s));
                const bool dead = tm < -1.0e37f;
                const float shift = dead ? 0.f : (un_ ? tm : (tm > 8.f ? tm : 0.f));
                if (__any(shift != 0.f)) {
                    const float al = un_ ? 1.f : ex2(-shift);
#pragma unroll
                    for (int i = 0; i < 16; ++i) s[i] -= shift;
                    st.l[qb] *= al;
#pragma unroll
                    for (int db = 0; db < 2; ++db)
#pragma unroll
                        for (int i = 0; i < 16; ++i) st.o[db][qb][i] *= al;
                }
                if (!dead) st.m[qb] = mref + shift;
                float sum = 0.f;
#pragma unroll
                for (int i = 0; i < 16; ++i) { s[i] = ex2(s[i]); sum += s[i]; }
                st.l[qb] += sum;
                pack_p(pf[qb], s);
                __builtin_amdgcn_sched_barrier(0);
            }
            if (nok) asm volatile("s_waitcnt vmcnt(8) lgkmcnt(0)" ::: "memory"); else asm volatile("s_waitcnt vmcnt(0) lgkmcnt(0)" ::: "memory");
#pragma unroll
            for (int db = 0; db < 2; ++db)
#pragma unroll
                for (int ks = 0; ks < 2; ++ks) { const bf16x8 vf = vfrag((pb ? wl + AL_V1 : vl) + (db ? voff1 : voff0), ks);
#pragma unroll
                    for (int qb = 0; qb < NQB; ++qb) if (act[qb]) st.o[db][qb] = __builtin_amdgcn_mfma_f32_32x32x16_bf16(vf, pf[qb][ks], st.o[db][qb], 0, 0, 0); }
            LDS_WAIT(); asm volatile("" ::: "memory");
            crow = nrow; cblk = nblk; cok = nok; pb ^= 1;
        }
#undef NEXT_TILE
        unsigned* stash = stash0; asm volatile("s_waitcnt vmcnt(0)" : "+v"(stash) :: "memory");
#pragma unroll
        for (int qb = 0; qb < NQB; ++qb) {
            const int tok = qb * 8 + (c >> 2);
            const float gbr = gates[((size_t)qrow0 + tok) * 48 + (4 * g + head) * 3 + 1 + br];
            const float lt = xhalf_sum(st.l[qb]); const float sc = lt > 0.f ? gbr / lt : 0.f;
            bf16* orow = Ob + ((size_t)qrow0 + tok) * DM + (4 * g + head) * 64;
#pragma unroll
            for (int db = 0; db < 2; ++db)
#pragma unroll
                for (int k = 0; k < 8; k += 2) {
                    const unsigned w0 = stash[((db * NQB + qb) * 8 + k) * 64], w1 = stash[((db * NQB + qb) * 8 + k + 1) * 64];
                    const float e0 = __uint_as_float(w0 << 16) + st.o[db][qb][2 * k] * sc, e1 = __uint_as_float(w0 & 0xffff0000u) + st.o[db][qb][2 * k + 1] * sc;
                    const float e2 = __uint_as_float(w1 << 16) + st.o[db][qb][2 * k + 2] * sc, e3 = __uint_as_float(w1 & 0xffff0000u) + st.o[db][qb][2 * k + 3] * sc;
                    if (br == 0) { stash[((db * NQB + qb) * 8 + k) * 64] = cvt_pk(e0, e1); stash[((db * NQB + qb) * 8 + k + 1) * 64] = cvt_pk(e2, e3); }
                    else { v2u w; w.x = cvt_pk(e0, e1); w.y = cvt_pk(e2, e3); *(v2u*)(orow + 32 * db + 8 * (k >> 1) + 4 * h) = w; }
                }
        }
        LDS_WAIT(); asm volatile("" ::: "memory");
    }
}

constexpr int CW_AQ = 8192;
__device__ __forceinline__ void attn_phase_v2(Frame& F, int qslot = 0) {
    LAS unsigned char* wl = F.lds + F.wave * WAVE_LDS;
    unsigned* qh = (unsigned*)(F.ws + WS_CTL) + CW_AQ + 64 * qslot;
    constexpr int NUP = NB * NG * (SEQ / 16), NUS = DB * NG;
    for (;;) {
        unsigned u = 0; if (F.lane == 0) u = atomicAdd(qh, 1u); u = __builtin_amdgcn_readfirstlane(u);
        if (u >= (unsigned)(NUP + NUS)) break;
        ASeq A;
        if (u >= (unsigned)NUS) {
            const unsigned v_ = u - NUS; const int tt = (SEQ / 16 - 1) - (int)(v_ >> 3), b = (v_ >> 2) & 1, g = v_ & 3;
            A.kc = (const bf16*)(F.ws + WS_KCP) + (size_t)(b * NG + g) * 512 * 64; A.vc = (const bf16*)(F.ws + WS_VCP) + (size_t)(b * NG + g) * 512 * 64; A.nc = NCP;
            A.ks = (const bf16*)(F.ws + WS_KVB) + (size_t)b * SEQ * 1024 + 512 + g * 64; A.spitch = 1024; A.srows = SEQ;
            A.kw = (const bf16*)(F.ws + WS_WINB) + (size_t)b * SEQ * 512 + g * 64; A.wpitch = 512; A.wrows = SEQ; A.wpos0 = 0; A.qpos0 = 0; A.ns = NSP;
            attn_unit<2>(F, A, b * SEQ + tt * 16, g, tt * 16, wl);
        } else {
            const int v = (int)u, s = v >> 2, g = v & 3;
            A.kc = (const bf16*)(F.ws + WS_KCS) + (size_t)(s * NG + g) * 128 * 64; A.vc = (const bf16*)(F.ws + WS_VCS) + (size_t)(s * NG + g) * 128 * 64; A.nc = NCS;
            A.ks = (const bf16*)(F.ws + WS_SELS) + (size_t)s * (PAST + DS) * 512 + g * 64; A.spitch = 512; A.srows = PAST + DS;
            A.kw = (const bf16*)(F.ws + WS_WINS) + (size_t)s * 520 * 512 + g * 64; A.wpitch = 512; A.wrows = 520; A.wpos0 = PAST - 512; A.qpos0 = PAST; A.ns = NSS;
            attn_unit<1>(F, A, MP + s * DS, g, 0, wl);
        }
    }
}
constexpr int S5L = 32;
__device__ __forceinline__ void cmul(float& r, float& i, float ar, float ai) { const float t = r * ar - i * ai; i = r * ai + i * ar; r = t; }

__device__ __forceinline__ void s5_tables_part(Frame& F, int g, int q, LAS float* sl) {
    LAS float* Bbr = sl; LAS float* Bbi = sl + 1024; LAS float* Cr = sl + 2048; LAS float* Ci = sl + 3072; LAS float* Ar = sl + 4096; LAS float* Ai = sl + 4160; LAS float* Qr = sl + 4224; LAS float* Qi = sl + 4288;
    const int tid = F.tid;
    bf16* KT = (bf16*)(F.ws + WS_S5K) + (size_t)g * 32 * 256; bf16* WE = (bf16*)(F.ws + WS_S5W) + (size_t)g * 128 * 512; bf16* VI = (bf16*)(F.ws + WS_S5V) + (size_t)g * 512 * 128;
    float* AL = (float*)(F.ws + WS_S5A) + (size_t)g * 128; float* A8 = (float*)(F.ws + WS_S5A) + 64 * 128 + (size_t)g * 128;
    const float* gn = F.in[I_NMIX] + DM;
    __syncthreads();
    if (tid < 64) {
        const int p = tid;
        const float are = F.in[I_ARE][g * 64 + p], aim = F.in[I_AIM][g * 64 + p], dt = expf(F.in[I_LDT][g]);
        const float er = expf(are * dt); float sn, cs; sincosf(aim * dt, &sn, &cs);
        const float abr = er * cs, abi = er * sn;
        const float nr = abr - 1.f, ni = abi, den = are * are + aim * aim;
        const float fr_ = (nr * are + ni * aim) / den, fi_ = (ni * are - nr * aim) / den;
        Ar[p] = abr; Ai[p] = abi;
#pragma unroll
        for (int c = 0; c < 16; ++c) { const float br = F.in[I_BRE][(g * 64 + p) * 16 + c], bi = F.in[I_BIM][(g * 64 + p) * 16 + c], gg = gn[g * 16 + c];
            Bbr[p * 16 + c] = (fr_ * br - fi_ * bi) * gg; Bbi[p * 16 + c] = (fr_ * bi + fi_ * br) * gg; }
        float r = abr, i = abi; cmul(r, i, r, i); cmul(r, i, r, i); cmul(r, i, r, i);
        float qr = 1.f, qi = 0.f;
        for (int k = 0; k < q; ++k) cmul(qr, qi, r, i);
        Qr[p] = qr; Qi[p] = qi;
        if (q == 0) { A8[p] = r; A8[64 + p] = i; cmul(r, i, r, i); cmul(r, i, r, i); AL[p] = r; AL[64 + p] = i; }
    }
    for (int e = tid; e < 1024; e += 512) { Cr[e] = F.in[I_CRE][g * 1024 + e]; Ci[e] = F.in[I_CIM][g * 1024 + e]; }
    __syncthreads();
    if (tid < 256) {
        const int c = tid >> 4, cp = tid & 15;
        float acc[8];
#pragma unroll
        for (int t = 0; t < 8; ++t) acc[t] = 0.f;
        for (int p = 0; p < 64; ++p) {
            const float cr = Cr[c * 64 + p], ci = Ci[c * 64 + p], br = Bbr[p * 16 + cp], bi = Bbi[p * 16 + cp], ar = Ar[p], ai = Ai[p];
            float mr = cr * br - ci * bi, mi = cr * bi + ci * br; cmul(mr, mi, Qr[p], Qi[p]);
#pragma unroll
            for (int t = 0; t < 8; ++t) { acc[t] += mr; cmul(mr, mi, ar, ai); }
        }
        if (q == 0 && c == cp) acc[0] += F.in[I_SD][g * 16 + c] * gn[g * 16 + c];
#pragma unroll
        for (int t = 0; t < 8; ++t) KT[(8 * q + t) * 256 + tid] = (bf16)f2bf(acc[t]);
    }
    {
        const int p = tid & 63, j = tid >> 6, sidx = 31 - 8 * q - j; const float ar = Ar[p], ai = Ai[p];
        float pr = Qr[p], pi = Qi[p];
        for (int k = 0; k < j; ++k) cmul(pr, pi, ar, ai);
        float wre[16], wim[16];
#pragma unroll
        for (int cp = 0; cp < 16; ++cp) { const float br = Bbr[p * 16 + cp], bi = Bbi[p * 16 + cp]; wre[cp] = pr * br - pi * bi; wim[cp] = pr * bi + pi * br; }
        v4u o;
        o.x = pk2(wre[0], wre[1]); o.y = pk2(wre[2], wre[3]); o.z = pk2(wre[4], wre[5]); o.w = pk2(wre[6], wre[7]); *(v4u*)(WE + (size_t)p * 512 + 16 * sidx) = o;
        o.x = pk2(wre[8], wre[9]); o.y = pk2(wre[10], wre[11]); o.z = pk2(wre[12], wre[13]); o.w = pk2(wre[14], wre[15]); *(v4u*)(WE + (size_t)p * 512 + 16 * sidx + 8) = o;
        o.x = pk2(wim[0], wim[1]); o.y = pk2(wim[2], wim[3]); o.z = pk2(wim[4], wim[5]); o.w = pk2(wim[6], wim[7]); *(v4u*)(WE + (size_t)(64 + p) * 512 + 16 * sidx) = o;
        o.x = pk2(wim[8], wim[9]); o.y = pk2(wim[10], wim[11]); o.z = pk2(wim[12], wim[13]); o.w = pk2(wim[14], wim[15]); *(v4u*)(WE + (size_t)(64 + p) * 512 + 16 * sidx + 8) = o;
    }
    {
        const int p = tid & 63, cq = tid >> 6; const float ar = Ar[p], ai = Ai[p];
        float pr = Qr[p], pi = Qi[p]; cmul(pr, pi, ar, ai);
        for (int j = 0; j < 8; ++j) { const int t = 8 * q + j;
#pragma unroll
            for (int k = 0; k < 2; ++k) { const int c = 2 * cq + k; const float cr = Cr[c * 64 + p], ci = Ci[c * 64 + p];
                VI[(size_t)(16 * t + c) * 128 + p] = (bf16)f2bf(cr * pr - ci * pi); VI[(size_t)(16 * t + c) * 128 + 64 + p] = (bf16)f2bf(-(cr * pi + ci * pr)); }
            cmul(pr, pi, ar, ai);
        }
    }
    __syncthreads();
}
__device__ __forceinline__ void s5_tables(Frame& F) { for (int u = blockIdx.x; u < 256; u += gridDim.x) s5_tables_part(F, u >> 2, u & 3, (LAS float*)F.lds); }

__device__ __forceinline__ bf16x8 s5_ufrag(const bf16* XG, const float* ss, int row, int col) {
    const v4u w = *(const v4u*)(XG + ((size_t)(col >> 4) * M + row) * 16 + (col & 15)); const float rs = rsqrtf(ss[row] * (1.f / DM) + EPS);
    v4u o; o.x = cvt_pk(__uint_as_float(w.x << 16) * rs, __uint_as_float(w.x & 0xffff0000u) * rs); o.y = cvt_pk(__uint_as_float(w.y << 16) * rs, __uint_as_float(w.y & 0xffff0000u) * rs);
    o.z = cvt_pk(__uint_as_float(w.z << 16) * rs, __uint_as_float(w.z & 0xffff0000u) * rs); o.w = cvt_pk(__uint_as_float(w.w << 16) * rs, __uint_as_float(w.w & 0xffff0000u) * rs);
    return __builtin_bit_cast(bf16x8, o);
}
__device__ __forceinline__ bf16x8 ldfrag(const bf16* p) { return *(const bf16x8*)p; }
__device__ __forceinline__ void s5_store_z(bf16* Z, const f32x16& y, size_t row_t0, int g, int h) {
#pragma unroll
    for (int q = 0; q < 4; ++q) { v2u w; w.x = cvt_pk(gelu_tanh_div(y[4 * q]), gelu_tanh_div(y[4 * q + 1])); w.y = cvt_pk(gelu_tanh_div(y[4 * q + 2]), gelu_tanh_div(y[4 * q + 3]));
        *(v2u*)(Z + (row_t0 + (q >> 1)) * DM + g * 16 + 8 * (q & 1) + 4 * h) = w; }
}

constexpr int S5_EP = 65;
constexpr int S5_HP = 136;
constexpr int S5_XP = 1040;
constexpr int S5_LE = 0, S5_LH = 128 * S5_EP * 4, S5_LX = S5_LH + 64 * S5_HP * 2, S5_LK = S5_LX + 64 * S5_XP, S5_LEND = S5_LK + 16384;
static_assert(S5_LEND <= MISC_OFF, "S5 LDS map");
__device__ __forceinline__ void s5_prompt_unit(Frame& F, int b, int g, const bf16* XG, const float* ss) {
    LAS float* E = (LAS float*)(F.lds + S5_LE); LAS bf16* Hp = (LAS bf16*)(F.lds + S5_LH); LAS unsigned char* xs = F.lds + S5_LX; LAS unsigned char* kt = F.lds + S5_LK;
    const int w = F.wave;
    const bf16* KT = (const bf16*)(F.ws + WS_S5K) + (size_t)g * 32 * 256; const bf16* WE = (const bf16*)(F.ws + WS_S5W) + (size_t)g * 128 * 512; const bf16* VI = (const bf16*)(F.ws + WS_S5V) + (size_t)g * 512 * 128;
    const float* AL = (const float*)(F.ws + WS_S5A) + (size_t)g * 128;
    bf16* Z = (bf16*)(F.ws + WS_Z);
    float hr = 0.f, hi = 0.f, alr = 0.f, ali = 0.f;
    if (w == 0) { alr = AL[F.lane]; ali = AL[64 + F.lane]; }
    const int cb = w >> 2, rq = w & 3;
    __syncthreads();
    { const int tid = F.tid; const v4u* src = (const v4u*)KT; LAS v4u* dst = (LAS v4u*)kt; dst[tid] = src[tid]; dst[tid + 512] = src[tid + 512]; }
    v4u xv[8]; float rv[8];
    { const int tid = F.tid; const bf16* xsrc = XG + ((size_t)g * M + (size_t)b * SEQ) * 16;
#pragma unroll
      for (int k = 0; k < 8; ++k) { const int e = tid + 512 * k; xv[k] = *(const v4u*)(xsrc + (size_t)e * 8); rv[k] = ss[b * SEQ + (e >> 1)]; } }
    for (int seg = 0; seg < 4; ++seg) {
        int lane_ = F.lane; asm volatile("" : "+v"(lane_));
        const int lane = lane_ & 63, tid = w * 64 + lane, h = lane >> 5, c31 = lane & 31;
        const int srow0 = b * SEQ + seg * 2048;
        bf16x8 wfr[32];
        { const bf16* wp = WE + (size_t)(32 * rq + c31) * 512 + 8 * h;
#pragma unroll
          for (int s = 0; s < 32; ++s) wfr[s] = ldfrag(wp + 16 * s); }
        {
#pragma unroll
            for (int k = 0; k < 8; ++k) { const int e = tid + 512 * k, tok = e >> 1; const float rs = rsqrtf(rv[k] * (1.f / DM) + EPS); const v4u w4 = xv[k];
                v4u o; o.x = cvt_pk(__uint_as_float(w4.x << 16) * rs, __uint_as_float(w4.x & 0xffff0000u) * rs); o.y = cvt_pk(__uint_as_float(w4.y << 16) * rs, __uint_as_float(w4.y & 0xffff0000u) * rs);
                o.z = cvt_pk(__uint_as_float(w4.z << 16) * rs, __uint_as_float(w4.z & 0xffff0000u) * rs); o.w = cvt_pk(__uint_as_float(w4.w << 16) * rs, __uint_as_float(w4.w & 0xffff0000u) * rs);
                *(LAS v4u*)(xs + (tok >> 5) * S5_XP + (tok & 31) * 32 + (e & 1) * 16) = o; }
        }
        __syncthreads();
        LAS const unsigned char* xl = xs + (32 * cb + c31) * S5_XP + 16 * h;
        const int row0 = srow0 + (32 * cb + c31) * S5L;
        {
            f32x16 acc;
#pragma unroll
            for (int i = 0; i < 16; ++i) acc[i] = 0.f;
#pragma unroll
            for (int s = 0; s < 32; ++s) acc = __builtin_amdgcn_mfma_f32_32x32x16_bf16(wfr[s], *(LAS const bf16x8*)(xl + 32 * s), acc, 0, 0, 0);
#pragma unroll
            for (int i = 0; i < 16; ++i) E[(32 * rq + (i & 3) + 8 * (i >> 2) + 4 * h) * S5_EP + 32 * cb + c31] = acc[i];
        }
        __syncthreads();
        if (w == 0) {
            for (int j0 = 0; j0 < 64; j0 += 8) {
                float er[8], ei[8];
#pragma unroll
                for (int j = 0; j < 8; ++j) { er[j] = E[lane * S5_EP + j0 + j]; ei[j] = E[(64 + lane) * S5_EP + j0 + j]; }
#pragma unroll
                for (int j = 0; j < 8; ++j) {
                    Hp[(j0 + j) * S5_HP + lane] = (bf16)f2bf(hr); Hp[(j0 + j) * S5_HP + 64 + lane] = (bf16)f2bf(hi);
                    cmul(hr, hi, alr, ali); hr += er[j]; hi += ei[j];
                }
            }
        }
        __syncthreads();
        if (seg < 3) {
            const bf16* xsrc = XG + ((size_t)g * M + srow0 + 2048) * 16;
#pragma unroll
            for (int k = 0; k < 8; ++k) { const int e = tid + 512 * k; xv[k] = *(const v4u*)(xsrc + (size_t)e * 8); rv[k] = ss[srow0 + 2048 + (e >> 1)]; }
        }
        {
            f32x16 acc[4];
#pragma unroll
            for (int i4 = 0; i4 < 4; ++i4)
#pragma unroll
                for (int i = 0; i < 16; ++i) acc[i4][i] = 0.f;
            const int tin = c31 >> 4, cc = c31 & 15;
            bf16x8 vi[4][4];
#pragma unroll
            for (int ks = 0; ks < 4; ++ks)
#pragma unroll
                for (int i4 = 0; i4 < 4; ++i4) vi[ks][i4] = ldfrag(VI + (size_t)(32 * (rq + 4 * i4) + c31) * 128 + 16 * ks + 8 * h);
#pragma unroll 4
            for (int s = 0; s < 32; ++s) {
                const bf16x8 uf = *(LAS const bf16x8*)(xl + 32 * s);
#pragma unroll
                for (int i4 = 0; i4 < 4; ++i4) { const int tau = 2 * (rq + 4 * i4) + tin - s;
                    if (s <= 2 * (rq + 4 * i4) + 1) {
                        bf16x8 a = *(LAS const bf16x8*)(kt + (tau < 0 ? 0 : tau) * 512 + cc * 32 + 16 * h);
                        if (tau < 0) a = (bf16x8){0, 0, 0, 0, 0, 0, 0, 0};
                        acc[i4] = __builtin_amdgcn_mfma_f32_32x32x16_bf16(a, uf, acc[i4], 0, 0, 0); } }
            }
#pragma unroll
            for (int ks = 0; ks < 4; ++ks) {
                const bf16x8 hf = *(LAS const bf16x8*)(Hp + (32 * cb + c31) * S5_HP + 16 * ks + 8 * h);
#pragma unroll
                for (int i4 = 0; i4 < 4; ++i4) acc[i4] = __builtin_amdgcn_mfma_f32_32x32x16_bf16(vi[ks][i4], hf, acc[i4], 0, 0, 0);
            }
#pragma unroll
            for (int ks = 0; ks < 4; ++ks)
#pragma unroll
                for (int i4 = 0; i4 < 4; ++i4) vi[ks][i4] = ldfrag(VI + (size_t)(32 * (rq + 4 * i4) + c31) * 128 + 16 * (ks + 4) + 8 * h);
#pragma unroll
            for (int ks = 0; ks < 4; ++ks) {
                const bf16x8 hf = *(LAS const bf16x8*)(Hp + (32 * cb + c31) * S5_HP + 16 * (ks + 4) + 8 * h);
#pragma unroll
                for (int i4 = 0; i4 < 4; ++i4) acc[i4] = __builtin_amdgcn_mfma_f32_32x32x16_bf16(vi[ks][i4], hf, acc[i4], 0, 0, 0);
            }
#pragma unroll
            for (int i4 = 0; i4 < 4; ++i4) s5_store_z(Z, acc[i4], (size_t)row0 + 2 * (rq + 4 * i4), g, h);
        }
        __syncthreads();
    }
    if (w == 0) { F.out[O_SREP + ((size_t)b * 64 + g) * 64 + F.lane] = hr; F.out[O_SIMP + ((size_t)b * 64 + g) * 64 + F.lane] = hi; }
}

__device__ __forceinline__ void s5_sample_unit(Frame& F, int g, int cb, const bf16* XB, const float* ss) {
    const int lane = F.lane, h = lane >> 5, c31 = lane & 31, seq = 32 * cb + c31;
    const bf16* KT = (const bf16*)(F.ws + WS_S5K) + (size_t)g * 32 * 256; const bf16* WE = (const bf16*)(F.ws + WS_S5W) + (size_t)g * 128 * 512; const bf16* VI = (const bf16*)(F.ws + WS_S5V) + (size_t)g * 512 * 128;
    const float* A8 = (const float*)(F.ws + WS_S5A) + 64 * 128 + (size_t)g * 128;
    bf16* Z = (bf16*)(F.ws + WS_Z);
    const int row0 = MP + seq * DS;
    bf16x8 uf[8];
#pragma unroll
    for (int s = 0; s < 8; ++s) uf[s] = s5_ufrag(XB, ss, row0 + s, g * 16 + 8 * h);
    const float* h0r = F.in[I_SRE] + ((size_t)seq * 64 + g) * 64; const float* h0i = F.in[I_SIM] + ((size_t)seq * 64 + g) * 64;
    {
        f32x16 acc[4];
#pragma unroll
        for (int rb = 0; rb < 4; ++rb)
#pragma unroll
            for (int i = 0; i < 16; ++i) acc[rb][i] = 0.f;
        const int tin = c31 >> 4, cc = c31 & 15;
#pragma unroll
        for (int s = 0; s < 8; ++s)
#pragma unroll
            for (int rb = 0; rb < 4; ++rb) if (s <= 2 * rb + 1) { const int tau = 2 * rb + tin - s;
                bf16x8 a = ldfrag(KT + (size_t)(tau < 0 ? 0 : tau) * 256 + cc * 16 + 8 * h); if (tau < 0) a = (bf16x8){0, 0, 0, 0, 0, 0, 0, 0};
                acc[rb] = __builtin_amdgcn_mfma_f32_32x32x16_bf16(a, uf[s], acc[rb], 0, 0, 0); }
#pragma unroll
        for (int ks = 0; ks < 8; ++ks) {
            const float* hp = (ks < 4 ? h0r : h0i) + 16 * (ks & 3) + 8 * h;
            const f32x4 x0 = ld4(hp), x1 = ld4(hp + 4);
            v4u o; o.x = cvt_pk(x0[0], x0[1]); o.y = cvt_pk(x0[2], x0[3]); o.z = cvt_pk(x1[0], x1[1]); o.w = cvt_pk(x1[2], x1[3]);
            const bf16x8 hf = __builtin_bit_cast(bf16x8, o);
#pragma unroll
            for (int rb = 0; rb < 4; ++rb) acc[rb] = __builtin_amdgcn_mfma_f32_32x32x16_bf16(ldfrag(VI + (size_t)(32 * rb + c31) * 128 + 16 * ks + 8 * h), hf, acc[rb], 0, 0, 0);
        }
#pragma unroll
        for (int rb = 0; rb < 4; ++rb) s5_store_z(Z, acc[rb], (size_t)row0 + 2 * rb, g, h);
    }
    {
        f32x16 acc[4];
#pragma unroll
        for (int rb = 0; rb < 4; ++rb)
#pragma unroll
            for (int i = 0; i < 16; ++i) acc[rb][i] = 0.f;
#pragma unroll
        for (int s = 0; s < 8; ++s)
#pragma unroll
            for (int rb = 0; rb < 4; ++rb) acc[rb] = __builtin_amdgcn_mfma_f32_32x32x16_bf16(ldfrag(WE + (size_t)(32 * rb + c31) * 512 + 16 * (24 + s) + 8 * h), uf[s], acc[rb], 0, 0, 0);
        float* ore = F.out + O_SRES + ((size_t)seq * 64 + g) * 64; float* oim = F.out + O_SIMS + ((size_t)seq * 64 + g) * 64;
#pragma unroll
        for (int rb = 0; rb < 2; ++rb)
#pragma unroll
            for (int i = 0; i < 16; ++i) { const int p = 32 * rb + (i & 3) + 8 * (i >> 2) + 4 * h;
                const float xr = h0r[p], xi = h0i[p], ar = A8[p], ai = A8[64 + p];
                ore[p] = acc[rb][i] + (ar * xr - ai * xi); oim[p] = acc[rb + 2][i] + (ar * xi + ai * xr); }
    }
}

__device__ __forceinline__ void s5_phase_v2(Frame& F) {
    const bf16* XB = (const bf16*)(F.ws + WS_XG); const float* ss = F.SS(3);
    const int G = gridDim.x, bid = blockIdx.x;
    const int npw = (G >= 256) ? 128 : G;
    if (bid < npw) { for (int u = bid; u < NB * 64; u += npw) s5_prompt_unit(F, u >> 6, u & 63, XB, ss); }
    const int ws0 = (G >= 256) ? 128 : 0, nsw = (G - ws0) * NWAVES;
    if (bid >= ws0) { for (int u = (bid - ws0) * NWAVES + F.wave; u < 64 * 4; u += nsw) s5_sample_unit(F, u >> 2, u & 3, XB, ss); }
}
#ifndef MK_ONE_LAUNCH
#define MK_ONE_LAUNCH 0
#endif
constexpr int N_PHASES = 17;
#define GP(EPI) pg8::gemm_phase<EPI, pg8::StaticOrder, true, true>
#define REFRESH() do { F.lane = mk_lane(); F.tid = F.wave * 64 + F.lane; } while (0)

__global__ void __launch_bounds__(NWAVES * 64, 2) nsa_s5_fwd(Args args) {
    extern __shared__ __attribute__((aligned(16))) unsigned char lds[];
    Frame F;
    F.lds = (LAS unsigned char*)lds;
    F.wave = __builtin_amdgcn_readfirstlane((int)(threadIdx.x >> 6)); F.lane = mk_lane(); F.tid = F.wave * 64 + F.lane;
    F.gw = blockIdx.x * NWAVES + F.wave; F.NGW = gridDim.x * NWAVES;
    F.ws = args.ws; F.out = args.out; F.in = args.in; F.pt = args.page_table;
    volatile LAS unsigned* MISC = (volatile LAS unsigned*)(F.lds + MISC_OFF);
    if (F.tid < 64) MISC[F.tid] = 0u;
    __syncthreads();
#if MK_ONE_LAUNCH
    XcdBarrier bar = xcd_barrier_post((unsigned*)(F.ws + WS_CTL) + CW_BAR, MISC + 8, (unsigned)F.wave);
#define GRID_BAR() xcd_barrier(bar)
#else
#define GRID_BAR() do {} while (0)
#endif
    const int lo = args.ph_lo, hi = args.ph_hi;
#ifndef PHMASK
#define PHMASK 0x1ffff
#endif
#define IN(k) ((((PHMASK) >> (k)) & 1) && lo <= (k) && (k) < hi)
#define SEAM(k) do { if (IN(k) && IN((k) + 1)) GRID_BAR(); } while (0)
    unsigned char* ws = F.ws;
    LAS unsigned char* ring = F.lds;
    const int G = gridDim.x, cid = blockIdx.x;

    const bool split1 = (G == 256); const int j1 = cid >> 3; const bool streamer = split1 && (j1 & 1) == 0;
    const int G1 = split1 ? 128 : G, c1 = split1 ? ((j1 >> 1) * 8 + (cid & 7)) : cid;
    if (IN(0)) { REFRESH(); p0_prologue(F); if (!split1) p0_stream(F, F.gw, F.NGW, 0, DB * PAST, true); SEAM(0); }

    if (IN(1)) {
        if (streamer) { REFRESH(); p0_stream(F, c1 * NWAVES + F.wave, 128 * NWAVES, 0, DB * PAST / 16 * 15, true); }
        else {
        { pg8::Gemm g{(const bf16*)(ws + WS_XBA), (const bf16*)(ws + WS_WIN_T), M, NINP, DM}; pg8::StaticOrder S; S.init(M, NINP, G1, c1);
          EpiAttnIn E{ws, F.out};
          GP(EpiAttnIn)(ring, g, S, E, F.wave); }
        { int kp = PLE; asm volatile("" : "+s"(kp));
          { pg8::Gemm g{(const bf16*)(ws + WS_PB0), (const bf16*)(ws + WS_WP_T0), MP, DM, kp}; pg8::StaticOrder S; S.init(MP, DM, G1, c1);
            EpiPlain E{(bf16*)(ws + WS_PP0), DM}; GP(EpiPlain)(ring, g, S, E, F.wave); }
          REFRESH(); sample_plain_sub(F, (const bf16*)(ws + WS_PB0), PLE, (const bf16*)(ws + WS_WP_T0), kp, (bf16*)(ws + WS_PP0), c1, G1); }
          if (split1) { REFRESH(); p0_stream(F, c1 * NWAVES + F.wave, 128 * NWAVES, DB * PAST / 16 * 15, DB * PAST, false); }
        }
        SEAM(1);
    }
    if (IN(2)) {
        REFRESH(); sample_cmp_pages(F);
        REFRESH(); prompt_cmp(F);
        SEAM(2);
    }
    if (IN(3)) { REFRESH(); cmp_finalize(F); s5_tables(F); SEAM(3); }
    if (IN(4)) { REFRESH(); attn_phase_v2(F); SEAM(4); }
    if (IN(5)) {
        pg8::Gemm g{(const bf16*)(ws + WS_OB), (const bf16*)(ws + WS_WOUT_T), MP, DM, DM}; pg8::StaticOrder S; S.init(MP, DM, G, cid);
        EpiResid E{(const bf16*)(ws + WS_XBA), (bf16*)(ws + WS_XBB), F.SS(1)};
        GP(EpiResid)(ring, g, S, E, F.wave);
        REFRESH(); sample_resid(F, (const bf16*)(ws + WS_OB), DM, (const bf16*)(ws + WS_WOUT_T), DM, (const bf16*)(ws + WS_XBA), (bf16*)(ws + WS_XBB), F.SS(1));
        SEAM(5);
    }
#define LAYER_BODY(layer) do { \
        const int pb = layer ? 12 : 6; \
        bf16* xb_up = (bf16*)(ws + (layer ? WS_XBA : WS_XBB)); \
        bf16* xb_dn = (bf16*)(ws + (layer ? WS_XBB : WS_XBA)); \
        if (layer == 1) { \
            if (IN(10)) { REFRESH(); s5_phase_v2(F); \
                if (G >= 256 && cid >= 128) {     \
                    int kp = PLE; asm volatile("" : "+s"(kp)); \
                    pg8::Gemm g{(const bf16*)(ws + WS_PB1), (const bf16*)(ws + WS_WP_T1), MP, DM, kp}; pg8::StaticOrder S; S.init(MP, DM, 128, cid - 128); \
                    EpiPlain E{(bf16*)(ws + WS_PP1), DM}; GP(EpiPlain)(ring, g, S, E, F.wave); \
                    REFRESH(); sample_plain_sub(F, (const bf16*)(ws + WS_PB1), PLE, (const bf16*)(ws + WS_WP_T1), kp, (bf16*)(ws + WS_PP1), cid - 128, 128); \
                    REFRESH(); p0_weights<1>(F, (cid - 128) * NWAVES + F.wave, 128 * NWAVES); \
                } else if (G < 256) { \
                    int kp = PLE; asm volatile("" : "+s"(kp)); \
                    pg8::Gemm g{(const bf16*)(ws + WS_PB1), (const bf16*)(ws + WS_WP_T1), MP, DM, kp}; pg8::StaticOrder S; S.init(MP, DM, G, cid); \
                    EpiPlain E{(bf16*)(ws + WS_PP1), DM}; GP(EpiPlain)(ring, g, S, E, F.wave); \
                    REFRESH(); sample_plain_sub(F, (const bf16*)(ws + WS_PB1), PLE, (const bf16*)(ws + WS_WP_T1), kp, (bf16*)(ws + WS_PP1), cid, G); \
                    REFRESH(); p0_weights<1>(F, F.gw, F.NGW); \
                } \
                SEAM(10); } \
            if (IN(11)) { \
                pg8::Gemm g{(const bf16*)(ws + WS_Z), (const bf16*)(ws + WS_WGLU_T), MP, 2 * DM, DM}; pg8::StaticOrder S; S.init(MP, 2 * DM, G, cid); \
                EpiGlu E{xb_dn, xb_up, F.SS(4)}; \
                GP(EpiGlu)(ring, g, S, E, F.wave); \
                REFRESH(); sample_glu(F, (const bf16*)(ws + WS_Z), (const bf16*)(ws + WS_WGLU_T), xb_dn, xb_up, F.SS(4)); \
                SEAM(11); \
            } \
        } \
        if (IN(pb)) { \
            pg8::Gemm g{xb_up, (const bf16*)(ws + (layer ? WS_WUP_T1 : WS_WUP_T0)), M, 2 * FF, DM}; pg8::StaticOrder S; S.init(M, 2 * FF, G, cid); \
            EpiUpFused E{ws, F.out, F.in[I_CONVW] + (size_t)layer * 3 * FF, F.in[I_CONVB] + (size_t)layer * FF, F.in[I_SCONV] + (size_t)layer * DB * 2 * FF, layer, F.lds}; \
            GP(EpiUpFused)(ring, g, S, E, F.wave); \
            SEAM(pb); \
        } \
        if (IN(pb + 2)) { \
            pg8::Gemm g{(const bf16*)(ws + WS_ACT), (const bf16*)(ws + (layer ? WS_WDN_T1 : WS_WDN_T0)), MP, DM, FF}; pg8::StaticOrder S; S.init(MP, DM, G, cid); \
            { REFRESH(); pg8::Unit uu; for (int i = 0; S.next(i, uu); ++i) { if (uu.pm < MP / 256 && (uu.pm & 31) != 0) up_fix(ws, F.in[I_CONVW] + (size_t)layer * 3 * FF, F.in[I_CONVB] + (size_t)layer * FF, uu.pm, F.tid); } \
              VM_WAIT(); __syncthreads(); } \
            EpiResid E{xb_up, xb_dn, F.SS(layer ? 5 : 2)}; \
            GP(EpiResid)(ring, g, S, E, F.wave); \
            REFRESH(); sample_resid(F, (const bf16*)(ws + WS_ACT), FF, (const bf16*)(ws + (layer ? WS_WDN_T1 : WS_WDN_T0)), FF, xb_up, xb_dn, F.SS(layer ? 5 : 2)); \
            SEAM(pb + 2); \
        } \
        if (IN(pb + 3)) { \
            pg8::Gemm g{xb_dn, (const bf16*)(ws + (layer ? WS_WG_T1 : WS_WG_T0)), MP, DM, DM}; pg8::StaticOrder S; S.init(MP, DM, G, cid); \
            EpiGate E{F.SS(layer ? 5 : 2), (const bf16*)(ws + (layer ? WS_PP1 : WS_PP0)), xb_dn, xb_up, F.SS(layer ? 6 : 3), layer ? (bf16*)nullptr : (bf16*)(ws + WS_XG)}; \
            GP(EpiGate)(ring, g, S, E, F.wave); \
            REFRESH(); sample_gate(F, xb_dn, (const bf16*)(ws + (layer ? WS_WG_T1 : WS_WG_T0)), F.SS(layer ? 5 : 2), (const bf16*)(ws + (layer ? WS_PP1 : WS_PP0)), xb_dn, xb_up, layer ? (bf16*)nullptr : (bf16*)(ws + WS_XG), F.SS(layer ? 6 : 3)); \
            SEAM(pb + 3); \
        } \
    } while (0)
    LAYER_BODY(0);
    LAYER_BODY(1);
#undef LAYER_BODY
    if (IN(16)) { REFRESH(); final_norm(F); }
#undef IN
#undef SEAM
}

extern "C" void kernel_launch(void* const* d_in, const int* in_sizes, int n_in, void* d_out, int out_size, void* d_ws, size_t ws_size, hipStream_t stream) {
    static int grid = 0;
    if (grid == 0) {
        if (n_in != 34 || out_size != (int)O_END || ws_size < WS_END) { fprintf(stderr, "kernel_launch: unexpected sizes n_in %d out %d ws %zu\n", n_in, out_size, ws_size); grid = -1; return; }
        int dev = 0, cus = 0, per_cu = 0;
        if (hipGetDevice(&dev) != hipSuccess || hipDeviceGetAttribute(&cus, hipDeviceAttributeMultiprocessorCount, dev) != hipSuccess) { grid = -1; return; }
        if (hipFuncSetAttribute((const void*)nsa_s5_fwd, hipFuncAttributeMaxDynamicSharedMemorySize, LDS_BYTES) != hipSuccess) { fprintf(stderr, "kernel_launch: hipFuncSetAttribute failed\n"); grid = -1; return; }
        if (hipOccupancyMaxActiveBlocksPerMultiprocessor(&per_cu, (const void*)nsa_s5_fwd, NWAVES * 64, LDS_BYTES) != hipSuccess || per_cu < 1)
            fprintf(stderr, "kernel_launch: occupancy query reports %d blocks per CU\n", per_cu);
        (void)hipGetLastError();
        grid = cus;
    }
    if (grid < 0) return;
    (void)hipMemsetAsync((char*)d_ws + WS_CTL, 0, CTL_ZERO_BYTES, stream);
    Args a{};
    for (int i = 0; i < 34; ++i) a.in[i] = (const float*)d_in[i];
    a.page_table = (const int*)d_in[I_PT]; a.out = (float*)d_out; a.ws = (unsigned char*)d_ws;
#if MK_ONE_LAUNCH
    a.ph_lo = 0; a.ph_hi = N_PHASES;
    hipLaunchKernelGGL(nsa_s5_fwd, dim3(grid), dim3(NWAVES * 64), LDS_BYTES, stream, a);
#else
    for (int p = 0; p < N_PHASES; ++p) { a.ph_lo = p; a.ph_hi = p + 1; hipLaunchKernelGGL(nsa_s5_fwd, dim3(grid), dim3(NWAVES * 64), LDS_BYTES, stream, a); }
#endif
}
```

```cpp
#include <hip/hip_runtime.h>
#include <cstdio>
#include <cstdint>

#define GAS __attribute__((address_space(1)))
#define LAS __attribute__((address_space(3)))
typedef unsigned short bf16;
typedef unsigned v4u __attribute__((ext_vector_type(4)));
typedef unsigned v2u __attribute__((ext_vector_type(2)));
typedef float f32x4 __attribute__((ext_vector_type(4)));
typedef float f32x2 __attribute__((ext_vector_type(2)));
typedef short bf16x8 __attribute__((ext_vector_type(8)));
typedef float f32x16 __attribute__((ext_vector_type(16)));

constexpr int DM = 1024, SEQ = 8192, NB = 2, MP = NB * SEQ  , DB = 128, DS = 8, MS = DB * DS  , M = MP + MS  ;
constexpr int PAST = 2048, PAGE = 128, NPAGES = PAST / PAGE  ;
constexpr int NH = 16, HD = 64, NG = 4;
constexpr int NIN = 2608, NINP = 2816;
constexpr int FF = 2816, PLE = 256;
constexpr int NCP = 511, NCS = 127;
constexpr int NSP = 128, NSS = 33;
constexpr float EPS = 1e-6f;
constexpr int CMP_ROWS_P = 2 * NB * 512 * NG;
constexpr int CMP_ROWS_S = 2 * DB * 128 * NG;
constexpr int CMP_ROWS = CMP_ROWS_P + CMP_ROWS_S;

constexpr size_t MiB = 1u << 20;
constexpr size_t WS_CTL = 0, CTL_ZERO_BYTES = 2 * MiB;
constexpr size_t WS_WIN_T = 2 * MiB, WS_WOUT_T = 8 * MiB, WS_WUP_T0 = 10 * MiB, WS_WUP_T1 = 21 * MiB, WS_WDN_T0 = 32 * MiB, WS_WDN_T1 = 38 * MiB;
constexpr size_t WS_WP_T0 = 44 * MiB, WS_WP_T1 = 45 * MiB, WS_WG_T0 = 47 * MiB, WS_WG_T1 = 49 * MiB, WS_WGLU_T = 51 * MiB, WS_W1R_T = 55 * MiB, WS_CVEC = 55 * MiB + 768 * 1024, WS_S5TAB = 56 * MiB;
constexpr size_t WS_XBA = 64 * MiB, WS_XBB = 98 * MiB, WS_XR = 132 * MiB, WS_QB = 200 * MiB, WS_OB = 234 * MiB, WS_KVB = 268 * MiB, WS_WINB = 302 * MiB, WS_GATES = 319 * MiB;
constexpr size_t WS_KCP = 323 * MiB, WS_VCP = 323 * MiB + 512 * 1024, WS_KCS = 324 * MiB, WS_VCS = 332 * MiB, WS_CMPA = 340 * MiB, WS_PBUF = 612 * MiB;
constexpr size_t WS_HG = 680 * MiB, WS_ACT = 867 * MiB, WS_PB0 = 961 * MiB, WS_PB1 = 970 * MiB, WS_PP0 = 979 * MiB, WS_PP1 = 1013 * MiB, WS_Z = 1047 * MiB, WS_SELS = 1081 * MiB, WS_WINS = 1340 * MiB, WS_S5K = 1407 * MiB, WS_S5W = 1408 * MiB, WS_S5V = 1416 * MiB, WS_S5A = 1424 * MiB, WS_HALOA = 1425 * MiB, WS_HALOB = 1429 * MiB, WS_S5E = 1431 * MiB, WS_S5H = 1448 * MiB, WS_STASH = 1457 * MiB, WS_XG = 1474 * MiB, WS_END = 1509 * MiB;
constexpr int CW_TMO = 0, CW_BAR = 4096, CW_SS = 65536;
static_assert((CW_SS + 7 * M) * 4 <= (int)CTL_ZERO_BYTES, "ctl words inside the memset region");

constexpr int NWAVES = 8;
constexpr int RING_BYTES = 131072;
constexpr int WAVE_LDS = 18432;
constexpr int MISC_OFF = NWAVES * WAVE_LDS;
constexpr int LDS_BYTES = MISC_OFF + 256;

#define RLX_AGENT __ATOMIC_RELAXED, __HIP_MEMORY_SCOPE_AGENT
#define LDS_WAIT() asm volatile("s_waitcnt lgkmcnt(0)" ::: "memory")
#define VM_WAIT() asm volatile("s_waitcnt vmcnt(0)" ::: "memory")

__device__ __forceinline__ float bf2f(bf16 v) { return __uint_as_float(((unsigned)v) << 16); }
__device__ __forceinline__ unsigned f2bf(float f) { unsigned u = __builtin_bit_cast(unsigned, f); return (u + 0x7fffu + ((u >> 16) & 1u)) >> 16; }
__device__ __forceinline__ unsigned cvt_pk(float lo, float hi) { unsigned r; asm("v_cvt_pk_bf16_f32 %0, %1, %2" : "=v"(r) : "v"(lo), "v"(hi)); return r; }
__device__ __forceinline__ unsigned pk2(float lo, float hi) { return cvt_pk(lo, hi); }
__device__ __forceinline__ v4u pk8(f32x4 a, f32x4 b) { v4u w; w.x = pk2(a[0], a[1]); w.y = pk2(a[2], a[3]); w.z = pk2(b[0], b[1]); w.w = pk2(b[2], b[3]); return w; }
__device__ __forceinline__ float wave_sum(float v) {
#pragma unroll
    for (int o = 1; o < 64; o <<= 1) v += __shfl_xor(v, o);
    return v;
}
__device__ __forceinline__ float wave_max(float v) {
#pragma unroll
    for (int o = 1; o < 64; o <<= 1) v = fmaxf(v, __shfl_xor(v, o));
    return v;
}
__device__ __forceinline__ float sigmoidf_(float x) { return __builtin_amdgcn_rcpf(1.f + __builtin_amdgcn_exp2f(-1.4426950408889634f * x)); }
__device__ __forceinline__ float gelu_tanh(float x) { constexpr float K1 = -2.f * 0.7978845608028654f * 1.4426950408889634f, K2 = K1 * 0.044715f;
    const float t = x * __builtin_fmaf(x * x, K2, K1); return x * __builtin_amdgcn_rcpf(1.f + __builtin_amdgcn_exp2f(t)); }
__device__ __forceinline__ float gelu_tanh_div(float x) { const float y = 0.7978845608028654f * (x + 0.044715f * x * x * x); return x / (1.f + __expf(-2.f * y)); }
__device__ __forceinline__ f32x4 ld4(const float* p) { return *(const f32x4*)p; }
__device__ __forceinline__ void st4(float* p, f32x4 v) { *(f32x4*)p = v; }
constexpr size_t O_YP = 0, O_YS = O_YP + (size_t)MP * DM, O_KVP = O_YS + (size_t)MS * DM, O_KVS = O_KVP + (size_t)MP * 1024, O_WINP = O_KVS + (size_t)MS * 1024,
                 O_WINS = O_WINP + (size_t)NB * 512 * 512, O_SREP = O_WINS + (size_t)DB * 512 * 512, O_SIMP = O_SREP + NB * 64 * 64, O_SRES = O_SIMP + NB * 64 * 64,
                 O_SIMS = O_SRES + (size_t)DB * 64 * 64, O_CONVP = O_SIMS + (size_t)DB * 64 * 64, O_CONVS = O_CONVP + 2 * NB * 2 * FF, O_END = O_CONVS + (size_t)2 * DB * 2 * FF;
static_assert(O_END == 72259584, "output size");
__device__ __forceinline__ int mk_lane() { int l; asm volatile("v_mbcnt_lo_u32_b32 %0, -1, 0\n\tv_mbcnt_hi_u32_b32 %0, -1, %0" : "=v"(l)); return l & 63; }
__device__ __forceinline__ void unpk8(v4u w, f32x4& a, f32x4& b) { a[0] = __uint_as_float(w.x << 16); a[1] = __uint_as_float(w.x & 0xffff0000u); a[2] = __uint_as_float(w.y << 16); a[3] = __uint_as_float(w.y & 0xffff0000u);
    b[0] = __uint_as_float(w.z << 16); b[1] = __uint_as_float(w.z & 0xffff0000u); b[2] = __uint_as_float(w.w << 16); b[3] = __uint_as_float(w.w & 0xffff0000u); }
__device__ __forceinline__ v4u pk8c(f32x4 a, f32x4 b) { v4u w; w.x = cvt_pk(a[0], a[1]); w.y = cvt_pk(a[2], a[3]); w.z = cvt_pk(b[0], b[1]); w.w = cvt_pk(b[2], b[3]); return w; }
#define MK_ONE_LAUNCH 1
namespace pg8 {
#define PG8_LAS __attribute__((address_space(3)))
typedef unsigned short bf16_t;
typedef short bf16x8 __attribute__((ext_vector_type(8)));
typedef float f32x4 __attribute__((ext_vector_type(4)));
typedef unsigned u32x4 __attribute__((ext_vector_type(4)));
constexpr int BM = 256, BK = 64, HALF = 128, HTB = HALF * BK * 2  , STAGE_BYTES = 8 * HTB, NXCD = 8, WGM = 8;

__host__ __device__ __forceinline__ int lds_byte(int r, int c) { const int st = (r >> 4) * 2 + (c >> 5), rr = r & 15, cc = c & 31, ob = rr * 64 + cc * 2; return st * 1024 + (ob ^ (((ob >> 9) & 1) << 5)); }
__host__ __device__ __forceinline__ void stage_rc(int b, int& R, int& C) { const int st = b / 1024, sb = b % 1024, swz = sb ^ (((sb >> 9) & 1) << 5); R = (st >> 1) * 16 + swz / 64; C = (st & 1) * 32 + (swz % 64) / 2; }
__host__ __device__ __forceinline__ int perm32(int rho) { const int n = rho >> 4, i = rho & 15; return 8 * (i >> 2) + 4 * n + (i & 3); }

struct Unit { int pm, pn; };
struct Gemm { const bf16_t* A; const bf16_t* Bt; int M, N, K; };

struct StaticOrder {
    int nM, nN, nwg, G, c;
    __host__ __device__ void init(int M, int N, int G_, int c_) { nM = M / BM; nN = N / BM; nwg = nM * nN; G = G_; c = c_; }
    __host__ __device__ __forceinline__ bool next(int i, Unit& u) const {
        const long L = (long)i * G + c; if (L >= nwg) return false;
        int wgid = (int)L; { const int q = nwg / NXCD, r = nwg % NXCD, xcd = wgid % NXCD, off = wgid / NXCD; wgid = (xcd < r ? xcd * (q + 1) : r * (q + 1) + (xcd - r) * q) + off; }
        const int nig = WGM * nN, gid = wgid / nig, fm = gid * WGM, gsz = (nM - fm) < WGM ? (nM - fm) : WGM;
        u.pm = fm + ((wgid % nig) % gsz); u.pn = (wgid % nig) / gsz; return true;
    }
    __device__ __forceinline__ void a_ready(const Unit&) const {}
    __device__ __forceinline__ void done(const Unit&) const {}
};

__device__ __forceinline__ unsigned cvt_pk_bf16(float lo, float hi) { unsigned r; asm volatile("v_cvt_pk_bf16_f32 %0, %1, %2" : "=v"(r) : "v"(lo), "v"(hi)); return r; }
template <class Epi, class Sched, bool ALIGN_EPI = false, bool SP2 = false>
__device__ __forceinline__ void gemm_phase(PG8_LAS unsigned char* lds, const Gemm g, const Sched& S, const Epi& E, const int wid) {
    const int lane = mk_lane(), tid = wid * 64 + lane, wr = wid >> 2, wc = wid & 3, fr = lane & 15, fq = lane >> 4;
    const int K = g.K, nt = K / BK;
    unsigned voffA[2], voffB[2];
#pragma unroll
    for (int i = 0; i < 2; ++i) { int R, C; stage_rc(tid * 16 + i * 8192, R, C); const int Rb = Epi::PERM ? ((R & ~31) + perm32(R & 31)) : R;
        voffA[i] = (unsigned)(R * K + C) * 2u; voffB[i] = (unsigned)(Rb * K + C) * 2u; }
    const size_t kstep = (size_t)(BK * 2);
    const size_t hstep = (size_t)HALF * K * 2;
    const size_t tstep = 2 * hstep;
    const unsigned ldsw = (unsigned)wid * 1024u;
    const int aoff = lds_byte(wr * 64 + fr, fq * 8), boff = lds_byte(wc * 32 + fr, fq * 8);
#define PG8_SA(b, h) (((b) * 2 + (h)) * HTB)
#define PG8_SB(b, h) ((4 + (b) * 2 + (h)) * HTB)
#define PG8_STAGE(bufoff, gbase, voff) do { _Pragma("unroll") for (int _i = 0; _i < 2; ++_i) \
        __builtin_amdgcn_global_load_lds((const unsigned*)((const char*)(gbase) + (voff)[_i]), (PG8_LAS unsigned*)(lds + (bufoff) + ldsw + _i * 8192), 16, 0, 0); } while (0)
#define PG8_LDA(dst, b, h) do { _Pragma("unroll") for (int m = 0; m < 4; ++m) _Pragma("unroll") for (int k = 0; k < 2; ++k) dst[m][k] = *(const PG8_LAS bf16x8*)(lds + PG8_SA(b, h) + aoff + m * 2048 + k * 1024); } while (0)
#define PG8_LDB(dst, b, h) do { _Pragma("unroll") for (int n = 0; n < 2; ++n) _Pragma("unroll") for (int k = 0; k < 2; ++k) dst[n][k] = *(const PG8_LAS bf16x8*)(lds + PG8_SB(b, h) + boff + n * 2048 + k * 1024); } while (0)
#define PG8_MMA(ai, bj, At, Bt) do { __builtin_amdgcn_s_setprio(1); _Pragma("unroll") for (int m = 0; m < 4; ++m) _Pragma("unroll") for (int n = 0; n < 2; ++n) _Pragma("unroll") for (int k = 0; k < 2; ++k) \
        acc[ai][bj][m][n] = __builtin_amdgcn_mfma_f32_16x16x32_bf16(Bt[n][k], At[m][k], acc[ai][bj][m][n], 0, 0, 0); __builtin_amdgcn_s_setprio(0); } while (0)
#define PG8_WAIT_V(n) asm volatile("s_waitcnt vmcnt(" #n ")" ::: "memory")
#define PG8_WAIT_L(n) asm volatile("s_waitcnt lgkmcnt(" #n ")" ::: "memory")
#define PG8_BAR __builtin_amdgcn_s_barrier()
#define PG8_SCHED __builtin_amdgcn_sched_barrier(0)
    Unit cur, nxt; int ui = 0;
    if (!S.next(0, cur)) return;
    f32x4 acc[2][2][4][2];
#pragma unroll
    for (int a = 0; a < 2; ++a)
#pragma unroll
        for (int b = 0; b < 2; ++b)
#pragma unroll
            for (int m = 0; m < 4; ++m)
#pragma unroll
                for (int n = 0; n < 2; ++n) acc[a][b][m][n] = (f32x4){0.f, 0.f, 0.f, 0.f};
    bf16x8 At[4][2], B0[2][2], B1[2][2];
    const char* cA = (const char*)g.A + (size_t)cur.pm * tstep; const char* cB = (const char*)g.Bt + (size_t)cur.pn * tstep;
    S.a_ready(cur);
    if constexpr (SP2) {
        PG8_STAGE(PG8_SB(0, 0), cB, voffB); PG8_STAGE(PG8_SB(0, 1), cB + hstep, voffB); PG8_STAGE(PG8_SA(0, 0), cA, voffA); PG8_STAGE(PG8_SA(0, 1), cA + hstep, voffA);
        if (wr == 1) PG8_BAR;
        PG8_WAIT_V(2); PG8_BAR;
        PG8_STAGE(PG8_SB(1, 0), cB + kstep, voffB); PG8_STAGE(PG8_SA(1, 0), cA + kstep, voffA); PG8_STAGE(PG8_SB(1, 1), cB + hstep + kstep, voffB);
        PG8_WAIT_V(6); PG8_BAR;
    } else {
        PG8_STAGE(PG8_SB(0, 0), cB, voffB); PG8_STAGE(PG8_SA(0, 0), cA, voffA); PG8_STAGE(PG8_SB(0, 1), cB + hstep, voffB); PG8_STAGE(PG8_SA(0, 1), cA + hstep, voffA);
        if (wr == 1) PG8_BAR;
        PG8_WAIT_V(4); PG8_BAR;
        PG8_STAGE(PG8_SB(1, 0), cB + kstep, voffB); PG8_STAGE(PG8_SA(1, 0), cA + kstep, voffA); PG8_STAGE(PG8_SB(1, 1), cB + hstep + kstep, voffB);
        PG8_WAIT_V(6); PG8_BAR;
    }
    for (;;) {
        const bool has_next = S.next(ui + 1, nxt);
        const char* nA = has_next ? (const char*)g.A + (size_t)nxt.pm * tstep : cA; const char* nB = has_next ? (const char*)g.Bt + (size_t)nxt.pn * tstep : cB;
        for (int t = 0; t < nt; t += 2) {
            const bool last = (t == nt - 2);
            const char* a1 = cA + (size_t)(t + 1) * kstep;
            const char* a2 = last ? nA : cA + (size_t)(t + 2) * kstep; const char* b2 = last ? nB : cB + (size_t)(t + 2) * kstep;
            const char* a3 = a2 + kstep; const char* b3 = b2 + kstep;
            if (last && has_next) S.a_ready(nxt);
            if constexpr (SP2) {
            PG8_LDB(B0, 0, 0); PG8_LDB(B1, 0, 1); PG8_SCHED; PG8_LDA(At, 0, 0); PG8_STAGE(PG8_SA(1, 1), a1 + hstep, voffA);
            PG8_WAIT_V(8); PG8_WAIT_L(0); PG8_BAR; PG8_MMA(0, 0, At, B0); PG8_MMA(0, 1, At, B1); PG8_BAR; PG8_SCHED;
            PG8_LDA(At, 0, 1); PG8_STAGE(PG8_SB(0, 0), b2, voffB); PG8_STAGE(PG8_SB(0, 1), b2 + hstep, voffB); PG8_STAGE(PG8_SA(0, 0), a2, voffA);
            PG8_WAIT_V(8); PG8_WAIT_L(0); PG8_BAR; PG8_MMA(1, 0, At, B0); PG8_MMA(1, 1, At, B1); PG8_BAR; PG8_SCHED;
            PG8_LDB(B0, 1, 0); PG8_LDB(B1, 1, 1); PG8_SCHED; PG8_LDA(At, 1, 0); PG8_STAGE(PG8_SA(0, 1), a2 + hstep, voffA);
            PG8_WAIT_V(8); PG8_WAIT_L(0); PG8_BAR; PG8_MMA(0, 0, At, B0); PG8_MMA(0, 1, At, B1); PG8_BAR; PG8_SCHED;
            PG8_LDA(At, 1, 1); PG8_STAGE(PG8_SB(1, 0), b3, voffB); PG8_STAGE(PG8_SB(1, 1), b3 + hstep, voffB); PG8_STAGE(PG8_SA(1, 0), a3, voffA);
            PG8_WAIT_V(8); PG8_WAIT_L(0); PG8_BAR; PG8_MMA(1, 0, At, B0); PG8_MMA(1, 1, At, B1); PG8_BAR; PG8_SCHED;
            } else {
            PG8_LDB(B0, 0, 0); PG8_SCHED; PG8_LDA(At, 0, 0); PG8_STAGE(PG8_SA(1, 1), a1 + hstep, voffA);
            PG8_WAIT_L(8); PG8_BAR; PG8_WAIT_L(0); PG8_MMA(0, 0, At, B0); PG8_BAR; PG8_SCHED;
            PG8_LDB(B1, 0, 1); PG8_STAGE(PG8_SB(0, 0), b2, voffB);
            PG8_BAR; PG8_WAIT_L(0); PG8_MMA(0, 1, At, B1); PG8_BAR;
            PG8_LDA(At, 0, 1); PG8_STAGE(PG8_SA(0, 0), a2, voffA);
            PG8_BAR; PG8_WAIT_L(0); PG8_MMA(1, 0, At, B0); PG8_BAR; PG8_SCHED;
            PG8_STAGE(PG8_SB(0, 1), b2 + hstep, voffB);
            PG8_WAIT_V(6); PG8_BAR; PG8_MMA(1, 1, At, B1); PG8_BAR;
            PG8_LDB(B0, 1, 0); PG8_SCHED; PG8_LDA(At, 1, 0); PG8_STAGE(PG8_SA(0, 1), a2 + hstep, voffA);
            PG8_WAIT_L(8); PG8_BAR; PG8_WAIT_L(0); PG8_MMA(0, 0, At, B0); PG8_BAR; PG8_SCHED;
            PG8_LDB(B1, 1, 1); PG8_STAGE(PG8_SB(1, 0), b3, voffB);
            PG8_BAR; PG8_WAIT_L(0); PG8_MMA(0, 1, At, B1); PG8_BAR;
            PG8_LDA(At, 1, 1); PG8_STAGE(PG8_SA(1, 0), a3, voffA);
            PG8_BAR; PG8_WAIT_L(0); PG8_MMA(1, 0, At, B0); PG8_BAR; PG8_SCHED;
            PG8_STAGE(PG8_SB(1, 1), b3 + hstep, voffB);
            PG8_WAIT_V(6); PG8_BAR; PG8_MMA(1, 1, At, B1); PG8_BAR;
            }
        }
        if constexpr (ALIGN_EPI) { if (wr == 0) PG8_BAR; }
        if constexpr (!Epi::AFTER_DRAIN) { E(acc, cur, wr, wc, fr, fq); S.done(cur); }
        if (!has_next) break;
#pragma unroll
        for (int a = 0; a < 2; ++a)
#pragma unroll
            for (int b = 0; b < 2; ++b)
#pragma unroll
                for (int m = 0; m < 4; ++m)
#pragma unroll
                    for (int n = 0; n < 2; ++n) acc[a][b][m][n] = (f32x4){0.f, 0.f, 0.f, 0.f};
        cur = nxt; cA = nA; cB = nB; ++ui;
        if constexpr (ALIGN_EPI) { if (wr == 1) PG8_BAR; }
    }
    PG8_WAIT_V(0);
    if constexpr (!ALIGN_EPI) { if (wr == 0) PG8_BAR; }
    PG8_BAR;
    if constexpr (Epi::AFTER_DRAIN) { E.fused(acc, cur, wr, wc, fr, fq, lds, wid, lane); S.done(cur); }
#undef PG8_SA
#undef PG8_SB
#undef PG8_STAGE
#undef PG8_LDA
#undef PG8_LDB
#undef PG8_MMA
#undef PG8_WAIT_V
#undef PG8_WAIT_L
#undef PG8_BAR
#undef PG8_SCHED
}
}

#define XB_TMO      128
#define XB_XCNT(j)  (256  + 64 * (j))
#define XB_XSUB(j)  (1280 + 64 * (j))
#define XB_XGEN(j)  (2304 + 64 * (j))
#define XB_TOP      3328
#define XB_TOPGEN   3392
#define XCD_BAR_WORDS 3456
#define XB_SPIN_CAP (1u << 18)

__device__ __forceinline__ unsigned xb_ld(unsigned* p)              { return __hip_atomic_load(p, __ATOMIC_RELAXED, __HIP_MEMORY_SCOPE_AGENT); }
__device__ __forceinline__ unsigned xb_add(unsigned* p, unsigned v) { return __hip_atomic_fetch_add(p, v, __ATOMIC_RELAXED, __HIP_MEMORY_SCOPE_AGENT); }
__device__ __forceinline__ unsigned xb_xcc_id() { return (unsigned)__builtin_amdgcn_s_getreg((3 << 11) | 20) & 0xFu; }
#define XB_SPIN(cond, bar) do { unsigned _sp = 0; while (cond) { __builtin_amdgcn_s_sleep(1); \
    if ((++_sp & 255u) == 0u) { if (xb_ld(&(bar)[XB_TMO])) break; if (_sp > XB_SPIN_CAP) { atomicAdd(&(bar)[XB_TMO], 1u); break; } } } } while (0)

struct XcdBarrier {
    unsigned* bar; unsigned x; unsigned wid;
    volatile LAS unsigned* st;
};

__device__ __forceinline__ XcdBarrier xcd_barrier_post(unsigned* bar, volatile LAS unsigned* st, unsigned wid) {
    XcdBarrier b; b.bar = bar; b.x = xb_xcc_id(); b.st = st; b.wid = wid;
    if (wid == 0u && mk_lane() == 0) (void)xb_add(&bar[XB_XCNT(b.x)], 1u);
    return b;
}
__device__ __forceinline__ void xcd_barrier_complete(unsigned* bar, unsigned x, unsigned& nloc, unsigned& nx) {
    const unsigned G = gridDim.x * gridDim.y * gridDim.z;
    unsigned sum, cnt, mine, sp = 0u;
    for (;;) {
        sum = 0u; cnt = 0u; mine = 0u;
#pragma unroll
        for (unsigned j = 0; j < 16; ++j) { const unsigned c = xb_ld(&bar[XB_XCNT(j)]); sum += c; cnt += (c > 0u) ? 1u : 0u; mine = (j == x) ? c : mine; }
        if (sum == G) break;
        __builtin_amdgcn_s_sleep(1);
        if ((++sp & 255u) == 0u) { if (xb_ld(&bar[XB_TMO])) break; if (sp > XB_SPIN_CAP) { atomicAdd(&bar[XB_TMO], 1u); break; } }
    }
    nloc = mine > 0u ? mine : 1u; nx = cnt > 0u ? cnt : 1u;
}

__device__ __forceinline__ void xcd_barrier(const XcdBarrier& b) {
    asm volatile("s_waitcnt vmcnt(0)" ::: "memory");
    __syncthreads();
    if (b.wid == 0u && mk_lane() == 0) {
        unsigned* bar = b.bar;
        __builtin_amdgcn_s_waitcnt(0);
        unsigned nloc = b.st[0], nx = b.st[1];
        if (nloc == 0u) { xcd_barrier_complete(bar, b.x, nloc, nx); b.st[0] = nloc; b.st[1] = nx; }
        const unsigned old = xb_add(&bar[XB_XSUB(b.x)], 1u);
        const unsigned gen = old / nloc;
        if (old + 1u == (gen + 1u) * nloc) {
            __builtin_amdgcn_fence(__ATOMIC_RELEASE, "agent");
            asm volatile("s_waitcnt vmcnt(0)" ::: "memory");
            const unsigned og = xb_add(&bar[XB_TOP], 1u);
            const unsigned tg = og / nx;
            if (og + 1u == (tg + 1u) * nx) xb_add(&bar[XB_TOPGEN], 1u);
            else XB_SPIN(xb_ld(&bar[XB_TOPGEN]) == tg, bar);
            __builtin_amdgcn_fence(__ATOMIC_ACQUIRE, "agent");
            xb_add(&bar[XB_XGEN(b.x)], 1u);
            asm volatile("s_waitcnt vmcnt(0)" ::: "memory");
        } else {
            XB_SPIN(xb_ld(&bar[XB_XGEN(b.x)]) == gen, bar);
            __builtin_amdgcn_fence(__ATOMIC_ACQUIRE, "agent");
            asm volatile("s_waitcnt vmcnt(0)" ::: "memory");
        }
    }
    __syncthreads();
}

constexpr float LOG2E = 1.4426950408889634f;
constexpr float QSCALE = 0.125f * LOG2E;
typedef const f32x4 (&AccRef)[2][2][4][2];
using pg8::Unit;

struct EpiAttnIn {
    static constexpr bool PERM = true, AFTER_DRAIN = false;
    unsigned char* ws; float* out;
    __device__ __forceinline__ void operator()(AccRef acc, const Unit& u, int wr, int wc, int fr, int fq) const {
        const int pn = u.pn;
        const float* ss = (const float*)(ws + WS_CTL) + CW_SS;
        const int rbase = u.pm * 256 + wr * 64 + fr, cw = wc * 32 + 8 * fq;
#define EAI_LOOP(...) _Pragma("unroll") for (int ai = 0; ai < 2; ++ai) _Pragma("unroll") for (int m = 0; m < 4; ++m) { const int r = rbase + ai * 128 + m * 16; const float rstd = rsqrtf(ss[r] * (1.f / DM) + EPS); \
            _Pragma("unroll") for (int bj = 0; bj < 2; ++bj) { const f32x4 v0 = acc[ai][bj][m][0] * rstd, v1 = acc[ai][bj][m][1] * rstd; __VA_ARGS__ } asm volatile("" ::: "memory"); }
        if (pn < 4) {
            bf16* Qb = (bf16*)(ws + WS_QB) + pn * 256 + cw;
            EAI_LOOP({ *(v4u*)(Qb + (size_t)r * DM + bj * 128) = pk8(v0 * QSCALE, v1 * QSCALE); })
        } else if (pn < 8) {
            const int cc0 = (pn - 4) * 256 + cw;
            bf16* KVb = (bf16*)(ws + WS_KVB) + cc0; bf16* cmpa = (bf16*)(ws + WS_CMPA);
            float* okv = (rbase < MP) ? out + O_KVP + cc0 : out + O_KVS - (size_t)MP * 1024 + cc0;
            EAI_LOOP({ float* o = okv + (size_t)r * 1024 + bj * 128; st4(o, v0); st4(o + 4, v1);
                const v4u w = pk8(v0, v1); *(v4u*)(KVb + (size_t)r * 1024 + bj * 128) = w;
                if (pn < 6 && r < MP) { const int cc = cc0 + bj * 128; const int c = pn - 4, g = (cc & 255) >> 6, d = cc & 63, b = r >> 13, t = r & 8191, mb = t >> 4, l = t & 15;
                    *(v4u*)(cmpa + ((((size_t)(c * NB + b) * 512 + mb) * NG + g) * 16 + l) * 64 + d) = w; }
                if (pn >= 6 && r >= MP) { const int rs = r - MP; *(v4u*)((bf16*)(ws + WS_SELS) + ((size_t)(rs >> 3) * (PAST + DS) + PAST + (rs & 7)) * 512 + (cc0 - 512) + bj * 128) = w; } })
        } else if (pn < 10) {
            const int cc0 = (pn - 8) * 256 + cw;
            bf16* WINb = (bf16*)(ws + WS_WINB) + cc0;
            EAI_LOOP({ const int cc = cc0 + bj * 128; const v4u w = pk8(v0, v1); *(v4u*)(WINb + (size_t)r * 512 + bj * 128) = w;
                if (r >= MP) { const int rs = r - MP; *(v4u*)((bf16*)(ws + WS_WINS) + ((size_t)(rs >> 3) * 520 + 512 + (rs & 7)) * 512 + cc) = w; }
                if (r < MP) { const int t = r & 8191; if (t >= SEQ - 512) { float* o = out + O_WINP + ((size_t)(r >> 13) * 512 + (t - (SEQ - 512))) * 512 + cc; st4(o, v0); st4(o + 4, v1); } }
                else { const int rs = r - MP, s = rs >> 3, t = rs & 7; float* o = out + O_WINS + ((size_t)s * 512 + 504 + t) * 512 + cc; st4(o, v0); st4(o + 4, v1); } })
        } else {
            float* gates = (float*)(ws + WS_GATES);
            EAI_LOOP({ const int cc = bj * 128 + cw; if (cc < 48) { float* o = gates + (size_t)r * 48 + cc;
                f32x4 a, b2; a[0] = sigmoidf_(v0[0]); a[1] = sigmoidf_(v0[1]); a[2] = sigmoidf_(v0[2]); a[3] = sigmoidf_(v0[3]);
                b2[0] = sigmoidf_(v1[0]); b2[1] = sigmoidf_(v1[1]); b2[2] = sigmoidf_(v1[2]); b2[3] = sigmoidf_(v1[3]); st4(o, a); st4(o + 4, b2); } })
        }
#undef EAI_LOOP
    }
};

struct EpiPlain {
    static constexpr bool PERM = true, AFTER_DRAIN = false;
    bf16* O; int ldc;
    __device__ __forceinline__ void operator()(AccRef acc, const Unit& u, int wr, int wc, int fr, int fq) const {
#pragma unroll
        for (int ai = 0; ai < 2; ++ai)
#pragma unroll
            for (int m = 0; m < 4; ++m) {
                const int r = u.pm * 256 + ai * 128 + wr * 64 + m * 16 + fr;
#pragma unroll
                for (int bj = 0; bj < 2; ++bj) { const int c0 = u.pn * 256 + bj * 128 + wc * 32 + 8 * fq; *(v4u*)(O + (size_t)r * ldc + c0) = pk8(acc[ai][bj][m][0], acc[ai][bj][m][1]); }
            }
    }
};

__device__ __forceinline__ void ss_accum(float* ssout, int r, float s, int fq) {
    s += __shfl_xor(s, 16); s += __shfl_xor(s, 32);
    if (fq == 0) atomicAdd(ssout + r, s);
}

struct EpiResid {
    static constexpr bool PERM = true, AFTER_DRAIN = false;
    const bf16* XI; bf16* XO; float* ssout;
    __device__ __forceinline__ void operator()(AccRef acc, const Unit& u, int wr, int wc, int fr, int fq) const {
#pragma unroll
        for (int ai = 0; ai < 2; ++ai)
#pragma unroll
            for (int m = 0; m < 4; ++m) {
                const int r = u.pm * 256 + ai * 128 + wr * 64 + m * 16 + fr;
                float s = 0.f;
#pragma unroll
                for (int bj = 0; bj < 2; ++bj) {
                    const int c0 = u.pn * 256 + bj * 128 + wc * 32 + 8 * fq;
                    f32x4 v0, v1; unpk8(*(const v4u*)(XI + (size_t)r * DM + c0), v0, v1); v0 += acc[ai][bj][m][0]; v1 += acc[ai][bj][m][1];
                    *(v4u*)(XO + (size_t)r * DM + c0) = pk8c(v0, v1);
                    s += (v0[0] * v0[0] + v0[1] * v0[1]) + (v0[2] * v0[2] + v0[3] * v0[3]) + (v1[0] * v1[0] + v1[1] * v1[1]) + (v1[2] * v1[2] + v1[3] * v1[3]);
                }
                ss_accum(ssout, r, s, fq);
            }
    }
};

template <int CTRL> __device__ __forceinline__ float dppf(float v) { return __uint_as_float((unsigned)__builtin_amdgcn_update_dpp(0, (int)__float_as_uint(v), CTRL, 0xf, 0xf, false)); }
template <int CTRL> __device__ __forceinline__ f32x4 dpp4(f32x4 v) { f32x4 r; r[0] = dppf<CTRL>(v[0]); r[1] = dppf<CTRL>(v[1]); r[2] = dppf<CTRL>(v[2]); r[3] = dppf<CTRL>(v[3]); return r; }
__device__ __forceinline__ f32x4 sel4(bool c, f32x4 a, f32x4 b) { f32x4 r; r[0] = c ? a[0] : b[0]; r[1] = c ? a[1] : b[1]; r[2] = c ? a[2] : b[2]; r[3] = c ? a[3] : b[3]; return r; }
__device__ __forceinline__ f32x4 gelu4(f32x4 v) { f32x4 r; r[0] = gelu_tanh(v[0]); r[1] = gelu_tanh(v[1]); r[2] = gelu_tanh(v[2]); r[3] = gelu_tanh(v[3]); return r; }
constexpr int XCH_OFF = RING_BYTES;
struct EpiUpFused {
    static constexpr bool PERM = true, AFTER_DRAIN = false;
    unsigned char* ws; float* out; const float* cw; const float* cb; const float* sconv; int layer; LAS unsigned char* lds;
    __device__ __forceinline__ void operator()(AccRef acc, const Unit& u, int wr, int wc, int fr, int fq) const {
        const float* ss = (const float*)(ws + WS_CTL) + CW_SS + (size_t)(layer ? 4 : 1) * M;
        bf16* ACT = (bf16*)(ws + WS_ACT); float* haloA = (float*)(ws + WS_HALOA); float* haloB = (float*)(ws + WS_HALOB);
        LAS float* xch = (LAS float*)(lds + XCH_OFF);
        const int j0 = u.pn * 128 + wc * 32 + 8 * fq;
        const f32x4 w0a = ld4(cw + j0), w0b = ld4(cw + j0 + 4), w1a = ld4(cw + FF + j0), w1b = ld4(cw + FF + j0 + 4), w2a = ld4(cw + 2 * FF + j0), w2b = ld4(cw + 2 * FF + j0 + 4), bba = ld4(cb + j0), bbb = ld4(cb + j0 + 4);
        const int rs0 = u.pm * 256 + wr * 64 + fr;
        const bool sample = u.pm >= MP / 256;
        if (fr >= 14) {
#pragma unroll
            for (int ai = 0; ai < 2; ++ai) { const int r = rs0 + ai * 128 + 48; const float rstd = rsqrtf(ss[r] * (1.f / DM) + EPS);
                LAS float* d = xch + ((((ai * 2 + wr) * 4 + wc) * 2 + (fr - 14)) * 32) + 8 * fq;
                *(LAS f32x4*)d = acc[ai][0][3][0] * rstd; *(LAS f32x4*)(d + 4) = acc[ai][0][3][1] * rstd; }
        }
        asm volatile("s_waitcnt lgkmcnt(0)" ::: "memory"); __builtin_amdgcn_s_barrier(); asm volatile("" ::: "memory");
#pragma unroll
        for (int ai = 0; ai < 2; ++ai) {
            f32x4 hpa = {0.f, 0.f, 0.f, 0.f}, hpb = {0.f, 0.f, 0.f, 0.f};
            const bool first = (ai == 0 && wr == 0);
            if (!first && fr >= 14) { const int sa = wr ? ai : ai - 1, sw = wr ? 0 : 1;
                const LAS float* s = xch + ((((sa * 2 + sw) * 4 + wc) * 2 + (fr - 14)) * 32) + 8 * fq; hpa = *(const LAS f32x4*)s; hpb = *(const LAS f32x4*)(s + 4); }
            const bool defer = first && !sample && (u.pm & 31) != 0;
#pragma unroll
            for (int m = 0; m < 4; ++m) {
                const int r = rs0 + ai * 128 + m * 16; const float rstd = rsqrtf(ss[r] * (1.f / DM) + EPS);
                const f32x4 ha = acc[ai][0][m][0] * rstd, hb = acc[ai][0][m][1] * rstd, ga = acc[ai][1][m][0] * rstd, gb = acc[ai][1][m][1] * rstd;
                f32x4 p1a, p1b, p2a, p2b;
                if (!sample) {
                    p1a = sel4(fr == 0, dpp4<0x121>(hpa), dpp4<0x121>(ha)); p1b = sel4(fr == 0, dpp4<0x121>(hpb), dpp4<0x121>(hb));
                    p2a = sel4(fr < 2, dpp4<0x122>(hpa), dpp4<0x122>(ha)); p2b = sel4(fr < 2, dpp4<0x122>(hpb), dpp4<0x122>(hb));
                } else {
                    const int t = fr & 7; const float* sc = sconv + (size_t)((r - MP) >> 3) * 2 * FF + j0;
                    f32x4 s0a = {0.f, 0.f, 0.f, 0.f}, s0b = s0a, s1a = s0a, s1b = s0a;
                    if (t < 2) { s1a = ld4(sc + FF); s1b = ld4(sc + FF + 4); if (t == 0) { s0a = ld4(sc); s0b = ld4(sc + 4); } }
                    p1a = sel4(t >= 1, dpp4<0x121>(ha), s1a); p1b = sel4(t >= 1, dpp4<0x121>(hb), s1b);
                    p2a = sel4(t >= 2, dpp4<0x122>(ha), sel4(t == 1, s1a, s0a)); p2b = sel4(t >= 2, dpp4<0x122>(hb), sel4(t == 1, s1b, s0b));
                }
                if (defer && m == 0 && fr < 2) {
                    float* d = haloA + ((size_t)(u.pm * 2 + fr) * 2) * FF + j0; st4(d, ha); st4(d + 4, hb); st4(d + FF, ga); st4(d + FF + 4, gb);
                } else {
                    const f32x4 oa = gelu4(bba + w0a * p2a + w1a * p1a + w2a * ha) * ga, ob = gelu4(bbb + w0b * p2b + w1b * p1b + w2b * hb) * gb;
                    *(v4u*)(ACT + (size_t)r * FF + j0) = pk8(oa, ob);
                }
                if (!sample) { const int t = r & 8191; if (t >= SEQ - 2) { float* o = out + O_CONVP + ((size_t)(layer * NB + (r >> 13)) * 2 + (t - (SEQ - 2))) * FF + j0; st4(o, ha); st4(o + 4, hb); }
                    if (ai == 1 && wr == 1 && m == 3 && fr >= 14) { float* d = haloB + (size_t)(u.pm * 2 + (fr - 14)) * FF + j0; st4(d, ha); st4(d + 4, hb); } }
                else { const int rs = r - MP, t = rs & 7; if (t >= 6) { float* o = out + O_CONVS + ((size_t)(layer * DB + (rs >> 3)) * 2 + (t - 6)) * FF + j0; st4(o, ha); st4(o + 4, hb); } }
                hpa = ha; hpb = hb;
            }
        }
    }
};
__device__ __forceinline__ void up_fix(unsigned char* ws, const float* cw, const float* cb, int pm, int tid) {
    const float* haloA = (const float*)(ws + WS_HALOA) + (size_t)pm * 4 * FF; const float* haloB = (const float*)(ws + WS_HALOB) + (size_t)(pm - 1) * 2 * FF; bf16* ACT = (bf16*)(ws + WS_ACT) + (size_t)pm * 256 * FF;
    for (int j = tid; j < FF; j += NWAVES * 64) {
        const float hm2 = haloB[j], hm1 = haloB[FF + j], h0 = haloA[j], g0 = haloA[FF + j], h1 = haloA[2 * FF + j], g1 = haloA[3 * FF + j];
        const float w0 = cw[j], w1 = cw[FF + j], w2 = cw[2 * FF + j], bb = cb[j];
        ACT[j] = (bf16)f2bf(gelu_tanh(bb + w0 * hm2 + w1 * hm1 + w2 * h0) * g0);
        ACT[FF + j] = (bf16)f2bf(gelu_tanh(bb + w0 * hm1 + w1 * h0 + w2 * h1) * g1);
    }
}

struct EpiGate {
    static constexpr bool PERM = true, AFTER_DRAIN = false;
    const float* ss; const bf16* PP; const bf16* XI; bf16* XO; float* ssout; bf16* XG;
    __device__ __forceinline__ void operator()(AccRef acc, const Unit& u, int wr, int wc, int fr, int fq) const {
#pragma unroll
        for (int ai = 0; ai < 2; ++ai)
#pragma unroll
            for (int m = 0; m < 4; ++m) {
                const int r = u.pm * 256 + ai * 128 + wr * 64 + m * 16 + fr;
                const float rstd = rsqrtf(ss[r] * (1.f / DM) + EPS);
                float s = 0.f;
#pragma unroll
                for (int bj = 0; bj < 2; ++bj) {
                    const int c0 = u.pn * 256 + bj * 128 + wc * 32 + 8 * fq;
                    f32x4 p0, p1, v0, v1; unpk8(*(const v4u*)(PP + (size_t)r * DM + c0), p0, p1); unpk8(*(const v4u*)(XI + (size_t)r * DM + c0), v0, v1);
                    const f32x4 a0 = acc[ai][bj][m][0] * rstd, a1 = acc[ai][bj][m][1] * rstd;
#pragma unroll
                    for (int e = 0; e < 4; ++e) { v0[e] += p0[e] * sigmoidf_(a0[e]); v1[e] += p1[e] * sigmoidf_(a1[e]); }
                    const v4u wv = pk8c(v0, v1);
                    *(v4u*)(XO + (size_t)r * DM + c0) = wv;
                    if (XG) *(v4u*)(XG + ((size_t)(c0 >> 4) * M + r) * 16 + (c0 & 15)) = wv;
                    s += (v0[0] * v0[0] + v0[1] * v0[1]) + (v0[2] * v0[2] + v0[3] * v0[3]) + (v1[0] * v1[0] + v1[1] * v1[1]) + (v1[2] * v1[2] + v1[3] * v1[3]);
                }
                ss_accum(ssout, r, s, fq);
            }
    }
};

struct EpiGlu {
    static constexpr bool PERM = true, AFTER_DRAIN = false;
    const bf16* XI; bf16* XO; float* ssout;
    __device__ __forceinline__ void operator()(AccRef acc, const Unit& u, int wr, int wc, int fr, int fq) const {
#pragma unroll
        for (int ai = 0; ai < 2; ++ai)
#pragma unroll
            for (int m = 0; m < 4; ++m) {
                const int r = u.pm * 256 + ai * 128 + wr * 64 + m * 16 + fr;
                const int c0 = u.pn * 128 + wc * 32 + 8 * fq;
                f32x4 v0, v1; unpk8(*(const v4u*)(XI + (size_t)r * DM + c0), v0, v1);
                const f32x4 a0 = acc[ai][0][m][0], a1 = acc[ai][0][m][1], b0 = acc[ai][1][m][0], b1 = acc[ai][1][m][1];
#pragma unroll
                for (int e = 0; e < 4; ++e) { v0[e] += a0[e] * sigmoidf_(b0[e]); v1[e] += a1[e] * sigmoidf_(b1[e]); }
                *(v4u*)(XO + (size_t)r * DM + c0) = pk8c(v0, v1);
                const float s = (v0[0] * v0[0] + v0[1] * v0[1]) + (v0[2] * v0[2] + v0[3] * v0[3]) + (v1[0] * v1[0] + v1[1] * v1[1]) + (v1[2] * v1[2] + v1[3] * v1[3]);
                ss_accum(ssout, r, s, fq);
            }
    }
};

struct EpiCmp {
    static constexpr bool PERM = true, AFTER_DRAIN = false;
    float* PBUF;
    __device__ __forceinline__ void operator()(AccRef acc, const Unit& u, int wr, int wc, int fr, int fq) const {
        const int row0 = u.pm * 256;
        const int c = row0 / (CMP_ROWS_S / 2);
#pragma unroll
        for (int ai = 0; ai < 2; ++ai)
#pragma unroll
            for (int m = 0; m < 4; ++m) {
                const int r = row0 + ai * 128 + wr * 64 + m * 16 + fr;
                float* o = PBUF + (size_t)r * 128 + wc * 32 + 8 * fq;
                const f32x4 v0 = c ? acc[ai][1][m][0] : acc[ai][0][m][0], v1 = c ? acc[ai][1][m][1] : acc[ai][0][m][1];
                st4(o, v0); st4(o + 4, v1);
            }
    }
};
struct Args {
    const float* in[34]; const int* page_table; float* out; unsigned char* ws; int ph_lo, ph_hi;
};
static_assert(sizeof(Args) == 34 * 8 + 8 + 8 + 8 + 8, "Args has no padding");
enum { I_XP = 0, I_XS, I_CKV, I_CWIN, I_SRE, I_SIM, I_SCONV, I_PT, I_PP, I_PS, I_NMIX, I_NFFN, I_NPLE, I_NFIN, I_WIN, I_WOUT, I_CPE, I_CW1, I_CW2,
       I_ARE, I_AIM, I_LDT, I_BRE, I_BIM, I_CRE, I_CIM, I_SD, I_WGLU, I_WUP, I_CONVW, I_CONVB, I_WDN, I_WPP, I_WPG };

struct Frame {
    LAS unsigned char* lds;
    int tid, lane, wave, gw, NGW;
    unsigned char* ws; float* out; const float* const* in; const int* pt;
    __device__ __forceinline__ float* SS(int k) const { return (float*)(ws + WS_CTL) + CW_SS + (size_t)k * M; }
};

template <int MODE>
__device__ __forceinline__ void transpose_item(const float* W, int K, int N, int nblk, bf16* WT, const float* gain, LAS float* scr, int item, int lane) {
    const int kb = item / nblk, nb = item % nblk, k0 = 32 * kb, n0 = 128 * nb;
    const int nn = n0 + 4 * (lane & 31);
#pragma unroll 8
    for (int i = 0; i < 16; ++i) { const int kk = 2 * i + (lane >> 5); f32x4 v = {0.f, 0.f, 0.f, 0.f};
        if (nn + 3 < N) v = ld4(W + (size_t)(k0 + kk) * N + nn);
        else { if (nn < N) v[0] = W[(size_t)(k0 + kk) * N + nn]; if (nn + 1 < N) v[1] = W[(size_t)(k0 + kk) * N + nn + 1]; if (nn + 2 < N) v[2] = W[(size_t)(k0 + kk) * N + nn + 2]; }
        if (gain) v = v * gain[k0 + kk];
        *(LAS f32x4*)(scr + kk * 132 + 4 * (lane & 31)) = v; }
    LDS_WAIT(); asm volatile("" ::: "memory");
    const int c4 = lane >> 4;
#pragma unroll
    for (int j = 0; j < 8; ++j) { const int n = (lane & 15) + 16 * j; const LAS float* s = scr + (8 * c4) * 132 + n;
        v4u o; o.x = pk2(s[0 * 132], s[1 * 132]); o.y = pk2(s[2 * 132], s[3 * 132]); o.z = pk2(s[4 * 132], s[5 * 132]); o.w = pk2(s[6 * 132], s[7 * 132]);
        int ns = n0 + n, dr = ns;
        if (MODE == 1) { const int half = ns >> 10, jj = ns & 1023; dr = (jj >> 7) * 256 + half * 128 + (jj & 127); }
        if (MODE == 2) { const int half = ns >= FF ? 1 : 0, jj = ns - half * FF; dr = (jj >> 7) * 256 + half * 128 + (jj & 127); }
        *(v4u*)(WT + (size_t)dr * K + k0 + 8 * c4) = o; }
    LDS_WAIT(); asm volatile("" ::: "memory");
}

template <int PART>
__device__ __forceinline__ void p0_weights(Frame& F, int gw, int NGW) {
    LAS float* scr = (LAS float*)(F.lds + F.wave * WAVE_LDS);
    const int lane = F.lane; unsigned char* ws = F.ws;
    constexpr int I_IN = 32 * 22, I_OUT = 32 * 8, I_UP = 32 * 44, I_DN = 88 * 8, I_P = 8 * 8, I_G = 32 * 8, I_GLU = 32 * 16;
    if (PART == 0) {
        constexpr int NITEMS = I_IN + I_OUT + I_UP + I_DN + 2 * I_P + I_G;
        for (int it = gw; it < NITEMS; it += NGW) {
            int r = it;
            if (r < I_IN) { transpose_item<0>(F.in[I_WIN], DM, NIN, 22, (bf16*)(ws + WS_WIN_T), F.in[I_NMIX], scr, r, lane); continue; } r -= I_IN;
            if (r < I_OUT) { transpose_item<0>(F.in[I_WOUT], DM, DM, 8, (bf16*)(ws + WS_WOUT_T), nullptr, scr, r, lane); continue; } r -= I_OUT;
            if (r < I_UP) { transpose_item<2>(F.in[I_WUP], DM, 2 * FF, 44, (bf16*)(ws + WS_WUP_T0), F.in[I_NFFN], scr, r, lane); continue; } r -= I_UP;
            if (r < I_DN) { transpose_item<0>(F.in[I_WDN], FF, DM, 8, (bf16*)(ws + WS_WDN_T0), nullptr, scr, r, lane); continue; } r -= I_DN;
            if (r < I_P) { transpose_item<0>(F.in[I_WPP], PLE, DM, 8, (bf16*)(ws + WS_WP_T0), nullptr, scr, r, lane); continue; } r -= I_P;
            if (r < I_P) { transpose_item<0>(F.in[I_WPP] + (size_t)PLE * DM, PLE, DM, 8, (bf16*)(ws + WS_WP_T1), nullptr, scr, r, lane); continue; } r -= I_P;
            transpose_item<0>(F.in[I_WPG], DM, DM, 8, (bf16*)(ws + WS_WG_T0), F.in[I_NPLE], scr, r, lane);
        }
    } else {
        constexpr int NITEMS = I_UP + I_DN + I_G + I_GLU;
        for (int it = gw; it < NITEMS; it += NGW) {
            int r = it;
            if (r < I_UP) { transpose_item<2>(F.in[I_WUP] + (size_t)DM * 2 * FF, DM, 2 * FF, 44, (bf16*)(ws + WS_WUP_T1), F.in[I_NFFN] + DM, scr, r, lane); continue; } r -= I_UP;
            if (r < I_DN) { transpose_item<0>(F.in[I_WDN] + (size_t)FF * DM, FF, DM, 8, (bf16*)(ws + WS_WDN_T1), nullptr, scr, r, lane); continue; } r -= I_DN;
            if (r < I_G) { transpose_item<0>(F.in[I_WPG] + (size_t)DM * DM, DM, DM, 8, (bf16*)(ws + WS_WG_T1), F.in[I_NPLE] + DM, scr, r, lane); continue; } r -= I_G;
            transpose_item<1>(F.in[I_WGLU], DM, 2 * DM, 16, (bf16*)(ws + WS_WGLU_T), nullptr, scr, r, lane);
        }
    }
}

__device__ __forceinline__ void p0_prologue(Frame& F) {
    LAS float* scr = (LAS float*)(F.lds + F.wave * WAVE_LDS);
    const int gw = F.gw, NGW = F.NGW, lane = F.lane;
    unsigned char* ws = F.ws;
    p0_weights<0>(F, gw, NGW);
    {
        bf16* W1rT = (bf16*)(ws + WS_W1R_T); const float* w1 = F.in[I_CW1];
        for (int it = gw; it < 256 * 16; it += NGW) {
            const int np = it >> 4, lp = it & 15, c = np >> 7, a = (np >> 6) & 1, e = np & 63;
            W1rT[(size_t)np * 1024 + lp * 64 + lane] = (bf16)f2bf(w1[(((size_t)c * 32 + 16 * a + lp) * 64 + lane) * 64 + e]);
        }
        float* cvec = (float*)(ws + WS_CVEC); const float* pe = F.in[I_CPE];
        for (int it = gw; it < 128; it += NGW) {
            const int c = it >> 6, e = it & 63; float s = 0.f;
#pragma unroll 1
            for (int i0 = lane; i0 < 2048; i0 += 512) { float a[8], b[8];
#pragma unroll
                for (int k = 0; k < 8; ++k) { const int i = i0 + 64 * k; a[k] = pe[c * 2048 + i]; b[k] = w1[((size_t)c * 2048 + i) * 64 + e]; }
#pragma unroll
                for (int k = 0; k < 8; ++k) s += a[k] * b[k]; }
            s = wave_sum(s); if (lane == 0) cvec[it] = s;
        }
    }
    {
        bf16* XB = (bf16*)(ws + WS_XBA); float* ss = F.SS(0);
        for (int r = gw; r < M; r += NGW) {
            const float* xr = (r < MP) ? F.in[I_XP] + (size_t)r * DM : F.in[I_XS] + (size_t)(r - MP) * DM;
            float s = 0.f;
#pragma unroll
            for (int j = 0; j < 4; ++j) { const f32x4 v = ld4(xr + 4 * lane + 256 * j); s += (v[0] * v[0] + v[1] * v[1]) + (v[2] * v[2] + v[3] * v[3]);
                v2u w; w.x = pk2(v[0], v[1]); w.y = pk2(v[2], v[3]); *(v2u*)(XB + (size_t)r * DM + 4 * lane + 256 * j) = w; }
            s = wave_sum(s); if (lane == 0) ss[r] = s;
        }
    }
    for (int it0 = gw * 8; it0 < 2 * M; it0 += NGW * 8) {
        f32x4 v[8];
#pragma unroll
        for (int k = 0; k < 8; ++k) { const int it = it0 + k, i = it / M, r = it % M;
            const float* pr = (r < MP) ? F.in[I_PP] + ((size_t)i * MP + r) * PLE : F.in[I_PS] + ((size_t)i * MS + (r - MP)) * PLE;
            v[k] = ld4(pr + 4 * lane); }
#pragma unroll
        for (int k = 0; k < 8; ++k) { const int it = it0 + k, i = it / M, r = it % M;
            bf16* o = (bf16*)(ws + (i ? WS_PB1 : WS_PB0)) + (size_t)r * PLE;
            v2u w; w.x = pk2(v[k][0], v[k][1]); w.y = pk2(v[k][2], v[k][3]); *(v2u*)(o + 4 * lane) = w; }
    }
}

__device__ __forceinline__ void p0_stream(Frame& F, int gw, int NGW, int e_lo, int e_hi, bool do_f) {
    const int lane = F.lane;
    unsigned char* ws = F.ws;
    {
        bf16* sels = (bf16*)(ws + WS_SELS); const float* ckv = F.in[I_CKV];
        for (int it = e_lo + gw * 8; it < e_hi; it += NGW * 8) {
            const int s = it >> 11, tok0 = it & 2047;
            const int page = F.pt[s * NPAGES + (tok0 >> 7)];
            const float* src = ckv + ((size_t)page * PAGE + (tok0 & 127)) * 1024 + 512 + 4 * lane;
            f32x4 v[8][2];
#pragma unroll
            for (int j = 0; j < 8; ++j) { v[j][0] = __builtin_nontemporal_load((const f32x4*)(src + j * 1024)); v[j][1] = __builtin_nontemporal_load((const f32x4*)(src + j * 1024 + 256)); }
            bf16* so = sels + ((size_t)s * (PAST + DS) + tok0) * 512 + 4 * lane;
#pragma unroll
            for (int j = 0; j < 8; ++j)
#pragma unroll
                for (int c = 0; c < 2; ++c) { v2u w; w.x = pk2(v[j][c][0], v[j][c][1]); w.y = pk2(v[j][c][2], v[j][c][3]); *(v2u*)(so + j * 512 + c * 256) = w; }
        }
    }
    if (do_f) {
        const float* cw = F.in[I_CWIN]; float* o = F.out + O_WINS; bf16* wins = (bf16*)(ws + WS_WINS);
        for (int it = gw * 4; it < DB * 512; it += NGW * 4) {
            const int s = it >> 9, i0 = it & 511;
            const float* src = cw + ((size_t)s * 512 + i0) * 512 + 4 * lane;
            f32x4 a[4], b[4];
#pragma unroll
            for (int j = 0; j < 4; ++j) { a[j] = __builtin_nontemporal_load((const f32x4*)(src + j * 512)); b[j] = __builtin_nontemporal_load((const f32x4*)(src + j * 512 + 256)); }
#pragma unroll
            for (int j = 0; j < 4; ++j) { const int i = i0 + j;
                v2u w; w.x = pk2(a[j][0], a[j][1]); w.y = pk2(a[j][2], a[j][3]); *(v2u*)(wins + ((size_t)s * 520 + i) * 512 + 4 * lane) = w;
                w.x = pk2(b[j][0], b[j][1]); w.y = pk2(b[j][2], b[j][3]); *(v2u*)(wins + ((size_t)s * 520 + i) * 512 + 256 + 4 * lane) = w;
                if (i >= 8) { float* dst = o + ((size_t)s * 512 + (i - 8)) * 512 + 4 * lane; __builtin_nontemporal_store(a[j], (f32x4*)dst); __builtin_nontemporal_store(b[j], (f32x4*)(dst + 256)); } }
        }
    }
}

__device__ __forceinline__ void cmp_finalize(Frame& F) {
    const float* PB = (const float*)(F.ws + WS_PBUF); const float* cvec = (const float*)(F.ws + WS_CVEC); const float* w2 = F.in[I_CW2];
    const int lane = F.lane, r = lane & 31, h = lane >> 5;
    constexpr int LP = NB * NCP * NG  , LS = DB * NCS * NG  , BP = (LP + 31) / 32, BS = (LS + 31) / 32, NBT = 2 * BP + 2 * BS;
    bf16x8 wf[2][4]; int wc_ = -1;
    for (int bt = F.gw; bt < NBT; bt += F.NGW) {
        int c, lb, len; bool prompt;
        if (bt < 2 * BP) { prompt = true; c = bt / BP; lb = bt % BP; len = LP; } else { const int q = bt - 2 * BP; prompt = false; c = q / BS; lb = q % BS; len = LS; }
        int idx = lb * 32 + r; const bool valid = idx < len; idx = valid ? idx : len - 1;
        const int g = idx & 3; int q = idx >> 2; size_t row0; bf16* dst;
        if (prompt) { const int n = q % NCP, sq = q / NCP; row0 = (((size_t)(c * NB + sq) * 512 + n) * NG + g); dst = (bf16*)(F.ws + (c ? WS_VCP : WS_KCP)) + ((size_t)(sq * NG + g) * 512 + n) * 64; }
        else { const int n = q % NCS, sq = q / NCS; row0 = CMP_ROWS_P + (((size_t)(c * DB + sq) * 128 + n) * NG + g); dst = (bf16*)(F.ws + (c ? WS_VCS : WS_KCS)) + ((size_t)(sq * NG + g) * 128 + n) * 64; }
        const float* p0 = PB + row0 * 128 + 8 * h; const float* p1 = PB + (row0 + NG) * 128 + 64 + 8 * h;
        f32x4 a[4][2], b[4][2];
#pragma unroll
        for (int ks = 0; ks < 4; ++ks) { a[ks][0] = ld4(p0 + 16 * ks); a[ks][1] = ld4(p0 + 16 * ks + 4); b[ks][0] = ld4(p1 + 16 * ks); b[ks][1] = ld4(p1 + 16 * ks + 4); }
        if (c != wc_) { wc_ = c;
#pragma unroll
            for (int fb = 0; fb < 2; ++fb)
#pragma unroll
                for (int ks = 0; ks < 4; ++ks) { const float* wp = w2 + ((size_t)c * 64 + 16 * ks + 8 * h) * 64 + 32 * fb + r;
                    v4u o; o.x = cvt_pk(wp[0], wp[64]); o.y = cvt_pk(wp[128], wp[192]); o.z = cvt_pk(wp[256], wp[320]); o.w = cvt_pk(wp[384], wp[448]); wf[fb][ks] = __builtin_bit_cast(bf16x8, o); } }
        f32x16 acc[2];
#pragma unroll
        for (int fb = 0; fb < 2; ++fb)
#pragma unroll
            for (int i = 0; i < 16; ++i) acc[fb][i] = 0.f;
#pragma unroll
        for (int ks = 0; ks < 4; ++ks) { const float* cv = cvec + c * 64 + 16 * ks + 8 * h; const f32x4 c0 = ld4(cv), c1 = ld4(cv + 4);
            const f32x4 x0 = a[ks][0] + b[ks][0] + c0, x1 = a[ks][1] + b[ks][1] + c1;
            v4u o; o.x = cvt_pk(gelu_tanh(x0[0]), gelu_tanh(x0[1])); o.y = cvt_pk(gelu_tanh(x0[2]), gelu_tanh(x0[3])); o.z = cvt_pk(gelu_tanh(x1[0]), gelu_tanh(x1[1])); o.w = cvt_pk(gelu_tanh(x1[2]), gelu_tanh(x1[3]));
            const bf16x8 hf = __builtin_bit_cast(bf16x8, o);
#pragma unroll
            for (int fb = 0; fb < 2; ++fb) acc[fb] = __builtin_amdgcn_mfma_f32_32x32x16_bf16(wf[fb][ks], hf, acc[fb], 0, 0, 0); }
        if (valid) {
#pragma unroll
            for (int fb = 0; fb < 2; ++fb)
#pragma unroll
                for (int q4 = 0; q4 < 4; ++q4) { v2u w; w.x = cvt_pk(acc[fb][4 * q4], acc[fb][4 * q4 + 1]); w.y = cvt_pk(acc[fb][4 * q4 + 2], acc[fb][4 * q4 + 3]);
                    *(v2u*)(dst + 32 * fb + 8 * q4 + 4 * h) = w; }
        }
    }
}

__device__ __forceinline__ void final_norm(Frame& F) {
    const bf16* X = (const bf16*)(F.ws + WS_XBA); const float* ss = F.SS(6); const float* gn = F.in[I_NFIN];
    for (int r = F.gw; r < M; r += F.NGW) {
        const float rstd = rsqrtf(ss[r] * (1.f / DM) + EPS);
        float* o = (r < MP) ? F.out + O_YP + (size_t)r * DM : F.out + O_YS + (size_t)(r - MP) * DM;
#pragma unroll
        for (int j = 0; j < 2; ++j) { const int c = 8 * F.lane + 512 * j; f32x4 v0, v1; unpk8(*(const v4u*)(X + (size_t)r * DM + c), v0, v1);
            __builtin_nontemporal_store(v0 * rstd * ld4(gn + c), (f32x4*)(o + c)); __builtin_nontemporal_store(v1 * rstd * ld4(gn + c + 4), (f32x4*)(o + c + 4)); }
    }
}
constexpr int SG_PITCH = 68;
struct SgPre { v4u a, b; float f; };
template <bool DUAL, class Pre, class Fn>
__device__ __forceinline__ void sgemm_tile(LAS unsigned char* lds, const bf16* A, int lda, const bf16* B0, const bf16* B1, int K, int wave, int lane, const Pre& pre, const Fn& fn) {
    LAS float* part = (LAS float*)lds;
    const int nsl = DUAL ? 4 : 8, sl = DUAL ? (wave & 3) : wave; const bf16* Bt = (DUAL && wave >= 4) ? B1 : B0;
    const int ksl = K / nsl, k0 = sl * ksl, steps = ksl / 16;
    const int r = lane & 31, h = lane >> 5;
    f32x16 acc[2][2];
#pragma unroll
    for (int a = 0; a < 2; ++a)
#pragma unroll
        for (int b = 0; b < 2; ++b)
#pragma unroll
            for (int i = 0; i < 16; ++i) acc[a][b][i] = 0.f;
    const bf16* ap = A + (size_t)r * lda + k0 + 8 * h; const bf16* bp = Bt + (size_t)r * K + k0 + 8 * h;
    for (int s0 = 0; s0 < steps; s0 += 8) {
        bf16x8 fa0[8], fa1[8], fb0[8], fb1[8];
#pragma unroll
        for (int j = 0; j < 8; ++j) { const int st = (s0 + j < steps) ? s0 + j : steps - 1;
            fa0[j] = *(const bf16x8*)(ap + 16 * st); fa1[j] = *(const bf16x8*)(ap + (size_t)32 * lda + 16 * st); fb0[j] = *(const bf16x8*)(bp + 16 * st); fb1[j] = *(const bf16x8*)(bp + (size_t)32 * K + 16 * st); }
        __builtin_amdgcn_sched_barrier(0);
#pragma unroll
        for (int j = 0; j < 8; ++j) if (s0 + j < steps) {
            acc[0][0] = __builtin_amdgcn_mfma_f32_32x32x16_bf16(fa0[j], fb0[j], acc[0][0], 0, 0, 0); acc[0][1] = __builtin_amdgcn_mfma_f32_32x32x16_bf16(fa0[j], fb1[j], acc[0][1], 0, 0, 0);
            acc[1][0] = __builtin_amdgcn_mfma_f32_32x32x16_bf16(fa1[j], fb0[j], acc[1][0], 0, 0, 0); acc[1][1] = __builtin_amdgcn_mfma_f32_32x32x16_bf16(fa1[j], fb1[j], acc[1][1], 0, 0, 0); }
    }
    const int t = wave * 64 + lane, row = t >> 3, c8 = (t & 7) * 8;
    const SgPre pv = pre(row, c8);
    LAS float* pw = part + wave * 64 * SG_PITCH;
#pragma unroll
    for (int a = 0; a < 2; ++a)
#pragma unroll
        for (int b = 0; b < 2; ++b)
#pragma unroll
            for (int i = 0; i < 16; ++i) pw[(32 * a + (i & 3) + 8 * (i >> 2) + 4 * h) * SG_PITCH + 32 * b + r] = acc[a][b][i];
    asm volatile("s_waitcnt lgkmcnt(0)" ::: "memory"); __syncthreads();
    f32x4 v0 = {0.f, 0.f, 0.f, 0.f}, v1 = v0, w0 = v0, w1 = v0;
#pragma unroll
    for (int p = 0; p < nsl; ++p) { const LAS float* q = part + (p * 64 + row) * SG_PITCH + c8; v0 += *(const LAS f32x4*)q; v1 += *(const LAS f32x4*)(q + 4); }
    if (DUAL) {
#pragma unroll
        for (int p = 4; p < 8; ++p) { const LAS float* q = part + (p * 64 + row) * SG_PITCH + c8; w0 += *(const LAS f32x4*)q; w1 += *(const LAS f32x4*)(q + 4); }
    }
    fn(row, c8, v0, v1, w0, w1, pv);
    asm volatile("s_waitcnt lgkmcnt(0)" ::: "memory"); __syncthreads();
}
__device__ __forceinline__ void ss_accum8(float* ssout, int r, float s, int lane) {
    s += __shfl_xor(s, 1); s += __shfl_xor(s, 2); s += __shfl_xor(s, 4);
    if ((lane & 7) == 0) atomicAdd(ssout + r, s);
}
__device__ __forceinline__ float sumsq8(f32x4 a, f32x4 b) { return (a[0] * a[0] + a[1] * a[1]) + (a[2] * a[2] + a[3] * a[3]) + (b[0] * b[0] + b[1] * b[1]) + (b[2] * b[2] + b[3] * b[3]); }

__device__ __forceinline__ void sample_resid(Frame& F, const bf16* A, int lda, const bf16* Bt, int K, const bf16* XI, bf16* XO, float* ssout) {
    for (int u = blockIdx.x; u < 256; u += gridDim.x) { const int rb = u >> 4, cbk = u & 15; const int lane = F.lane;
        sgemm_tile<false>(F.lds, A + (size_t)(MP + 64 * rb) * lda, lda, Bt + (size_t)(64 * cbk) * K, nullptr, K, F.wave, lane,
            [&](int row, int c8) { SgPre p; p.a = *(const v4u*)(XI + (size_t)(MP + 64 * rb + row) * DM + 64 * cbk + c8); p.b = p.a; p.f = 0.f; return p; },
            [&](int row, int c8, f32x4 v0, f32x4 v1, f32x4, f32x4, const SgPre& pv) { const int r = MP + 64 * rb + row, c0 = 64 * cbk + c8;
                f32x4 x0, x1; unpk8(pv.a, x0, x1); v0 += x0; v1 += x1;
                *(v4u*)(XO + (size_t)r * DM + c0) = pk8c(v0, v1);
                ss_accum8(ssout, r, sumsq8(v0, v1), lane); }); }
}
__device__ __forceinline__ void sample_gate(Frame& F, const bf16* A, const bf16* Bt, const float* ss, const bf16* PP, const bf16* XI, bf16* XO, bf16* XG, float* ssout) {
    for (int u = blockIdx.x; u < 256; u += gridDim.x) { const int rb = u >> 4, cbk = u & 15; const int lane = F.lane;
        sgemm_tile<false>(F.lds, A + (size_t)(MP + 64 * rb) * DM, DM, Bt + (size_t)(64 * cbk) * DM, nullptr, DM, F.wave, lane,
            [&](int row, int c8) { const int r = MP + 64 * rb + row, c0 = 64 * cbk + c8; SgPre p; p.a = *(const v4u*)(PP + (size_t)r * DM + c0); p.b = *(const v4u*)(XI + (size_t)r * DM + c0); p.f = ss[r]; return p; },
            [&](int row, int c8, f32x4 a0, f32x4 a1, f32x4, f32x4, const SgPre& pv) { const int r = MP + 64 * rb + row, c0 = 64 * cbk + c8;
                const float rstd = rsqrtf(pv.f * (1.f / DM) + EPS);
                f32x4 p0, p1, v0, v1; unpk8(pv.a, p0, p1); unpk8(pv.b, v0, v1);
                a0 = a0 * rstd; a1 = a1 * rstd;
#pragma unroll
                for (int e = 0; e < 4; ++e) { v0[e] += p0[e] * sigmoidf_(a0[e]); v1[e] += p1[e] * sigmoidf_(a1[e]); }
                const v4u wv = pk8c(v0, v1); *(v4u*)(XO + (size_t)r * DM + c0) = wv;
                if (XG) *(v4u*)(XG + ((size_t)(c0 >> 4) * M + r) * 16 + (c0 & 15)) = wv;
                ss_accum8(ssout, r, sumsq8(v0, v1), lane); }); }
}
__device__ __forceinline__ void sample_glu(Frame& F, const bf16* A, const bf16* WgluT, const bf16* XI, bf16* XO, float* ssout) {
    for (int u = blockIdx.x; u < 256; u += gridDim.x) { const int rb = u >> 4, cbk = u & 15; const int lane = F.lane; const int j0 = 64 * cbk;
        const bf16* B0 = WgluT + (size_t)((j0 >> 7) * 256 + (j0 & 127)) * DM;
        sgemm_tile<true>(F.lds, A + (size_t)(MP + 64 * rb) * DM, DM, B0, B0 + (size_t)128 * DM, DM, F.wave, lane,
            [&](int row, int c8) { SgPre p; p.a = *(const v4u*)(XI + (size_t)(MP + 64 * rb + row) * DM + j0 + c8); p.b = p.a; p.f = 0.f; return p; },
            [&](int row, int c8, f32x4 a0, f32x4 a1, f32x4 b0, f32x4 b1, const SgPre& pv) { const int r = MP + 64 * rb + row, c0 = j0 + c8;
                f32x4 v0, v1; unpk8(pv.a, v0, v1);
#pragma unroll
                for (int e = 0; e < 4; ++e) { v0[e] += a0[e] * sigmoidf_(b0[e]); v1[e] += a1[e] * sigmoidf_(b1[e]); }
                *(v4u*)(XO + (size_t)r * DM + c0) = pk8c(v0, v1);
                ss_accum8(ssout, r, sumsq8(v0, v1), lane); }); }
}

__device__ __forceinline__ void sample_plain(Frame& F, const bf16* A, int lda, const bf16* Bt, int K, bf16* O) {
    for (int u = blockIdx.x; u < 256; u += gridDim.x) { const int rb = u >> 4, cbk = u & 15;
        sgemm_tile<false>(F.lds, A + (size_t)(MP + 64 * rb) * lda, lda, Bt + (size_t)(64 * cbk) * K, nullptr, K, F.wave, F.lane,
            [&](int, int) { SgPre p; p.a = (v4u){0u, 0u, 0u, 0u}; p.b = p.a; p.f = 0.f; return p; },
            [&](int row, int c8, f32x4 v0, f32x4 v1, f32x4, f32x4, const SgPre&) { *(v4u*)(O + (size_t)(MP + 64 * rb + row) * DM + 64 * cbk + c8) = pk8c(v0, v1); }); }
}
__device__ __forceinline__ void sample_plain_sub(Frame& F, const bf16* A, int lda, const bf16* Bt, int K, bf16* O, int r, int n) {
    for (int u = r; u < 256; u += n) { const int rb = u >> 4, cbk = u & 15;
        sgemm_tile<false>(F.lds, A + (size_t)(MP + 64 * rb) * lda, lda, Bt + (size_t)(64 * cbk) * K, nullptr, K, F.wave, F.lane,
            [&](int, int) { SgPre p; p.a = (v4u){0u, 0u, 0u, 0u}; p.b = p.a; p.f = 0.f; return p; },
            [&](int row, int c8, f32x4 v0, f32x4 v1, f32x4, f32x4, const SgPre&) { *(v4u*)(O + (size_t)(MP + 64 * rb + row) * DM + 64 * cbk + c8) = pk8c(v0, v1); }); }
}
__device__ __forceinline__ void prompt_cmp(Frame& F) {
    const bf16* A = (const bf16*)(F.ws + WS_CMPA); const bf16* W = (const bf16*)(F.ws + WS_W1R_T); float* PB = (float*)(F.ws + WS_PBUF);
    for (int u = blockIdx.x; u < 256; u += gridDim.x) { const int rb = u >> 1, c2 = u & 1, c = (64 * rb) / (CMP_ROWS_P / 2);
        sgemm_tile<false>(F.lds, A + (size_t)(64 * rb) * 1024, 1024, W + (size_t)(128 * c + 64 * c2) * 1024, nullptr, 1024, F.wave, F.lane,
            [&](int, int) { SgPre p; p.a = (v4u){0u, 0u, 0u, 0u}; p.b = p.a; p.f = 0.f; return p; },
            [&](int row, int c8, f32x4 v0, f32x4 v1, f32x4, f32x4, const SgPre&) { float* o = PB + (size_t)(64 * rb + row) * 128 + 64 * c2 + c8; st4(o, v0); st4(o + 4, v1); }); }
}

constexpr int SC_PITCH = 2064, SC_BUF = 32 * SC_PITCH;
__device__ __forceinline__ void sample_cmp_pages(Frame& F) {
    LAS unsigned char* al = F.lds;
    const int lane = F.lane, w = F.wave, j16 = lane & 15, kq = lane >> 4;
    const int c = blockIdx.x & 1, u0 = blockIdx.x >> 1, ustep = gridDim.x >> 1;
    const float* ckv = F.in[I_CKV] + c * 256 + 4 * lane; float* PB = (float*)(F.ws + WS_PBUF);
    bf16x8 bq[32];
    { const bf16* bp = (const bf16*)(F.ws + WS_W1R_T) + (size_t)(c * 128 + 16 * w + j16) * 1024 + 8 * kq;
#pragma unroll
      for (int ks = 0; ks < 32; ++ks) bq[ks] = *(const bf16x8*)(bp + 32 * ks); }
    LAS unsigned char* aw = al + (lane >> 4) * SC_PITCH + 2 * (w * 64 + (lane & 15) * 4);
    LAS const unsigned char* ap = al + j16 * SC_PITCH + 16 * kq;
    f32x4 v[16];
    int u = u0;
    if (u < DB * NPAGES) { const float* src = ckv + ((size_t)F.pt[u] * PAGE + w) * 1024;
#pragma unroll
        for (int i = 0; i < 16; ++i) v[i] = __builtin_nontemporal_load((const f32x4*)(src + (size_t)i * 8192));
#pragma unroll
        for (int i = 0; i < 16; ++i) { v2u wv; wv.x = cvt_pk(v[i][0], v[i][1]); wv.y = cvt_pk(v[i][2], v[i][3]); *(LAS v2u*)(aw + (i >> 1) * 4 * SC_PITCH + (i & 1) * 1024) = wv; } }
    LDS_WAIT(); __syncthreads();
    for (int p = 0; u < DB * NPAGES; u += ustep, p ^= 1) {
        const int un = u + ustep; const bool more = un < DB * NPAGES;
        if (more) { const float* src = ckv + ((size_t)F.pt[un] * PAGE + w) * 1024;
#pragma unroll
            for (int i = 0; i < 16; ++i) v[i] = __builtin_nontemporal_load((const f32x4*)(src + (size_t)i * 8192)); }
        f32x4 acc0 = {0.f, 0.f, 0.f, 0.f}, acc1 = acc0;
        LAS const unsigned char* a = ap + p * SC_BUF;
#pragma unroll
        for (int ks = 0; ks < 32; ++ks) { const bf16x8 a0 = *(LAS const bf16x8*)(a + 64 * ks), a1 = *(LAS const bf16x8*)(a + 16 * SC_PITCH + 64 * ks);
            acc0 = __builtin_amdgcn_mfma_f32_16x16x32_bf16(a0, bq[ks], acc0, 0, 0, 0); acc1 = __builtin_amdgcn_mfma_f32_16x16x32_bf16(a1, bq[ks], acc1, 0, 0, 0); }
        const int s = u >> 4, pg = u & 15;
        float* po = PB + ((size_t)CMP_ROWS_P + (size_t)(c * DB + s) * 512 + 32 * pg + 4 * kq) * 128 + 16 * w + j16;
#pragma unroll
        for (int e = 0; e < 4; ++e) { po[e * 128] = acc0[e]; po[(16 + e) * 128] = acc1[e]; }
        if (more) { LAS unsigned char* d = aw + (p ^ 1) * SC_BUF;
#pragma unroll
            for (int i = 0; i < 16; ++i) { v2u wv; wv.x = cvt_pk(v[i][0], v[i][1]); wv.y = cvt_pk(v[i][2], v[i][3]); *(LAS v2u*)(d + (i >> 1) * 4 * SC_PITCH + (i & 1) * 1024) = wv; } }
        LDS_WAIT(); __syncthreads();
    }
}

typedef short s16x4 __attribute__((ext_vector_type(4)));
constexpr float NEGS = -3.0e38f;
constexpr int VBUF = 4096;
constexpr int AL_K = 0, AL_V = VBUF, AL_IMP = 2 * VBUF, AL_V1 = 2 * VBUF  , AL_SELM = 2 * VBUF + 8192, AL_END = AL_SELM + 256;
static_assert(AL_END <= WAVE_LDS, "attention LDS map");

struct ASeq {
    const bf16* kc; const bf16* vc; int nc;
    const bf16* ks; int spitch; int srows;
    const bf16* kw; int wpitch; int wrows; int wpos0;
    int qpos0; int ns;
};

__device__ __forceinline__ float ex2(float x) { return __builtin_amdgcn_exp2f(x); }
typedef unsigned v2uu __attribute__((ext_vector_type(2)));
__device__ __forceinline__ float xhalf_max(float v) { const unsigned b = __float_as_uint(v); const v2uu r = __builtin_amdgcn_permlane32_swap(b, b, false, false); float o; asm("v_max_f32 %0, %1, %2" : "=v"(o) : "v"(r[0]), "v"(r[1])); return o; }
__device__ __forceinline__ float xhalf_sum(float v) { const unsigned b = __float_as_uint(v); const v2uu r = __builtin_amdgcn_permlane32_swap(b, b, false, false); return __uint_as_float(r[0]) + __uint_as_float(r[1]); }
template <int CTRL> __device__ __forceinline__ float dpp_f(float v) { return __uint_as_float((unsigned)__builtin_amdgcn_update_dpp(0, (int)__float_as_uint(v), CTRL, 0xf, 0xf, true)); }
__device__ __forceinline__ float quad_sum(float v) { v += dpp_f<0xB1>(v); v += dpp_f<0x4E>(v); return v; }

__device__ __forceinline__ void issue_k(LAS unsigned char* kbuf, const bf16* kbase, int pitch, int row0, int nrows, int lane) {
#pragma unroll
    for (int i = 0; i < 4; ++i) { int row = row0 + 8 * i + (lane >> 3); row = row < nrows ? row : nrows - 1;
        const int ch = (lane & 7) ^ ((lane >> 3) & 7);
        __builtin_amdgcn_global_load_lds((const unsigned*)(kbase + (size_t)row * pitch + 8 * ch), (LAS unsigned*)(kbuf + i * 1024), 16, 0, 0); }
}
__device__ __forceinline__ void read_kf(bf16x8 (&kf)[4], LAS const unsigned char* kbuf, int lane) {
    const int key = lane & 31, h = lane >> 5;
#pragma unroll
    for (int ks = 0; ks < 4; ++ks) kf[ks] = *(LAS const bf16x8*)(kbuf + key * 128 + (((2 * ks + h) ^ (key & 7)) << 4));
}
__device__ __forceinline__ void issue_v(LAS unsigned char* vbuf, const bf16* vbase, int pitch, int row0, int nrows, int lane) {
#pragma unroll
    for (int i = 0; i < 4; ++i) { int row = row0 + 8 * i + (lane >> 3); row = row < nrows ? row : nrows - 1;
        const int ch = (lane & 7) ^ (((lane >> 4) & 1) << 2);
        __builtin_amdgcn_global_load_lds((const unsigned*)(vbase + (size_t)row * pitch + 8 * ch), (LAS unsigned*)(vbuf + i * 1024), 16, 0, 0); }
}
__device__ __forceinline__ s16x4 vtr(LAS const unsigned char* p) { return __builtin_bit_cast(s16x4, __builtin_amdgcn_ds_read_tr16_b64_v4i16((LAS s16x4*)p)); }
__device__ __forceinline__ bf16x8 vfrag(LAS const unsigned char* va, int ks) {
    const s16x4 lo = vtr(va + ks * 2048), hi = vtr(va + ks * 2048 + 1024);
    bf16x8 r; r[0] = lo[0]; r[1] = lo[1]; r[2] = lo[2]; r[3] = lo[3]; r[4] = hi[0]; r[5] = hi[1]; r[6] = hi[2]; r[7] = hi[3]; return r;
}

template <int NQB> struct AState { float m[NQB], l[NQB]; f32x16 o[2][NQB]; };

#define OFFI(i) (((i) & 3) + 8 * ((i) >> 2))
__device__ __forceinline__ void qk_raw(f32x16& acc, const bf16x8 (&kf)[4], const bf16x8 (&qf)[4]) {
#pragma unroll
    for (int i = 0; i < 16; ++i) acc[i] = 0.f;
#pragma unroll
    for (int ks = 0; ks < 4; ++ks) acc = __builtin_amdgcn_mfma_f32_32x32x16_bf16(kf[ks], qf[ks], acc, 0, 0, 0);
}
__device__ __forceinline__ void mask_bias(f32x16& s, float sl_alpha, float fb, int lo_rel, int hi_rel, bool extra) {
#pragma unroll
    for (int i = 0; i < 16; ++i) { const bool ok = extra && (OFFI(i) <= hi_rel) && (OFFI(i) >= lo_rel); s[i] = ok ? __builtin_fmaf(sl_alpha, (float)OFFI(i), s[i] + fb) : NEGS; }
}
template <int NQB>
__device__ __forceinline__ void scores(f32x16& s, const bf16x8 (&kf)[4], const bf16x8 (&qf)[4], float sl_alpha, float fb, int lo_rel, int hi_rel, bool extra) {
    qk_raw(s, kf, qf); mask_bias(s, sl_alpha, fb, lo_rel, hi_rel, extra);
}
__device__ __forceinline__ float max16(const f32x16& s) {
    float a = fmaxf(fmaxf(s[0], s[1]), fmaxf(s[2], s[3])), b = fmaxf(fmaxf(s[4], s[5]), fmaxf(s[6], s[7])), c = fmaxf(fmaxf(s[8], s[9]), fmaxf(s[10], s[11])), d = fmaxf(fmaxf(s[12], s[13]), fmaxf(s[14], s[15]));
    return fmaxf(fmaxf(a, b), fmaxf(c, d));
}
__device__ __forceinline__ void pack_p(bf16x8 (&pf)[2], const f32x16& p) {
#pragma unroll
    for (int ks = 0; ks < 2; ++ks) { v4u w; w.x = cvt_pk(p[8 * ks + 0], p[8 * ks + 1]); w.y = cvt_pk(p[8 * ks + 2], p[8 * ks + 3]); w.z = cvt_pk(p[8 * ks + 4], p[8 * ks + 5]); w.w = cvt_pk(p[8 * ks + 6], p[8 * ks + 7]); pf[ks] = __builtin_bit_cast(bf16x8, w); }
}

template <int NQB>
__device__ __forceinline__ void attn_unit(Frame& F, const ASeq& A, int qrow0, int g, int tl0, LAS unsigned char* wl) {
    int lane_ = F.lane; asm volatile("" : "+v"(lane_));
    const int lane = lane_ & 63, h = lane >> 5, c = lane & 31, head = c & 3;
    LAS unsigned char* kl = wl + AL_K; LAS unsigned char* vl = wl + AL_V; LAS float* imp = (LAS float*)(wl + AL_IMP); LAS unsigned* selm = (LAS unsigned*)(wl + AL_SELM);
    unsigned* stash0 = (unsigned*)(F.ws + WS_STASH) + (size_t)F.gw * 2048 + lane;
    const int vq = (lane & 15) >> 2, vfq = (vq >> 1) & 1;
    const int vbase_off = (4 * h + vq) * 128 + (2 * ((lane >> 4) & 1) + ((lane & 3) >> 1)) * 16 + (lane & 1) * 8;
    const int voff0 = vbase_off + vfq * 64, voff1 = vbase_off + (1 - vfq) * 64;
    const bf16* Qb = (const bf16*)(F.ws + WS_QB); bf16* Ob = (bf16*)(F.ws + WS_OB); const float* gates = (const float*)(F.ws + WS_GATES);
    bf16x8 qf[NQB][4]; int qpos[NQB];
#pragma unroll
    for (int qb = 0; qb < NQB; ++qb) {
        const int tok = qb * 8 + (c >> 2); const size_t r = (size_t)qrow0 + tok;
        const bf16* qp = Qb + r * DM + (4 * g + head) * 64 + 8 * h;
#pragma unroll
        for (int ks = 0; ks < 4; ++ks) qf[qb][ks] = *(const bf16x8*)(qp + 16 * ks);
        qpos[qb] = A.qpos0 + tl0 + tok;
    }
    const float sl = exp2f(-0.5f * (float)(4 * g + head + 1)) * LOG2E;
    const int qmin = A.qpos0 + tl0, qmax = qmin + 8 * NQB - 1;
    AState<NQB> st;

#pragma unroll
    for (int i = 0; i < 8; ++i) *(LAS f32x4*)(imp + (i * 64 + lane) * 4) = (f32x4){0.f, 0.f, 0.f, 0.f};

    int lim[NQB];
#pragma unroll
    for (int qb = 0; qb < NQB; ++qb) { int nv = qpos[qb] >= 31 ? (qpos[qb] - 31) / 16 + 1 : 0; nv = nv < A.nc ? nv : A.nc; lim[qb] = nv - 1; }
    int nvmax = qmax >= 31 ? (qmax - 31) / 16 + 1 : 0; nvmax = nvmax < A.nc ? nvmax : A.nc;
    const int ntc = (nvmax + 31) >> 5;
#pragma unroll
    for (int qb = 0; qb < NQB; ++qb) { st.m[qb] = -1.0e30f; st.l[qb] = 0.f; }
    if (ntc > 0) issue_k(kl, A.kc, 64, 0, A.nc, lane);
    for (int tile = 0; tile < ntc; ++tile) {
        bf16x8 kf[4];
        asm volatile("s_waitcnt vmcnt(0)" ::: "memory"); read_kf(kf, kl, lane); LDS_WAIT(); asm volatile("" ::: "memory");
        if (tile + 1 < ntc) issue_k(kl, A.kc, 64, (tile + 1) * 32, A.nc, lane);
        const int nb = tile * 32 + 4 * h;
#pragma unroll
        for (int qb = 0; qb < NQB; ++qb) {
            f32x16 s; scores<NQB>(s, kf, qf[qb], sl * 16.f, sl * (16.f * (float)nb + 15.5f - (float)qpos[qb]), 0, lim[qb] - nb, true);
            float tm = xhalf_max(max16(s));
            const float mn = fmaxf(st.m[qb], tm); float sum = 0.f;
#pragma unroll
            for (int i = 0; i < 16; ++i) sum += ex2(s[i] - mn);
            st.l[qb] = st.l[qb] * ex2(st.m[qb] - mn) + sum; st.m[qb] = mn;
        }
    }
    float invl[NQB];
#pragma unroll
    for (int qb = 0; qb < NQB; ++qb) { const float lt = xhalf_sum(st.l[qb]); invl[qb] = (lim[qb] >= 0 && lt > 0.f) ? 1.f / lt : 0.f; }
#pragma unroll
    for (int db = 0; db < 2; ++db)
#pragma unroll
        for (int qb = 0; qb < NQB; ++qb)
#pragma unroll
            for (int i = 0; i < 16; ++i) st.o[db][qb][i] = 0.f;
    if (ntc > 0) { issue_k(kl, A.kc, 64, 0, A.nc, lane); issue_v(vl, A.vc, 64, 0, A.nc, lane); }
    for (int tile = 0; tile < ntc; ++tile) {
        const bool more = tile + 1 < ntc;
        bf16x8 kf[4];
        asm volatile("s_waitcnt vmcnt(4)" ::: "memory"); read_kf(kf, kl, lane); LDS_WAIT(); asm volatile("" ::: "memory");
        if (more) issue_k(kl, A.kc, 64, (tile + 1) * 32, A.nc, lane);
        const int nb = tile * 32 + 4 * h;
        bf16x8 pf[NQB][2];
#pragma unroll
        for (int qb = 0; qb < NQB; ++qb) {
            f32x16 s; scores<NQB>(s, kf, qf[qb], sl * 16.f, sl * (16.f * (float)nb + 15.5f - (float)qpos[qb]), 0, lim[qb] - nb, true);
            f32x16 p;
#pragma unroll
            for (int i = 0; i < 16; ++i) p[i] = ex2(s[i] - st.m[qb]) * invl[qb];
#pragma unroll
            for (int q = 0; q < 4; ++q) { const float v = quad_sum((p[4 * q] + p[4 * q + 1]) + (p[4 * q + 2] + p[4 * q + 3]));
                if (head == 0) imp[(qb * 8 + (c >> 2)) * 128 + 8 * tile + 2 * q + h] = v; }
            pack_p(pf[qb], p);
        }
        if (more) asm volatile("s_waitcnt vmcnt(4) lgkmcnt(0)" ::: "memory"); else asm volatile("s_waitcnt vmcnt(0) lgkmcnt(0)" ::: "memory");
#pragma unroll
        for (int db = 0; db < 2; ++db)
#pragma unroll
            for (int ks = 0; ks < 2; ++ks) { const bf16x8 vf = vfrag(vl + (db ? voff1 : voff0), ks);
#pragma unroll
                for (int qb = 0; qb < NQB; ++qb) st.o[db][qb] = __builtin_amdgcn_mfma_f32_32x32x16_bf16(vf, pf[qb][ks], st.o[db][qb], 0, 0, 0); }
        LDS_WAIT(); asm volatile("" ::: "memory");
        if (more) issue_v(vl, A.vc, 64, (tile + 1) * 32, A.nc, lane);
    }
    asm volatile("s_waitcnt vmcnt(0) lgkmcnt(0)" ::: "memory");

    unsigned taken = 0u;
    {
        const int tok = lane >> 2, part = lane & 3; const bool live = tok < 8 * NQB;
        const int cur = (A.qpos0 + tl0 + tok) >> 6;
        float v[32];
#pragma unroll
        for (int j4 = 0; j4 < 8; ++j4) { const f32x4 t = *(LAS const f32x4*)(imp + (live ? tok : 0) * 128 + 32 * part + 4 * j4); v[4 * j4] = t[0]; v[4 * j4 + 1] = t[1]; v[4 * j4 + 2] = t[2]; v[4 * j4 + 3] = t[3]; }
        const int rel = cur - 32 * part, nsrel = A.ns - 32 * part;
#pragma unroll
        for (int j = 0; j < 32; ++j) { const bool forced = (j == rel) || (j == rel - 1) || (j == 0 && part == 0);
            v[j] = (j < nsrel) ? ((j <= rel) ? v[j] + (forced ? 1.0e4f : 0.f) : -1.0e30f) : NEGS; }
        for (int k = 0; k < 16; ++k) {
            float bv = -__builtin_inff(); int bj = 0;
#pragma unroll
            for (int j = 0; j < 32; ++j) { const float cnd = ((taken >> j) & 1u) ? NEGS : v[j]; if (cnd > bv) { bv = cnd; bj = j; } }
            int bi = 32 * part + bj;
            { const float ov = dpp_f<0xB1>(bv); const int oi = __builtin_amdgcn_update_dpp(0, bi, 0xB1, 0xf, 0xf, true); if (ov > bv || (ov == bv && oi < bi)) { bv = ov; bi = oi; } }
            { const float ov = dpp_f<0x4E>(bv); const int oi = __builtin_amdgcn_update_dpp(0, bi, 0x4E, 0xf, 0xf, true); if (ov > bv || (ov == bv && oi < bi)) { bv = ov; bi = oi; } }
            if ((bi >> 5) == part) taken |= 1u << (bi & 31);
        }
        if (!live) taken = 0u;
        selm[lane] = taken;
    }
    LDS_WAIT(); asm volatile("" ::: "memory");
    { unsigned* stash = stash0; asm volatile("" : "+v"(stash));
#pragma unroll
    for (int db = 0; db < 2; ++db)
#pragma unroll
        for (int qb = 0; qb < NQB; ++qb)
#pragma unroll
            for (int k = 0; k < 8; ++k) { const float g0 = gates[((size_t)qrow0 + qb * 8 + (c >> 2)) * 48 + (4 * g + head) * 3];
                stash[((db * NQB + qb) * 8 + k) * 64] = cvt_pk(st.o[db][qb][2 * k] * g0, st.o[db][qb][2 * k + 1] * g0); } }
    unsigned un[4], unq[NQB][4];
    { unsigned u = taken; u |= __shfl_xor(u, 4); u |= __shfl_xor(u, 8); u |= __shfl_xor(u, 16);
#pragma unroll
      for (int qb = 0; qb < NQB; ++qb)
#pragma unroll
          for (int p = 0; p < 4; ++p) unq[qb][p] = __builtin_amdgcn_readlane(u, 32 * qb + p);
#pragma unroll
      for (int p = 0; p < 4; ++p) { un[p] = unq[0][p]; if (NQB > 1) un[p] |= unq[NQB - 1][p]; } }
    LDS_WAIT(); asm volatile("" ::: "memory");

    f32x16 sbase;
#pragma unroll
    for (int i = 0; i < 16; ++i) sbase[i] = sl * (float)OFFI(i);
#pragma unroll
    for (int br = 0; br < 2; ++br) {
#pragma unroll
        for (int qb = 0; qb < NQB; ++qb) { st.m[qb] = -1.0e30f; st.l[qb] = 0.f; }
#pragma unroll
        for (int db = 0; db < 2; ++db)
#pragma unroll
            for (int qb = 0; qb < NQB; ++qb)
#pragma unroll
                for (int i = 0; i < 16; ++i) st.o[db][qb][i] = 0.f;
        const bf16* kb_ = br == 0 ? A.ks : A.kw; const int pitch = br == 0 ? A.spitch : A.wpitch, nrows = br == 0 ? A.srows : A.wrows, pos0 = br == 0 ? 0 : A.wpos0;
        const int curblk = qmin >> 6;
        unsigned ub[4];
#pragma unroll
        for (int p = 0; p < 4; ++p) { const int hi = curblk - 32 * p; ub[p] = hi < 0 ? 0u : (hi >= 31 ? un[p] : (un[p] & ((2u << hi) - 1u))); }
        int wrow_min = 0, wrow_cur = -1, ublk = 0, upart = 3, hcnt = 0; unsigned ubits = ub[3];
        if (br == 1) { int lo = qmin - 511 - pos0; lo = lo > 0 ? lo : 0; wrow_min = lo & ~31; wrow_cur = (qmax - pos0) & ~31; }
#define NEXT_TILE(ROW, BLK, OK) do { OK = false; \
            if (br == 0) { for (;;) { \
                if (hcnt == 0) { while (ubits == 0u && upart > 0) { --upart; ubits = upart == 2 ? ub[2] : (upart == 1 ? ub[1] : ub[0]); } \
                    if (ubits == 0u) break; \
                    const int j_ = 31 - __builtin_clz(ubits); ubits &= ~(1u << j_); ublk = 32 * upart + j_; hcnt = 2; } \
                --hcnt; const int r_ = ublk * 64 + 32 * hcnt; if (r_ > qmax) continue; \
                ROW = r_; BLK = ublk; OK = true; break; } } \
            else if (wrow_cur >= wrow_min) { ROW = wrow_cur; BLK = 0; wrow_cur -= 32; OK = true; } } while (0)
        int crow = 0, cblk = 0; bool cok; NEXT_TILE(crow, cblk, cok);
        int pb = 0;
        if (cok) { issue_k(kl, kb_, pitch, crow, nrows, lane); issue_v(vl, kb_ + 256, pitch, crow, nrows, lane); }
        while (cok) {
            int nrow = 0, nblk = 0; bool nok; NEXT_TILE(nrow, nblk, nok);
            bf16x8 kf[4];
            asm volatile("s_waitcnt vmcnt(4)" ::: "memory"); read_kf(kf, kl, lane); LDS_WAIT(); asm volatile("" ::: "memory");
            if (nok) { issue_k(kl, kb_, pitch, nrow, nrows, lane); issue_v(pb ? vl : wl + AL_V1, kb_ + 256, pitch, nrow, nrows, lane); }
            bool sb[NQB], act[NQB];
#pragma unroll
            for (int qb = 0; qb < NQB; ++qb) { sb[qb] = true; act[qb] = true;
                if (br == 0) { const unsigned w = selm[(qb * 8 + (c >> 2)) * 4 + (cblk >> 5)]; sb[qb] = (w >> (cblk & 31)) & 1u;
                    const int pp = cblk >> 5; const unsigned uw = pp == 0 ? unq[qb][0] : (pp == 1 ? unq[qb][1] : (pp == 2 ? unq[qb][2] : unq[qb][3])); act[qb] = (uw >> (cblk & 31)) & 1u; } }
            const int nb = pos0 + crow + 4 * h;
            const bool interior = (pos0 + crow + 31 <= qmin) && (br == 0 || qmax - (pos0 + crow) < 512);
            bf16x8 pf[NQB][2];
#pragma unroll
            for (int qb = 0; qb < NQB; ++qb) if (act[qb]) {
                const bool un_ = st.m[qb] < -1.0e29f; const float mref = un_ ? 0.f : st.m[qb];
                const float fb = sl * (float)(nb - qpos[qb]);
                const float c0 = ((interior && !sb[qb]) ? NEGS : fb) - mref;
                f32x16 s;
#pragma unroll
                for (int i = 0; i < 16; ++i) s[i] = sbase[i] + c0;
#pragma unroll
                for (int ks = 0; ks < 4; ++ks) s = __builtin_amdgcn_mfma_f32_32x32x16_bf16(kf[ks], qf[qb][ks], s, 0, 0, 0);
                if (!interior) { const int lo_rel = (br == 1) ? (qpos[qb] - 511 - nb) : -64, hi_rel = qpos[qb] - nb;
#pragma unroll
                    for (int i = 0; i < 16; ++i) { const bool ok = sb[qb] && (OFFI(i) <= hi_rel) && (OFFI(i) >= lo_rel); s[i] = ok ? s[i] : NEGS; } }
                float tm = xhalf_max(max16(s));
                const bool dead = tm < -1.0e37f;
                const float shift = dead ? 0.f : (un_ ? tm : (tm > 8.f ? tm : 0.f));
                if (__any(shift != 0.f)) {
                    const float al = un_ ? 1.f : ex2(-shift);
#pragma unroll
                    for (int i = 0; i < 16; ++i) s[i] -= shift;
                    st.l[qb] *= al;
#pragma unroll
                    for (int db = 0; db < 2; ++db)
#pragma unroll
                        for (int i = 0; i < 16; ++i) st.o[db][qb][i] *= al;
                }
                if (!dead) st.m[qb] = mref + shift;
                float sum = 0.f;
#pragma unroll
                for (int i = 0; i < 16; ++i) { s[i] = ex2(s[i]); sum += s[i]; }
                st.l[qb] += sum;
                pack_p(pf[qb], s);
                __builtin_amdgcn_sched_barrier(0);
            }
            if (nok) asm volatile("s_waitcnt vmcnt(8) lgkmcnt(0)" ::: "memory"); else asm volatile("s_waitcnt vmcnt(0) lgkmcnt(0)" ::: "memory");
#pragma unroll
            for (int db = 0; db < 2; ++db)
#pragma unroll
                for (int ks = 0; ks < 2; ++ks) { const bf16x8 vf = vfrag((pb ? wl + AL_V1 : vl) + (db ? voff1 : voff0), ks);
#pragma unroll
                    for (int qb = 0; qb < NQB; ++qb) if (act[qb]) st.o[db][qb] = __builtin_amdgcn_mfma_f32_32x32x16_bf16(vf, pf[qb][ks], st.o[db][qb], 0, 0, 0); }
            LDS_WAIT(); asm volatile("" ::: "memory");
            crow = nrow; cblk = nblk; cok = nok; pb ^= 1;
        }
#undef NEXT_TILE
        unsigned* stash = stash0; asm volatile("s_waitcnt vmcnt(0)" : "+v"(stash) :: "memory");
#pragma unroll
        for (int qb = 0; qb < NQB; ++qb) {
            const int tok = qb * 8 + (c >> 2);
            const float gbr = gates[((size_t)qrow0 + tok) * 48 + (4 * g + head) * 3 + 1 + br];
            const float lt = xhalf_sum(st.l[qb]); const float sc = lt > 0.f ? gbr / lt : 0.f;
            bf16* orow = Ob + ((size_t)qrow0 + tok) * DM + (4 * g + head) * 64;
#pragma unroll
            for (int db = 0; db < 2; ++db)
#pragma unroll
                for (int k = 0; k < 8; k += 2) {
                    const unsigned w0 = stash[((db * NQB + qb) * 8 + k) * 64], w1 = stash[((db * NQB + qb) * 8 + k + 1) * 64];
                    const float e0 = __uint_as_float(w0 << 16) + st.o[db][qb][2 * k] * sc, e1 = __uint_as_float(w0 & 0xffff0000u) + st.o[db][qb][2 * k + 1] * sc;
                    const float e2 = __uint_as_float(w1 << 16) + st.o[db][qb][2 * k + 2] * sc, e3 = __uint_as_float(w1 & 0xffff0000u) + st.o[db][qb][2 * k + 3] * sc;
                    if (br == 0) { stash[((db * NQB + qb) * 8 + k) * 64] = cvt_pk(e0, e1); stash[((db * NQB + qb) * 8 + k + 1) * 64] = cvt_pk(e2, e3); }
                    else { v2u w; w.x = cvt_pk(e0, e1); w.y = cvt_pk(e2, e3); *(v2u*)(orow + 32 * db + 8 * (k >> 1) + 4 * h) = w; }
                }
        }
        LDS_WAIT(); asm volatile("" ::: "memory");
    }
}

constexpr int CW_AQ = 8192;
__device__ __forceinline__ void attn_phase_v2(Frame& F, int qslot = 0) {
    LAS unsigned char* wl = F.lds + F.wave * WAVE_LDS;
    unsigned* qh = (unsigned*)(F.ws + WS_CTL) + CW_AQ + 64 * qslot;
    constexpr int NUP = NB * NG * (SEQ / 16), NUS = DB * NG;
    for (;;) {
        unsigned u = 0; if (F.lane == 0) u = atomicAdd(qh, 1u); u = __builtin_amdgcn_readfirstlane(u);
        if (u >= (unsigned)(NUP + NUS)) break;
        ASeq A;
        if (u >= (unsigned)NUS) {
            const unsigned v_ = u - NUS; const int tt = (SEQ / 16 - 1) - (int)(v_ >> 3), b = (v_ >> 2) & 1, g = v_ & 3;
            A.kc = (const bf16*)(F.ws + WS_KCP) + (size_t)(b * NG + g) * 512 * 64; A.vc = (const bf16*)(F.ws + WS_VCP) + (size_t)(b * NG + g) * 512 * 64; A.nc = NCP;
            A.ks = (const bf16*)(F.ws + WS_KVB) + (size_t)b * SEQ * 1024 + 512 + g * 64; A.spitch = 1024; A.srows = SEQ;
            A.kw = (const bf16*)(F.ws + WS_WINB) + (size_t)b * SEQ * 512 + g * 64; A.wpitch = 512; A.wrows = SEQ; A.wpos0 = 0; A.qpos0 = 0; A.ns = NSP;
            attn_unit<2>(F, A, b * SEQ + tt * 16, g, tt * 16, wl);
        } else {
            const int v = (int)u, s = v >> 2, g = v & 3;
            A.kc = (const bf16*)(F.ws + WS_KCS) + (size_t)(s * NG + g) * 128 * 64; A.vc = (const bf16*)(F.ws + WS_VCS) + (size_t)(s * NG + g) * 128 * 64; A.nc = NCS;
            A.ks = (const bf16*)(F.ws + WS_SELS) + (size_t)s * (PAST + DS) * 512 + g * 64; A.spitch = 512; A.srows = PAST + DS;
            A.kw = (const bf16*)(F.ws + WS_WINS) + (size_t)s * 520 * 512 + g * 64; A.wpitch = 512; A.wrows = 520; A.wpos0 = PAST - 512; A.qpos0 = PAST; A.ns = NSS;
            attn_unit<1>(F, A, MP + s * DS, g, 0, wl);
        }
    }
}
constexpr int S5L = 32;
__device__ __forceinline__ void cmul(float& r, float& i, float ar, float ai) { const float t = r * ar - i * ai; i = r * ai + i * ar; r = t; }

__device__ __forceinline__ void s5_tables_part(Frame& F, int g, int q, LAS float* sl) {
    LAS float* Bbr = sl; LAS float* Bbi = sl + 1024; LAS float* Cr = sl + 2048; LAS float* Ci = sl + 3072; LAS float* Ar = sl + 4096; LAS float* Ai = sl + 4160; LAS float* Qr = sl + 4224; LAS float* Qi = sl + 4288;
    const int tid = F.tid;
    bf16* KT = (bf16*)(F.ws + WS_S5K) + (size_t)g * 32 * 256; bf16* WE = (bf16*)(F.ws + WS_S5W) + (size_t)g * 128 * 512; bf16* VI = (bf16*)(F.ws + WS_S5V) + (size_t)g * 512 * 128;
    float* AL = (float*)(F.ws + WS_S5A) + (size_t)g * 128; float* A8 = (float*)(F.ws + WS_S5A) + 64 * 128 + (size_t)g * 128;
    const float* gn = F.in[I_NMIX] + DM;
    __syncthreads();
    if (tid < 64) {
        const int p = tid;
        const float are = F.in[I_ARE][g * 64 + p], aim = F.in[I_AIM][g * 64 + p], dt = expf(F.in[I_LDT][g]);
        const float er = expf(are * dt); float sn, cs; sincosf(aim * dt, &sn, &cs);
        const float abr = er * cs, abi = er * sn;
        const float nr = abr - 1.f, ni = abi, den = are * are + aim * aim;
        const float fr_ = (nr * are + ni * aim) / den, fi_ = (ni * are - nr * aim) / den;
        Ar[p] = abr; Ai[p] = abi;
#pragma unroll
        for (int c = 0; c < 16; ++c) { const float br = F.in[I_BRE][(g * 64 + p) * 16 + c], bi = F.in[I_BIM][(g * 64 + p) * 16 + c], gg = gn[g * 16 + c];
            Bbr[p * 16 + c] = (fr_ * br - fi_ * bi) * gg; Bbi[p * 16 + c] = (fr_ * bi + fi_ * br) * gg; }
        float r = abr, i = abi; cmul(r, i, r, i); cmul(r, i, r, i); cmul(r, i, r, i);
        float qr = 1.f, qi = 0.f;
        for (int k = 0; k < q; ++k) cmul(qr, qi, r, i);
        Qr[p] = qr; Qi[p] = qi;
        if (q == 0) { A8[p] = r; A8[64 + p] = i; cmul(r, i, r, i); cmul(r, i, r, i); AL[p] = r; AL[64 + p] = i; }
    }
    for (int e = tid; e < 1024; e += 512) { Cr[e] = F.in[I_CRE][g * 1024 + e]; Ci[e] = F.in[I_CIM][g * 1024 + e]; }
    __syncthreads();
    if (tid < 256) {
        const int c = tid >> 4, cp = tid & 15;
        float acc[8];
#pragma unroll
        for (int t = 0; t < 8; ++t) acc[t] = 0.f;
        for (int p = 0; p < 64; ++p) {
            const float cr = Cr[c * 64 + p], ci = Ci[c * 64 + p], br = Bbr[p * 16 + cp], bi = Bbi[p * 16 + cp], ar = Ar[p], ai = Ai[p];
            float mr = cr * br - ci * bi, mi = cr * bi + ci * br; cmul(mr, mi, Qr[p], Qi[p]);
#pragma unroll
            for (int t = 0; t < 8; ++t) { acc[t] += mr; cmul(mr, mi, ar, ai); }
        }
        if (q == 0 && c == cp) acc[0] += F.in[I_SD][g * 16 + c] * gn[g * 16 + c];
#pragma unroll
        for (int t = 0; t < 8; ++t) KT[(8 * q + t) * 256 + tid] = (bf16)f2bf(acc[t]);
    }
    {
        const int p = tid & 63, j = tid >> 6, sidx = 31 - 8 * q - j; const float ar = Ar[p], ai = Ai[p];
        float pr = Qr[p], pi = Qi[p];
        for (int k = 0; k < j; ++k) cmul(pr, pi, ar, ai);
        float wre[16], wim[16];
#pragma unroll
        for (int cp = 0; cp < 16; ++cp) { const float br = Bbr[p * 16 + cp], bi = Bbi[p * 16 + cp]; wre[cp] = pr * br - pi * bi; wim[cp] = pr * bi + pi * br; }
        v4u o;
        o.x = pk2(wre[0], wre[1]); o.y = pk2(wre[2], wre[3]); o.z = pk2(wre[4], wre[5]); o.w = pk2(wre[6], wre[7]); *(v4u*)(WE + (size_t)p * 512 + 16 * sidx) = o;
        o.x = pk2(wre[8], wre[9]); o.y = pk2(wre[10], wre[11]); o.z = pk2(wre[12], wre[13]); o.w = pk2(wre[14], wre[15]); *(v4u*)(WE + (size_t)p * 512 + 16 * sidx + 8) = o;
        o.x = pk2(wim[0], wim[1]); o.y = pk2(wim[2], wim[3]); o.z = pk2(wim[4], wim[5]); o.w = pk2(wim[6], wim[7]); *(v4u*)(WE + (size_t)(64 + p) * 512 + 16 * sidx) = o;
        o.x = pk2(wim[8], wim[9]); o.y = pk2(wim[10], wim[11]); o.z = pk2(wim[12], wim[13]); o.w = pk2(wim[14], wim[15]); *(v4u*)(WE + (size_t)(64 + p) * 512 + 16 * sidx + 8) = o;
    }
    {
        const int p = tid & 63, cq = tid >> 6; const float ar = Ar[p], ai = Ai[p];
        float pr = Qr[p], pi = Qi[p]; cmul(pr, pi, ar, ai);
        for (int j = 0; j < 8; ++j) { const int t = 8 * q + j;
#pragma unroll
            for (int k = 0; k < 2; ++k) { const int c = 2 * cq + k; const float cr = Cr[c * 64 + p], ci = Ci[c * 64 + p];
                VI[(size_t)(16 * t + c) * 128 + p] = (bf16)f2bf(cr * pr - ci * pi); VI[(size_t)(16 * t + c) * 128 + 64 + p] = (bf16)f2bf(-(cr * pi + ci * pr)); }
            cmul(pr, pi, ar, ai);
        }
    }
    __syncthreads();
}
__device__ __forceinline__ void s5_tables(Frame& F) { for (int u = blockIdx.x; u < 256; u += gridDim.x) s5_tables_part(F, u >> 2, u & 3, (LAS float*)F.lds); }

__device__ __forceinline__ bf16x8 s5_ufrag(const bf16* XG, const float* ss, int row, int col) {
    const v4u w = *(const v4u*)(XG + ((size_t)(col >> 4) * M + row) * 16 + (col & 15)); const float rs = rsqrtf(ss[row] * (1.f / DM) + EPS);
    v4u o; o.x = cvt_pk(__uint_as_float(w.x << 16) * rs, __uint_as_float(w.x & 0xffff0000u) * rs); o.y = cvt_pk(__uint_as_float(w.y << 16) * rs, __uint_as_float(w.y & 0xffff0000u) * rs);
    o.z = cvt_pk(__uint_as_float(w.z << 16) * rs, __uint_as_float(w.z & 0xffff0000u) * rs); o.w = cvt_pk(__uint_as_float(w.w << 16) * rs, __uint_as_float(w.w & 0xffff0000u) * rs);
    return __builtin_bit_cast(bf16x8, o);
}
__device__ __forceinline__ bf16x8 ldfrag(const bf16* p) { return *(const bf16x8*)p; }
__device__ __forceinline__ void s5_store_z(bf16* Z, const f32x16& y, size_t row_t0, int g, int h) {
#pragma unroll
    for (int q = 0; q < 4; ++q) { v2u w; w.x = cvt_pk(gelu_tanh_div(y[4 * q]), gelu_tanh_div(y[4 * q + 1])); w.y = cvt_pk(gelu_tanh_div(y[4 * q + 2]), gelu_tanh_div(y[4 * q + 3]));
        *(v2u*)(Z + (row_t0 + (q >> 1)) * DM + g * 16 + 8 * (q & 1) + 4 * h) = w; }
}

constexpr int S5_EP = 65;
constexpr int S5_HP = 136;
constexpr int S5_XP = 1040;
constexpr int S5_LE = 0, S5_LH = 128 * S5_EP * 4, S5_LX = S5_LH + 64 * S5_HP * 2, S5_LK = S5_LX + 64 * S5_XP, S5_LEND = S5_LK + 16384;
static_assert(S5_LEND <= MISC_OFF, "S5 LDS map");
__device__ __forceinline__ void s5_prompt_unit(Frame& F, int b, int g, const bf16* XG, const float* ss) {
    LAS float* E = (LAS float*)(F.lds + S5_LE); LAS bf16* Hp = (LAS bf16*)(F.lds + S5_LH); LAS unsigned char* xs = F.lds + S5_LX; LAS unsigned char* kt = F.lds + S5_LK;
    const int w = F.wave;
    const bf16* KT = (const bf16*)(F.ws + WS_S5K) + (size_t)g * 32 * 256; const bf16* WE = (const bf16*)(F.ws + WS_S5W) + (size_t)g * 128 * 512; const bf16* VI = (const bf16*)(F.ws + WS_S5V) + (size_t)g * 512 * 128;
    const float* AL = (const float*)(F.ws + WS_S5A) + (size_t)g * 128;
    bf16* Z = (bf16*)(F.ws + WS_Z);
    float hr = 0.f, hi = 0.f, alr = 0.f, ali = 0.f;
    if (w == 0) { alr = AL[F.lane]; ali = AL[64 + F.lane]; }
    const int cb = w >> 2, rq = w & 3;
    __syncthreads();
    { const int tid = F.tid; const v4u* src = (const v4u*)KT; LAS v4u* dst = (LAS v4u*)kt; dst[tid] = src[tid]; dst[tid + 512] = src[tid + 512]; }
    v4u xv[8]; float rv[8];
    { const int tid = F.tid; const bf16* xsrc = XG + ((size_t)g * M + (size_t)b * SEQ) * 16;
#pragma unroll
      for (int k = 0; k < 8; ++k) { const int e = tid + 512 * k; xv[k] = *(const v4u*)(xsrc + (size_t)e * 8); rv[k] = ss[b * SEQ + (e >> 1)]; } }
    for (int seg = 0; seg < 4; ++seg) {
        int lane_ = F.lane; asm volatile("" : "+v"(lane_));
        const int lane = lane_ & 63, tid = w * 64 + lane, h = lane >> 5, c31 = lane & 31;
        const int srow0 = b * SEQ + seg * 2048;
        bf16x8 wfr[32];
        { const bf16* wp = WE + (size_t)(32 * rq + c31) * 512 + 8 * h;
#pragma unroll
          for (int s = 0; s < 32; ++s) wfr[s] = ldfrag(wp + 16 * s); }
        {
#pragma unroll
            for (int k = 0; k < 8; ++k) { const int e = tid + 512 * k, tok = e >> 1; const float rs = rsqrtf(rv[k] * (1.f / DM) + EPS); const v4u w4 = xv[k];
                v4u o; o.x = cvt_pk(__uint_as_float(w4.x << 16) * rs, __uint_as_float(w4.x & 0xffff0000u) * rs); o.y = cvt_pk(__uint_as_float(w4.y << 16) * rs, __uint_as_float(w4.y & 0xffff0000u) * rs);
                o.z = cvt_pk(__uint_as_float(w4.z << 16) * rs, __uint_as_float(w4.z & 0xffff0000u) * rs); o.w = cvt_pk(__uint_as_float(w4.w << 16) * rs, __uint_as_float(w4.w & 0xffff0000u) * rs);
                *(LAS v4u*)(xs + (tok >> 5) * S5_XP + (tok & 31) * 32 + (e & 1) * 16) = o; }
        }
        __syncthreads();
        LAS const unsigned char* xl = xs + (32 * cb + c31) * S5_XP + 16 * h;
        const int row0 = srow0 + (32 * cb + c31) * S5L;
        {
            f32x16 acc;
#pragma unroll
            for (int i = 0; i < 16; ++i) acc[i] = 0.f;
#pragma unroll
            for (int s = 0; s < 32; ++s) acc = __builtin_amdgcn_mfma_f32_32x32x16_bf16(wfr[s], *(LAS const bf16x8*)(xl + 32 * s), acc, 0, 0, 0);
#pragma unroll
            for (int i = 0; i < 16; ++i) E[(32 * rq + (i & 3) + 8 * (i >> 2) + 4 * h) * S5_EP + 32 * cb + c31] = acc[i];
        }
        __syncthreads();
        if (w == 0) {
            for (int j0 = 0; j0 < 64; j0 += 8) {
                float er[8], ei[8];
#pragma unroll
                for (int j = 0; j < 8; ++j) { er[j] = E[lane * S5_EP + j0 + j]; ei[j] = E[(64 + lane) * S5_EP + j0 + j]; }
#pragma unroll
                for (int j = 0; j < 8; ++j) {
                    Hp[(j0 + j) * S5_HP + lane] = (bf16)f2bf(hr); Hp[(j0 + j) * S5_HP + 64 + lane] = (bf16)f2bf(hi);
                    cmul(hr, hi, alr, ali); hr += er[j]; hi += ei[j];
                }
            }
        }
        __syncthreads();
        if (seg < 3) {
            const bf16* xsrc = XG + ((size_t)g * M + srow0 + 2048) * 16;
#pragma unroll
            for (int k = 0; k < 8; ++k) { const int e = tid + 512 * k; xv[k] = *(const v4u*)(xsrc + (size_t)e * 8); rv[k] = ss[srow0 + 2048 + (e >> 1)]; }
        }
        {
            f32x16 acc[4];
#pragma unroll
            for (int i4 = 0; i4 < 4; ++i4)
#pragma unroll
                for (int i = 0; i < 16; ++i) acc[i4][i] = 0.f;
            const int tin = c31 >> 4, cc = c31 & 15;
            bf16x8 vi[4][4];
#pragma unroll
            for (int ks = 0; ks < 4; ++ks)
#pragma unroll
                for (int i4 = 0; i4 < 4; ++i4) vi[ks][i4] = ldfrag(VI + (size_t)(32 * (rq + 4 * i4) + c31) * 128 + 16 * ks + 8 * h);
#pragma unroll 4
            for (int s = 0; s < 32; ++s) {
                const bf16x8 uf = *(LAS const bf16x8*)(xl + 32 * s);
#pragma unroll
                for (int i4 = 0; i4 < 4; ++i4) { const int tau = 2 * (rq + 4 * i4) + tin - s;
                    if (s <= 2 * (rq + 4 * i4) + 1) {
                        bf16x8 a = *(LAS const bf16x8*)(kt + (tau < 0 ? 0 : tau) * 512 + cc * 32 + 16 * h);
                        if (tau < 0) a = (bf16x8){0, 0, 0, 0, 0, 0, 0, 0};
                        acc[i4] = __builtin_amdgcn_mfma_f32_32x32x16_bf16(a, uf, acc[i4], 0, 0, 0); } }
            }
#pragma unroll
            for (int ks = 0; ks < 4; ++ks) {
                const bf16x8 hf = *(LAS const bf16x8*)(Hp + (32 * cb + c31) * S5_HP + 16 * ks + 8 * h);
#pragma unroll
                for (int i4 = 0; i4 < 4; ++i4) acc[i4] = __builtin_amdgcn_mfma_f32_32x32x16_bf16(vi[ks][i4], hf, acc[i4], 0, 0, 0);
            }
#pragma unroll
            for (int ks = 0; ks < 4; ++ks)
#pragma unroll
                for (int i4 = 0; i4 < 4; ++i4) vi[ks][i4] = ldfrag(VI + (size_t)(32 * (rq + 4 * i4) + c31) * 128 + 16 * (ks + 4) + 8 * h);
#pragma unroll
            for (int ks = 0; ks < 4; ++ks) {
                const bf16x8 hf = *(LAS const bf16x8*)(Hp + (32 * cb + c31) * S5_HP + 16 * (ks + 4) + 8 * h);
#pragma unroll
                for (int i4 = 0; i4 < 4; ++i4) acc[i4] = __builtin_amdgcn_mfma_f32_32x32x16_bf16(vi[ks][i4], hf, acc[i4], 0, 0, 0);
            }
#pragma unroll
            for (int i4 = 0; i4 < 4; ++i4) s5_store_z(Z, acc[i4], (size_t)row0 + 2 * (rq + 4 * i4), g, h);
        }
        __syncthreads();
    }
    if (w == 0) { F.out[O_SREP + ((size_t)b * 64 + g) * 64 + F.lane] = hr; F.out[O_SIMP + ((size_t)b * 64 + g) * 64 + F.lane] = hi; }
}

__device__ __forceinline__ void s5_sample_unit(Frame& F, int g, int cb, const bf16* XB, const float* ss) {
    const int lane = F.lane, h = lane >> 5, c31 = lane & 31, seq = 32 * cb + c31;
    const bf16* KT = (const bf16*)(F.ws + WS_S5K) + (size_t)g * 32 * 256; const bf16* WE = (const bf16*)(F.ws + WS_S5W) + (size_t)g * 128 * 512; const bf16* VI = (const bf16*)(F.ws + WS_S5V) + (size_t)g * 512 * 128;
    const float* A8 = (const float*)(F.ws + WS_S5A) + 64 * 128 + (size_t)g * 128;
    bf16* Z = (bf16*)(F.ws + WS_Z);
    const int row0 = MP + seq * DS;
    bf16x8 uf[8];
#pragma unroll
    for (int s = 0; s < 8; ++s) uf[s] = s5_ufrag(XB, ss, row0 + s, g * 16 + 8 * h);
    const float* h0r = F.in[I_SRE] + ((size_t)seq * 64 + g) * 64; const float* h0i = F.in[I_SIM] + ((size_t)seq * 64 + g) * 64;
    {
        f32x16 acc[4];
#pragma unroll
        for (int rb = 0; rb < 4; ++rb)
#pragma unroll
            for (int i = 0; i < 16; ++i) acc[rb][i] = 0.f;
        const int tin = c31 >> 4, cc = c31 & 15;
#pragma unroll
        for (int s = 0; s < 8; ++s)
#pragma unroll
            for (int rb = 0; rb < 4; ++rb) if (s <= 2 * rb + 1) { const int tau = 2 * rb + tin - s;
                bf16x8 a = ldfrag(KT + (size_t)(tau < 0 ? 0 : tau) * 256 + cc * 16 + 8 * h); if (tau < 0) a = (bf16x8){0, 0, 0, 0, 0, 0, 0, 0};
                acc[rb] = __builtin_amdgcn_mfma_f32_32x32x16_bf16(a, uf[s], acc[rb], 0, 0, 0); }
#pragma unroll
        for (int ks = 0; ks < 8; ++ks) {
            const float* hp = (ks < 4 ? h0r : h0i) + 16 * (ks & 3) + 8 * h;
            const f32x4 x0 = ld4(hp), x1 = ld4(hp + 4);
            v4u o; o.x = cvt_pk(x0[0], x0[1]); o.y = cvt_pk(x0[2], x0[3]); o.z = cvt_pk(x1[0], x1[1]); o.w = cvt_pk(x1[2], x1[3]);
            const bf16x8 hf = __builtin_bit_cast(bf16x8, o);
#pragma unroll
            for (int rb = 0; rb < 4; ++rb) acc[rb] = __builtin_amdgcn_mfma_f32_32x32x16_bf16(ldfrag(VI + (size_t)(32 * rb + c31) * 128 + 16 * ks + 8 * h), hf, acc[rb], 0, 0, 0);
        }
#pragma unroll
        for (int rb = 0; rb < 4; ++rb) s5_store_z(Z, acc[rb], (size_t)row0 + 2 * rb, g, h);
    }
    {
        f32x16 acc[4];
#pragma unroll
        for (int rb = 0; rb < 4; ++rb)
#pragma unroll
            for (int i = 0; i < 16; ++i) acc[rb][i] = 0.f;
#pragma unroll
        for (int s = 0; s < 8; ++s)
#pragma unroll
            for (int rb = 0; rb < 4; ++rb) acc[rb] = __builtin_amdgcn_mfma_f32_32x32x16_bf16(ldfrag(WE + (size_t)(32 * rb + c31) * 512 + 16 * (24 + s) + 8 * h), uf[s], acc[rb], 0, 0, 0);
        float* ore = F.out + O_SRES + ((size_t)seq * 64 + g) * 64; float* oim = F.out + O_SIMS + ((size_t)seq * 64 + g) * 64;
#pragma unroll
        for (int rb = 0; rb < 2; ++rb)
#pragma unroll
            for (int i = 0; i < 16; ++i) { const int p = 32 * rb + (i & 3) + 8 * (i >> 2) + 4 * h;
                const float xr = h0r[p], xi = h0i[p], ar = A8[p], ai = A8[64 + p];
                ore[p] = acc[rb][i] + (ar * xr - ai * xi); oim[p] = acc[rb + 2][i] + (ar * xi + ai * xr); }
    }
}

__device__ __forceinline__ void s5_phase_v2(Frame& F) {
    const bf16* XB = (const bf16*)(F.ws + WS_XG); const float* ss = F.SS(3);
    const int G = gridDim.x, bid = blockIdx.x;
    const int npw = (G >= 256) ? 128 : G;
    if (bid < npw) { for (int u = bid; u < NB * 64; u += npw) s5_prompt_unit(F, u >> 6, u & 63, XB, ss); }
    const int ws0 = (G >= 256) ? 128 : 0, nsw = (G - ws0) * NWAVES;
    if (bid >= ws0) { for (int u = (bid - ws0) * NWAVES + F.wave; u < 64 * 4; u += nsw) s5_sample_unit(F, u >> 2, u & 3, XB, ss); }
}
#ifndef MK_ONE_LAUNCH
#define MK_ONE_LAUNCH 0
#endif
constexpr int N_PHASES = 17;
#define GP(EPI) pg8::gemm_phase<EPI, pg8::StaticOrder, true, true>
#define REFRESH() do { F.lane = mk_lane(); F.tid = F.wave * 64 + F.lane; } while (0)

__global__ void __launch_bounds__(NWAVES * 64, 2) nsa_s5_fwd(Args args) {
    extern __shared__ __attribute__((aligned(16))) unsigned char lds[];
    Frame F;
    F.lds = (LAS unsigned char*)lds;
    F.wave = __builtin_amdgcn_readfirstlane((int)(threadIdx.x >> 6)); F.lane = mk_lane(); F.tid = F.wave * 64 + F.lane;
    F.gw = blockIdx.x * NWAVES + F.wave; F.NGW = gridDim.x * NWAVES;
    F.ws = args.ws; F.out = args.out; F.in = args.in; F.pt = args.page_table;
    volatile LAS unsigned* MISC = (volatile LAS unsigned*)(F.lds + MISC_OFF);
    if (F.tid < 64) MISC[F.tid] = 0u;
    __syncthreads();
#if MK_ONE_LAUNCH
    XcdBarrier bar = xcd_barrier_post((unsigned*)(F.ws + WS_CTL) + CW_BAR, MISC + 8, (unsigned)F.wave);
#define GRID_BAR() xcd_barrier(bar)
#else
#define GRID_BAR() do {} while (0)
#endif
    const int lo = args.ph_lo, hi = args.ph_hi;
#ifndef PHMASK
#define PHMASK 0x1ffff
#endif
#define IN(k) ((((PHMASK) >> (k)) & 1) && lo <= (k) && (k) < hi)
#define SEAM(k) do { if (IN(k) && IN((k) + 1)) GRID_BAR(); } while (0)
    unsigned char* ws = F.ws;
    LAS unsigned char* ring = F.lds;
    const int G = gridDim.x, cid = blockIdx.x;

    const bool split1 = (G == 256); const int j1 = cid >> 3; const bool streamer = split1 && (j1 & 1) == 0;
    const int G1 = split1 ? 128 : G, c1 = split1 ? ((j1 >> 1) * 8 + (cid & 7)) : cid;
    if (IN(0)) { REFRESH(); p0_prologue(F); if (!split1) p0_stream(F, F.gw, F.NGW, 0, DB * PAST, true); SEAM(0); }

    if (IN(1)) {
        if (streamer) { REFRESH(); p0_stream(F, c1 * NWAVES + F.wave, 128 * NWAVES, 0, DB * PAST / 16 * 15, true); }
        else {
        { pg8::Gemm g{(const bf16*)(ws + WS_XBA), (const bf16*)(ws + WS_WIN_T), M, NINP, DM}; pg8::StaticOrder S; S.init(M, NINP, G1, c1);
          EpiAttnIn E{ws, F.out};
          GP(EpiAttnIn)(ring, g, S, E, F.wave); }
        { int kp = PLE; asm volatile("" : "+s"(kp));
          { pg8::Gemm g{(const bf16*)(ws + WS_PB0), (const bf16*)(ws + WS_WP_T0), MP, DM, kp}; pg8::StaticOrder S; S.init(MP, DM, G1, c1);
            EpiPlain E{(bf16*)(ws + WS_PP0), DM}; GP(EpiPlain)(ring, g, S, E, F.wave); }
          REFRESH(); sample_plain_sub(F, (const bf16*)(ws + WS_PB0), PLE, (const bf16*)(ws + WS_WP_T0), kp, (bf16*)(ws + WS_PP0), c1, G1); }
          if (split1) { REFRESH(); p0_stream(F, c1 * NWAVES + F.wave, 128 * NWAVES, DB * PAST / 16 * 15, DB * PAST, false); }
        }
        SEAM(1);
    }
    if (IN(2)) {
        REFRESH(); sample_cmp_pages(F);
        REFRESH(); prompt_cmp(F);
        SEAM(2);
    }
    if (IN(3)) { REFRESH(); cmp_finalize(F); s5_tables(F); SEAM(3); }
    if (IN(4)) { REFRESH(); attn_phase_v2(F); SEAM(4); }
    if (IN(5)) {
        pg8::Gemm g{(const bf16*)(ws + WS_OB), (const bf16*)(ws + WS_WOUT_T), MP, DM, DM}; pg8::StaticOrder S; S.init(MP, DM, G, cid);
        EpiResid E{(const bf16*)(ws + WS_XBA), (bf16*)(ws + WS_XBB), F.SS(1)};
        GP(EpiResid)(ring, g, S, E, F.wave);
        REFRESH(); sample_resid(F, (const bf16*)(ws + WS_OB), DM, (const bf16*)(ws + WS_WOUT_T), DM, (const bf16*)(ws + WS_XBA), (bf16*)(ws + WS_XBB), F.SS(1));
        SEAM(5);
    }
#define LAYER_BODY(layer) do { \
        const int pb = layer ? 12 : 6; \
        bf16* xb_up = (bf16*)(ws + (layer ? WS_XBA : WS_XBB)); \
        bf16* xb_dn = (bf16*)(ws + (layer ? WS_XBB : WS_XBA)); \
        if (layer == 1) { \
            if (IN(10)) { REFRESH(); s5_phase_v2(F); \
                if (G >= 256 && cid >= 128) {     \
                    int kp = PLE; asm volatile("" : "+s"(kp)); \
                    pg8::Gemm g{(const bf16*)(ws + WS_PB1), (const bf16*)(ws + WS_WP_T1), MP, DM, kp}; pg8::StaticOrder S; S.init(MP, DM, 128, cid - 128); \
                    EpiPlain E{(bf16*)(ws + WS_PP1), DM}; GP(EpiPlain)(ring, g, S, E, F.wave); \
                    REFRESH(); sample_plain_sub(F, (const bf16*)(ws + WS_PB1), PLE, (const bf16*)(ws + WS_WP_T1), kp, (bf16*)(ws + WS_PP1), cid - 128, 128); \
                    REFRESH(); p0_weights<1>(F, (cid - 128) * NWAVES + F.wave, 128 * NWAVES); \
                } else if (G < 256) { \
                    int kp = PLE; asm volatile("" : "+s"(kp)); \
                    pg8::Gemm g{(const bf16*)(ws + WS_PB1), (const bf16*)(ws + WS_WP_T1), MP, DM, kp}; pg8::StaticOrder S; S.init(MP, DM, G, cid); \
                    EpiPlain E{(bf16*)(ws + WS_PP1), DM}; GP(EpiPlain)(ring, g, S, E, F.wave); \
                    REFRESH(); sample_plain_sub(F, (const bf16*)(ws + WS_PB1), PLE, (const bf16*)(ws + WS_WP_T1), kp, (bf16*)(ws + WS_PP1), cid, G); \
                    REFRESH(); p0_weights<1>(F, F.gw, F.NGW); \
                } \
                SEAM(10); } \
            if (IN(11)) { \
                pg8::Gemm g{(const bf16*)(ws + WS_Z), (const bf16*)(ws + WS_WGLU_T), MP, 2 * DM, DM}; pg8::StaticOrder S; S.init(MP, 2 * DM, G, cid); \
                EpiGlu E{xb_dn, xb_up, F.SS(4)}; \
                GP(EpiGlu)(ring, g, S, E, F.wave); \
                REFRESH(); sample_glu(F, (const bf16*)(ws + WS_Z), (const bf16*)(ws + WS_WGLU_T), xb_dn, xb_up, F.SS(4)); \
                SEAM(11); \
            } \
        } \
        if (IN(pb)) { \
            pg8::Gemm g{xb_up, (const bf16*)(ws + (layer ? WS_WUP_T1 : WS_WUP_T0)), M, 2 * FF, DM}; pg8::StaticOrder S; S.init(M, 2 * FF, G, cid); \
            EpiUpFused E{ws, F.out, F.in[I_CONVW] + (size_t)layer * 3 * FF, F.in[I_CONVB] + (size_t)layer * FF, F.in[I_SCONV] + (size_t)layer * DB * 2 * FF, layer, F.lds}; \
            GP(EpiUpFused)(ring, g, S, E, F.wave); \
            SEAM(pb); \
        } \
        if (IN(pb + 2)) { \
            pg8::Gemm g{(const bf16*)(ws + WS_ACT), (const bf16*)(ws + (layer ? WS_WDN_T1 : WS_WDN_T0)), MP, DM, FF}; pg8::StaticOrder S; S.init(MP, DM, G, cid); \
            { REFRESH(); pg8::Unit uu; for (int i = 0; S.next(i, uu); ++i) { if (uu.pm < MP / 256 && (uu.pm & 31) != 0) up_fix(ws, F.in[I_CONVW] + (size_t)layer * 3 * FF, F.in[I_CONVB] + (size_t)layer * FF, uu.pm, F.tid); } \
              VM_WAIT(); __syncthreads(); } \
            EpiResid E{xb_up, xb_dn, F.SS(layer ? 5 : 2)}; \
            GP(EpiResid)(ring, g, S, E, F.wave); \
            REFRESH(); sample_resid(F, (const bf16*)(ws + WS_ACT), FF, (const bf16*)(ws + (layer ? WS_WDN_T1 : WS_WDN_T0)), FF, xb_up, xb_dn, F.SS(layer ? 5 : 2)); \
            SEAM(pb + 2); \
        } \
        if (IN(pb + 3)) { \
            pg8::Gemm g{xb_dn, (const bf16*)(ws + (layer ? WS_WG_T1 : WS_WG_T0)), MP, DM, DM}; pg8::StaticOrder S; S.init(MP, DM, G, cid); \
            EpiGate E{F.SS(layer ? 5 : 2), (const bf16*)(ws + (layer ? WS_PP1 : WS_PP0)), xb_dn, xb_up, F.SS(layer ? 6 : 3), layer ? (bf16*)nullptr : (bf16*)(ws + WS_XG)}; \
            GP(EpiGate)(ring, g, S, E, F.wave); \
            REFRESH(); sample_gate(F, xb_dn, (const bf16*)(ws + (layer ? WS_WG_T1 : WS_WG_T0)), F.SS(layer ? 5 : 2), (const bf16*)(ws + (layer ? WS_PP1 : WS_PP0)), xb_dn, xb_up, layer ? (bf16*)nullptr : (bf16*)(ws + WS_XG), F.SS(layer ? 6 : 3)); \
            SEAM(pb + 3); \
        } \
    } while (0)
    LAYER_BODY(0);
    LAYER_BODY(1);
#undef LAYER_BODY
    if (IN(16)) { REFRESH(); final_norm(F); }
#undef IN
#undef SEAM
}

extern "C" void kernel_launch(void* const* d_in, const int* in_sizes, int n_in, void* d_out, int out_size, void* d_ws, size_t ws_size, hipStream_t stream) {
    static int grid = 0;
    if (grid == 0) {
        if (n_in != 34 || out_size != (int)O_END || ws_size < WS_END) { fprintf(stderr, "kernel_launch: unexpected sizes n_in %d out %d ws %zu\n", n_in, out_size, ws_size); grid = -1; return; }
        int dev = 0, cus = 0, per_cu = 0;
        if (hipGetDevice(&dev) != hipSuccess || hipDeviceGetAttribute(&cus, hipDeviceAttributeMultiprocessorCount, dev) != hipSuccess) { grid = -1; return; }
        if (hipFuncSetAttribute((const void*)nsa_s5_fwd, hipFuncAttributeMaxDynamicSharedMemorySize, LDS_BYTES) != hipSuccess) { fprintf(stderr, "kernel_launch: hipFuncSetAttribute failed\n"); grid = -1; return; }
        if (hipOccupancyMaxActiveBlocksPerMultiprocessor(&per_cu, (const void*)nsa_s5_fwd, NWAVES * 64, LDS_BYTES) != hipSuccess || per_cu < 1)
            fprintf(stderr, "kernel_launch: occupancy query reports %d blocks per CU\n", per_cu);
        (void)hipGetLastError();
        grid = cus;
    }
    if (grid < 0) return;
    (void)hipMemsetAsync((char*)d_ws + WS_CTL, 0, CTL_ZERO_BYTES, stream);
    Args a{};
    for (int i = 0; i < 34; ++i) a.in[i] = (const float*)d_in[i];
    a.page_table = (const int*)d_in[I_PT]; a.out = (float*)d_out; a.ws = (unsigned char*)d_ws;
#if MK_ONE_LAUNCH
    a.ph_lo = 0; a.ph_hi = N_PHASES;
    hipLaunchKernelGGL(nsa_s5_fwd, dim3(grid), dim3(NWAVES * 64), LDS_BYTES, stream, a);
#else
    for (int p = 0; p < N_PHASES; ++p) { a.ph_lo = p; a.ph_hi = p + 1; hipLaunchKernelGGL(nsa_s5_fwd, dim3(grid), dim3(NWAVES * 64), LDS_BYTES, stream, a); }
#endif
}
```
